# Optimizing an MI355X kernel written in HIP

```python
import math
import jax, jax.numpy as jnp
from jax import lax
import numpy as np

D_MODEL = 1024
BATCH = 8
SEQ = 2048
DEPTH = 2
DEC_BATCH = 128
DEC_SEQ = 1
PAST_LEN = 16384
PAGE_SIZE = 128

W_A = D_MODEL
N_BLOCKS_A = 8
BLK_A = W_A // N_BLOCKS_A
CONV_A = 4
LRU_C = 8.0
W_B = D_MODEL // 2
CONV_B = 31
W_C = D_MODEL // 2
GS_C = 16
G_C = W_C // GS_C
P_C = 64
N_BRANCH = 3
IN_W = W_A + 2 * W_B + W_C + N_BRANCH * D_MODEL
D_FF = int(math.ceil(8 * D_MODEL / 3 / 256) * 256)
EPS = 1e-6

kernel_name = 'hybrid_rglru_conformer_s5_step'


def rms_norm(x, g):
    xf = x.astype(jnp.float32)
    y = xf * lax.rsqrt(jnp.mean(xf * xf, axis=-1, keepdims=True) + EPS)
    return (y * g.astype(jnp.float32)).astype(x.dtype)


def layer_norm(x, g, b):
    xf = x.astype(jnp.float32)
    mu = jnp.mean(xf, axis=-1, keepdims=True)
    xc = xf - mu
    y = xc * lax.rsqrt(jnp.mean(xc * xc, axis=-1, keepdims=True) + EPS)
    return (y * g.astype(jnp.float32) + b.astype(jnp.float32)).astype(x.dtype)


def causal_dwconv(u, buf, w, b):
    k = w.shape[0]
    full = jnp.concatenate([buf.astype(u.dtype), u], axis=1)
    y = lax.conv_general_dilated(full, w[:, None, :].astype(u.dtype), window_strides=(1,), padding='VALID',
                                 dimension_numbers=('NWC', 'WIO', 'NWC'), feature_group_count=u.shape[-1])
    return y + b.astype(u.dtype), full[:, -(k - 1):]


def _lin_combine(e1, e2):
    a1, b1 = e1
    a2, b2 = e2
    return a1 * a2, a2 * b1 + b2


def _cplx_combine(e1, e2):
    a1r, a1i, b1r, b1i = e1
    a2r, a2i, b2r, b2i = e2
    return (a2r * a1r - a2i * a1i, a2r * a1i + a2i * a1r,
            a2r * b1r - a2i * b1i + b2r, a2r * b1i + a2i * b1r + b2i)


def rg_lru(u, h0, w_rg, b_rg, w_ig, b_ig, lam_a):
    n, t, w = u.shape
    ub = u.reshape(n, t, N_BLOCKS_A, BLK_A)
    r = jax.nn.sigmoid(jnp.einsum('nthi,hij->nthj', ub, w_rg).reshape(n, t, w).astype(jnp.float32) + b_rg.astype(jnp.float32))
    ig = jax.nn.sigmoid(jnp.einsum('nthi,hij->nthj', ub, w_ig).reshape(n, t, w).astype(jnp.float32) + b_ig.astype(jnp.float32))
    log_a = -LRU_C * r * jax.nn.softplus(-lam_a.astype(jnp.float32))
    a = jnp.exp(log_a)
    bx = jnp.sqrt(-jnp.expm1(2.0 * log_a)) * ig * u.astype(jnp.float32)
    bx = bx.at[:, 0].add(a[:, 0] * h0.astype(jnp.float32))
    _, h = lax.associative_scan(_lin_combine, (a, bx), axis=1)
    return h.astype(u.dtype), h[:, -1]


def s5_ssm(u, s0_re, s0_im, lam_re, lam_im, log_dt, b_re, b_im, c_re, c_im, d_skip):
    n, t, w = u.shape
    uf = u.astype(jnp.float32)
    ug = uf.reshape(n, t, G_C, GS_C)
    dt = jnp.exp(log_dt.astype(jnp.float32))[:, None]
    lr, li = lam_re.astype(jnp.float32), lam_im.astype(jnp.float32)
    mag = jnp.exp(lr * dt)
    ar, ai = mag * jnp.cos(li * dt), mag * jnp.sin(li * dt)
    den = lr * lr + li * li
    qr = ((ar - 1.0) * lr + ai * li) / den
    qi = (ai * lr - (ar - 1.0) * li) / den
    br, bi = b_re.astype(jnp.float32), b_im.astype(jnp.float32)
    bbr = qr[..., None] * br - qi[..., None] * bi
    bbi = qr[..., None] * bi + qi[..., None] * br
    xr = jnp.einsum('ntgc,gpc->ntgp', ug, bbr)
    xi = jnp.einsum('ntgc,gpc->ntgp', ug, bbi)
    s0r, s0i = s0_re.astype(jnp.float32), s0_im.astype(jnp.float32)
    xr = xr.at[:, 0].add(ar * s0r - ai * s0i)
    xi = xi.at[:, 0].add(ar * s0i + ai * s0r)
    arb = jnp.broadcast_to(ar, xr.shape)
    aib = jnp.broadcast_to(ai, xi.shape)
    _, _, sr, si = lax.associative_scan(_cplx_combine, (arb, aib, xr, xi), axis=1)
    y = (jnp.einsum('ntgp,gcp->ntgc', sr, c_re.astype(jnp.float32))
         - jnp.einsum('ntgp,gcp->ntgc', si, c_im.astype(jnp.float32))).reshape(n, t, w)
    y = y + d_skip.astype(jnp.float32) * uf
    return y.astype(u.dtype), sr[:, -1], si[:, -1]


def layer(x, conv_a, h_a, conv_b, s_re, s_im,
          g_mix, w_in, w_conv_a, b_conv_a, w_rg, b_rg, w_ig, b_ig, lam_a,
          w_dw_b, b_dw_b, ln_g_b, ln_b_b,
          lam_re, lam_im, log_dt, b_ssm_re, b_ssm_im, c_ssm_re, c_ssm_im, d_ssm, w_glu_c, b_glu_c,
          b_gate, w_pa, w_pb, w_pc, w_out, g_ffn, w_ffn_in, w_ffn_out):
    h = rms_norm(x, g_mix)
    proj = jnp.einsum('ntd,de->nte', h, w_in)
    o1, o2, o3 = W_A, W_A + 2 * W_B, W_A + 2 * W_B + W_C
    u_a, z_b, u_c, gate_in = proj[..., :o1], proj[..., o1:o2], proj[..., o2:o3], proj[..., o3:]
    c_a, new_conv_a = causal_dwconv(u_a, conv_a, w_conv_a, b_conv_a)
    y_a, new_h = rg_lru(c_a, h_a, w_rg, b_rg, w_ig, b_ig, lam_a)
    glu_b = z_b[..., :W_B] * jax.nn.sigmoid(z_b[..., W_B:])
    c_b, new_conv_b = causal_dwconv(glu_b, conv_b, w_dw_b, b_dw_b)
    y_b = jax.nn.silu(layer_norm(c_b, ln_g_b, ln_b_b))
    y_c, new_s_re, new_s_im = s5_ssm(u_c, s_re, s_im, lam_re, lam_im, log_dt, b_ssm_re, b_ssm_im, c_ssm_re, c_ssm_im, d_ssm)
    y_c = jax.nn.gelu(y_c)
    y_c = y_c * jax.nn.sigmoid(jnp.einsum('ntc,ce->nte', y_c, w_glu_c) + b_glu_c)
    gates = jax.nn.sigmoid(gate_in + b_gate)
    g_a, g_b, g_c = gates[..., :D_MODEL], gates[..., D_MODEL:2 * D_MODEL], gates[..., 2 * D_MODEL:]
    merged = (g_a * jnp.einsum('ntc,cd->ntd', y_a, w_pa)
              + g_b * jnp.einsum('ntc,cd->ntd', y_b, w_pb)
              + g_c * jnp.einsum('ntc,cd->ntd', y_c, w_pc))
    x = x + jnp.einsum('ntd,de->nte', merged, w_out)
    h2 = rms_norm(x, g_ffn)
    gu = jnp.einsum('ntd,df->ntf', h2, w_ffn_in)
    x = x + jnp.einsum('ntf,fd->ntd', jax.nn.silu(gu[..., :D_FF]) * gu[..., D_FF:], w_ffn_out)
    return x, (new_conv_a, new_h.astype(x.dtype), new_conv_b, new_s_re.astype(x.dtype), new_s_im.astype(x.dtype))


def trunk(x, states, layer_params, g_final):
    outs = ([], [], [], [], [])
    for l in range(DEPTH):
        st = [s[l] for s in states]
        x, new = layer(x, *st, *[p[l] for p in layer_params])
        for o, v in zip(outs, new):
            o.append(v)
    stacked = [jnp.stack(o, axis=0) for o in outs]
    return rms_norm(x, g_final), stacked


def setup_inputs(seed: int = 0) -> dict:
    key = jax.random.key(seed)
    ks = iter(jax.random.split(key, 64))
    f32 = jnp.float32
    L = DEPTH

    def nrm(shape, s):
        return jax.random.normal(next(ks), shape, f32) * s

    u0 = jax.random.uniform(next(ks), (L, W_A), f32, minval=0.9, maxval=0.999)
    a_base = u0 ** (1.0 / LRU_C)
    lam_a = jnp.log(a_base) - jnp.log1p(-a_base)
    lam_im = jnp.broadcast_to(jnp.pi * jnp.arange(P_C, dtype=f32), (L, G_C, P_C)) + nrm((L, G_C, P_C), 0.01)
    log_dt = jax.random.uniform(next(ks), (L, G_C), f32, minval=math.log(0.001), maxval=math.log(0.1))
    return {
        'x_prompt': nrm((BATCH, SEQ, D_MODEL), 1.0),
        'x_sample': nrm((DEC_BATCH, DEC_SEQ, D_MODEL), 1.0),
        'state_lru_conv': nrm((L, DEC_BATCH, CONV_A - 1, W_A), 1.0),
        'state_lru_h': nrm((L, DEC_BATCH, W_A), 0.5),
        'state_cfm_conv': nrm((L, DEC_BATCH, CONV_B - 1, W_B), 1.0),
        'state_ssm_re': nrm((L, DEC_BATCH, G_C, P_C), 0.1),
        'state_ssm_im': nrm((L, DEC_BATCH, G_C, P_C), 0.1),
        'g_mix': 1.0 + nrm((L, D_MODEL), 0.02),
        'w_in': nrm((L, D_MODEL, IN_W), D_MODEL ** -0.5),
        'w_conv_a': nrm((L, CONV_A, W_A), CONV_A ** -0.5),
        'b_conv_a': nrm((L, W_A), 0.01),
        'w_rg': nrm((L, N_BLOCKS_A, BLK_A, BLK_A), BLK_A ** -0.5),
        'b_rg': nrm((L, W_A), 0.01),
        'w_ig': nrm((L, N_BLOCKS_A, BLK_A, BLK_A), BLK_A ** -0.5),
        'b_ig': nrm((L, W_A), 0.01),
        'lam_a': lam_a,
        'w_dw_b': nrm((L, CONV_B, W_B), CONV_B ** -0.5),
        'b_dw_b': nrm((L, W_B), 0.01),
        'ln_g_b': 1.0 + nrm((L, W_B), 0.02),
        'ln_b_b': nrm((L, W_B), 0.01),
        'lam_re': -0.5 + nrm((L, G_C, P_C), 0.01),
        'lam_im': lam_im,
        'log_dt': log_dt,
        'b_ssm_re': nrm((L, G_C, P_C, GS_C), (2.0 * GS_C) ** -0.5),
        'b_ssm_im': nrm((L, G_C, P_C, GS_C), (2.0 * GS_C) ** -0.5),
        'c_ssm_re': nrm((L, G_C, GS_C, P_C), P_C ** -0.5),
        'c_ssm_im': nrm((L, G_C, GS_C, P_C), P_C ** -0.5),
        'd_ssm': nrm((L, W_C), 1.0),
        'w_glu_c': nrm((L, W_C, W_C), W_C ** -0.5),
        'b_glu_c': nrm((L, W_C), 0.01),
        'b_gate': nrm((L, N_BRANCH * D_MODEL), 0.01),
        'w_pa': nrm((L, W_A, D_MODEL), W_A ** -0.5),
        'w_pb': nrm((L, W_B, D_MODEL), W_B ** -0.5),
        'w_pc': nrm((L, W_C, D_MODEL), W_C ** -0.5),
        'w_out': nrm((L, D_MODEL, D_MODEL), D_MODEL ** -0.5),
        'g_ffn': 1.0 + nrm((L, D_MODEL), 0.02),
        'w_ffn_in': nrm((L, D_MODEL, 2 * D_FF), D_MODEL ** -0.5),
        'w_ffn_out': nrm((L, D_FF, D_MODEL), D_FF ** -0.5),
        'g_final': 1.0 + nrm((D_MODEL,), 0.02),
    }


def reference(x_prompt, x_sample, state_lru_conv, state_lru_h, state_cfm_conv, state_ssm_re, state_ssm_im,
              g_mix, w_in, w_conv_a, b_conv_a, w_rg, b_rg, w_ig, b_ig, lam_a,
              w_dw_b, b_dw_b, ln_g_b, ln_b_b,
              lam_re, lam_im, log_dt, b_ssm_re, b_ssm_im, c_ssm_re, c_ssm_im, d_ssm, w_glu_c, b_glu_c,
              b_gate, w_pa, w_pb, w_pc, w_out, g_ffn, w_ffn_in, w_ffn_out, g_final):
    layer_params = (g_mix, w_in, w_conv_a, b_conv_a, w_rg, b_rg, w_ig, b_ig, lam_a,
                    w_dw_b, b_dw_b, ln_g_b, ln_b_b,
                    lam_re, lam_im, log_dt, b_ssm_re, b_ssm_im, c_ssm_re, c_ssm_im, d_ssm, w_glu_c, b_glu_c,
                    b_gate, w_pa, w_pb, w_pc, w_out, g_ffn, w_ffn_in, w_ffn_out)
    dt = x_prompt.dtype
    nb = x_prompt.shape[0]
    prompt_states = (jnp.zeros((DEPTH, nb, CONV_A - 1, W_A), dt),
                     jnp.zeros((DEPTH, nb, W_A), dt),
                     jnp.zeros((DEPTH, nb, CONV_B - 1, W_B), dt),
                     jnp.zeros((DEPTH, nb, G_C, P_C), dt),
                     jnp.zeros((DEPTH, nb, G_C, P_C), dt))
    y_prompt, p_new = trunk(x_prompt, prompt_states, layer_params, g_final)
    sample_states = (state_lru_conv, state_lru_h, state_cfm_conv, state_ssm_re, state_ssm_im)
    y_sample, s_new = trunk(x_sample, sample_states, layer_params, g_final)
    p_lru_conv, p_lru_h, p_cfm_conv, p_ssm_re, p_ssm_im = p_new
    s_lru_conv, s_lru_h, s_cfm_conv, s_ssm_re, s_ssm_im = s_new
    return (y_prompt, y_sample, p_lru_conv, p_lru_h, p_cfm_conv, p_ssm_re, p_ssm_im,
            s_lru_conv, s_lru_h, s_cfm_conv, s_ssm_re, s_ssm_im)
```

```cpp
#include <hip/hip_runtime.h>
#include <hip/hip_cooperative_groups.h>
#include <cstdio>
namespace cg = cooperative_groups;

#define LAS __attribute__((address_space(3)))
typedef unsigned short bf16_t;
typedef short bf16x8 __attribute__((ext_vector_type(8)));
typedef float f32x4 __attribute__((ext_vector_type(4)));
typedef unsigned u32x4 __attribute__((ext_vector_type(4)));
typedef unsigned u32x2 __attribute__((ext_vector_type(2)));

constexpr int D = 1024, SEQ = 2048, NBATCH = 8, MP = 16384, MS = 128, MT = MP + MS;
constexpr int INW = 5632, DFF = 2816, WB = 512, NG = 32, NPC = 64, NLAYER = 2;
constexpr int NCHK = 1024;
constexpr int KS5 = 384;
constexpr float EPS = 1e-6f;

constexpr size_t O_PLC = 16908288, O_PLH = 16957440, O_PCC = 16973824, O_PSR = 17219584, O_PSI = 17252352,
                 O_SLC = 17285120, O_SLH = 18071552, O_SCC = 18333696, O_SSR = 22265856, O_SSI = 22790144;

constexpr size_t SZ34 = (size_t)MT * 1024 * 2, SZ17 = (size_t)MT * 512 * 2;
constexpr size_t OFF_WIN = 0;
constexpr size_t OFF_WGT = OFF_WIN + (size_t)5632 * 1024 * 2;
constexpr size_t OFF_WGLU = OFF_WGT + (size_t)2048 * 256 * 2;
constexpr size_t OFF_WPA = OFF_WGLU + (size_t)512 * 512 * 2;
constexpr size_t OFF_WPB = OFF_WPA + (size_t)1024 * 1024 * 2;
constexpr size_t OFF_WPC = OFF_WPB + (size_t)1024 * 512 * 2;
constexpr size_t OFF_WOUT = OFF_WPC + (size_t)1024 * 512 * 2;
constexpr size_t OFF_WF1 = OFF_WOUT + (size_t)1024 * 1024 * 2;
constexpr size_t OFF_WF2 = OFF_WF1 + (size_t)5632 * 1024 * 2;
constexpr size_t OFF_TF = OFF_WF2 + (size_t)1024 * 2816 * 2;
constexpr size_t OFF_ET = OFF_TF + (size_t)32 * 256 * KS5 * 2;
constexpr size_t OFF_TAB = OFF_ET + (size_t)(32 * 128 + 128) * 256 * 2;
constexpr int TAB_LAM = 4096 + 4096 + 65536;
constexpr size_t OFF_RSQ = OFF_TAB + (size_t)(TAB_LAM + 1024) * 4;
constexpr size_t OFF_RSQ2 = OFF_RSQ + (size_t)MT * 16 * 4;
constexpr size_t OFF_XB = OFF_RSQ2 + (size_t)MT * 16 * 4;
constexpr size_t OFF_SA = OFF_XB + SZ34;
constexpr size_t OFF_SB = OFF_SA + SZ34;
constexpr size_t OFF_SC = OFF_SB + SZ34;
constexpr size_t OFF_UCG = OFF_SC + SZ34;
constexpr size_t OFF_UCS = OFF_UCG + (size_t)32 * 1024 * KS5 * 2;
constexpr size_t OFF_SE = OFF_UCS + (size_t)128 * 512 * 2;
constexpr size_t OFF_YB = OFF_SE + SZ17;
constexpr size_t OFF_SF = OFF_YB + SZ17;
constexpr size_t SZG8 = (((size_t)MT * 3072) + 255) & ~(size_t)255;
constexpr size_t OFF_GT8 = OFF_SB;
constexpr int G8_SPLIT = 11008;
static_assert((size_t)G8_SPLIT * 3072 == SZ34 && (size_t)(MT - G8_SPLIT) * 3072 <= (size_t)32 * 1024 * KS5 * 2, "gate array placement");
constexpr size_t OFF_MRG = OFF_SC;
constexpr size_t OFF_BAR = OFF_SF + SZ17;
constexpr size_t WS_END = OFF_BAR + 16384;
static_assert((size_t)32 * 1024 * 128 * 4 <= SZ17, "ends fits");
static_assert((size_t)MT * 2816 * 2 <= 3 * SZ34, "act fits");
static_assert(WS_END <= (size_t)256 * 1024 * 1024, "workspace");

constexpr int LDS_BYTES = 128 * 1024 + 1024;

struct KArgs { const float* in[39]; float* out; unsigned char* ws; };
typedef const __attribute__((address_space(4))) KArgs* KArgsP;
__device__ __forceinline__ KArgsP kargs() { auto p = __builtin_amdgcn_kernarg_segment_ptr(); asm volatile("" : "+s"(p)); return (KArgsP)p; }

__device__ __forceinline__ unsigned cvt_pk_bf16(float lo, float hi) { unsigned r; asm volatile("v_cvt_pk_bf16_f32 %0, %1, %2" : "=v"(r) : "v"(lo), "v"(hi)); return r; }
__device__ __forceinline__ bf16_t f2bf(float f) { return (bf16_t)(cvt_pk_bf16(f, 0.f) & 0xffffu); }
__device__ __forceinline__ float bf2f(unsigned b) { return __uint_as_float(b << 16); }
__device__ __forceinline__ void store8(bf16_t* p, const float* v) { u32x4 w; w.x = cvt_pk_bf16(v[0], v[1]); w.y = cvt_pk_bf16(v[2], v[3]); w.z = cvt_pk_bf16(v[4], v[5]); w.w = cvt_pk_bf16(v[6], v[7]); *(u32x4*)p = w; }
__device__ __forceinline__ void store4(bf16_t* p, const f32x4 v) { u32x2 w; w.x = cvt_pk_bf16(v[0], v[1]); w.y = cvt_pk_bf16(v[2], v[3]); *(u32x2*)p = w; }
__device__ __forceinline__ void unpack8(const u32x4 w, float* v) {
    v[0] = __uint_as_float(w.x << 16); v[1] = __uint_as_float(w.x & 0xffff0000u); v[2] = __uint_as_float(w.y << 16); v[3] = __uint_as_float(w.y & 0xffff0000u);
    v[4] = __uint_as_float(w.z << 16); v[5] = __uint_as_float(w.z & 0xffff0000u); v[6] = __uint_as_float(w.w << 16); v[7] = __uint_as_float(w.w & 0xffff0000u); }
__device__ __forceinline__ void load8(const bf16_t* p, float* v) { unpack8(*(const u32x4*)p, v); }
__device__ __forceinline__ size_t g8row(int row) { return (size_t)row * 3072 + (row >= G8_SPLIT ? SZ34 : (size_t)0); }
__device__ __forceinline__ float sigm(float x) { return __builtin_amdgcn_rcpf(1.0f + __expf(-x)); }
__device__ __forceinline__ float wave_sum(float v) { for (int o = 32; o >= 1; o >>= 1) v += __shfl_xor(v, o); return v; }

__device__ __forceinline__ int otid() { int t = threadIdx.x; asm volatile("" : "+v"(t)); return t; }
__device__ __forceinline__ int oblk() { int t = blockIdx.x; asm volatile("" : "+s"(t)); return t; }
constexpr int BM = 256, BK = 64, HALF = 128, HTB = HALF * BK * 2, NXCD = 8, WGM = 8;
__device__ __forceinline__ int lds_byte(int r, int c) { const int st = (r >> 4) * 2 + (c >> 5), rr = r & 15, cc = c & 31, ob = rr * 64 + cc * 2; return st * 1024 + (ob ^ (((ob >> 9) & 1) << 5)); }
__device__ __forceinline__ void stage_rc(int b, int& R, int& C) { const int st = b / 1024, sb = b % 1024, swz = sb ^ (((sb >> 9) & 1) << 5); R = (st >> 1) * 16 + swz / 64; C = (st & 1) * 32 + (swz % 64) / 2; }
__device__ __forceinline__ int perm32(int rho) { const int n = rho >> 4, i = rho & 15; return 8 * (i >> 2) + 4 * n + (i & 3); }

struct Unit { int pm, pn, g, sm, fin; const char* A; const char* B; };
struct Sched {
    int nM, nN, nGrp, G, c, bd; const char* A;     const char* B; size_t a_g, b_g, a_pm, b_pn; long L0 = 0, Lend = (1L << 40);
    __device__ __forceinline__ bool next(int i, Unit& u) const {
        const long L = L0 + (long)i * G + c; const int nwg = nM * nN; if (L >= (long)nwg * nGrp || L >= Lend) return false;
        const int g = (int)(L / nwg); int wgid = (int)(L % nwg);
        { const int q = nwg / NXCD, r = nwg % NXCD, xcd = wgid % NXCD, off = wgid / NXCD; wgid = (xcd < r ? xcd * (q + 1) : r * (q + 1) + (xcd - r) * q) + off; }
        const int nig = WGM * nN, gid = wgid / nig, fm = gid * WGM, gsz = (nM - fm) < WGM ? (nM - fm) : WGM;
        u.pm = fm + ((wgid % nig) % gsz); u.pn = (wgid % nig) / gsz; u.g = g; u.sm = 0; u.fin = 1;
        u.A = A + (size_t)g * a_g + (size_t)u.pm * a_pm + (bd ? (size_t)(u.pn >> 1) * 512 : 0); u.B = B + (size_t)g * b_g + (size_t)u.pn * b_pn; return true;
    }
};

struct SchedM3 {
    int G, c; const char* YA; const char* YB; const char* YC; const char* WPA; const char* WPB; const char* WPC;
    __device__ __forceinline__ bool next(int i, Unit& u) const {
        const int rnd = i / 3, seg = i - rnd * 3; int wgid = c + rnd * G; if (wgid >= 256) return false;
        { const int q = 256 / NXCD, xcd = wgid % NXCD, off = wgid / NXCD; wgid = xcd * q + off; }
        const int nig = WGM * 4, gid = wgid / nig, fm = gid * WGM;
        u.pm = fm + ((wgid % nig) % WGM); u.pn = (wgid % nig) / WGM; u.g = seg; u.sm = seg ? 1 : 0; u.fin = (seg == 2);
        const size_t pa = (size_t)u.pm * 256 * 2, pb = (size_t)u.pn * 256 * 2;
        if (seg == 0) { u.A = YA + pa * 1024; u.B = WPA + pb * 1024; }
        else if (seg == 1) { u.A = YB + pa * 512; u.B = WPB + pb * 512; }
        else { u.A = YC + pa * 512; u.B = WPC + pb * 512; }
        return true;
    }
};

template <class F, class SC, bool MIX>
__device__ __forceinline__ void gemm_phase_t(LAS unsigned char* lds, const int lda, const int ldb, const int nt_, const SC& S, const F& E) {
    const int tid = otid(), wid = __builtin_amdgcn_readfirstlane(tid >> 6), lane = tid & 63, wr = wid >> 2, wc = wid & 3, fr = lane & 15, fq = lane >> 4;
    unsigned voffA[2], voffB[2];
#pragma unroll
    for (int i = 0; i < 2; ++i) { int R, C; stage_rc(tid * 16 + i * 8192, R, C); const int Rb = (R & ~31) + perm32(R & 31);
        voffA[i] = (unsigned)(R * (MIX ? 512 : lda) + C) * 2u; voffB[i] = (unsigned)(Rb * (MIX ? 512 : ldb) + C) * 2u; }
    const size_t kstep = (size_t)(BK * 2);
    const size_t hA0 = (size_t)HALF * lda * 2, hB0 = (size_t)HALF * ldb * 2;
    const unsigned ldsw = (unsigned)wid * 1024u;
    const int aoff = lds_byte(wr * 64 + fr, fq * 8), boff = lds_byte(wc * 32 + fr, fq * 8);
#define PG8_SA(b, h) (((b) * 2 + (h)) * HTB)
#define PG8_SB(b, h) ((4 + (b) * 2 + (h)) * HTB)
#define PG8_STAGE(bufoff, gbase, voff, m2) do { _Pragma("unroll") for (int _i = 0; _i < 2; ++_i) \
        __builtin_amdgcn_global_load_lds((const unsigned*)((const char*)(gbase) + ((voff)[_i] + ((voff)[_i] & (m2)))), (LAS unsigned*)(lds + (bufoff) + ldsw + _i * 8192), 16, 0, 0); } while (0)
#define PG8_LDA(dst, b, h) do { _Pragma("unroll") for (int m = 0; m < 4; ++m) _Pragma("unroll") for (int k = 0; k < 2; ++k) dst[m][k] = *(const LAS bf16x8*)(lds + PG8_SA(b, h) + aoff + m * 2048 + k * 1024); } while (0)
#define PG8_LDB(dst, b, h) do { _Pragma("unroll") for (int n = 0; n < 2; ++n) _Pragma("unroll") for (int k = 0; k < 2; ++k) dst[n][k] = *(const LAS bf16x8*)(lds + PG8_SB(b, h) + boff + n * 2048 + k * 1024); } while (0)
#define PG8_MMA(ai, bj, At, Bt) do { __builtin_amdgcn_s_setprio(1); _Pragma("unroll") for (int m = 0; m < 4; ++m) _Pragma("unroll") for (int n = 0; n < 2; ++n) _Pragma("unroll") for (int k = 0; k < 2; ++k) \
        acc[ai][bj][m][n] = __builtin_amdgcn_mfma_f32_16x16x32_bf16(Bt[n][k], At[m][k], acc[ai][bj][m][n], 0, 0, 0); __builtin_amdgcn_s_setprio(0); } while (0)
#define PG8_WAIT_V(n) asm volatile("s_waitcnt vmcnt(" #n ")" ::: "memory")
#define PG8_WAIT_L(n) asm volatile("s_waitcnt lgkmcnt(" #n ")" ::: "memory")
#define PG8_BAR __builtin_amdgcn_s_barrier()
#define PG8_SCHED __builtin_amdgcn_sched_barrier(0)
    Unit cur, nxt; int ui = 0;
    if (!S.next(0, cur)) return;
    f32x4 acc[2][2][4][2];
    if constexpr (F::ACC_INIT) E.init(acc, cur.pm, cur.pn, wr, wc, fr, fq); else {
#pragma unroll
    for (int a = 0; a < 2; ++a)
#pragma unroll
        for (int b = 0; b < 2; ++b)
#pragma unroll
            for (int m = 0; m < 4; ++m)
#pragma unroll
                for (int n = 0; n < 2; ++n) acc[a][b][m][n] = (f32x4){0.f, 0.f, 0.f, 0.f};
    }
    bf16x8 At[4][2], B0[2][2], B1[2][2];
    const char* cA = cur.A; const char* cB = cur.B;
    unsigned cm = (MIX && !cur.sm) ? ~1023u : 0u; size_t hA = MIX ? (cur.sm ? (size_t)131072 : (size_t)262144) : hA0, hB = MIX ? hA : hB0; int nt = MIX ? (cur.sm ? 8 : 16) : nt_;
    PG8_STAGE(PG8_SB(0, 0), cB, voffB, cm); PG8_STAGE(PG8_SA(0, 0), cA, voffA, cm); PG8_STAGE(PG8_SB(0, 1), cB + hB, voffB, cm); PG8_STAGE(PG8_SA(0, 1), cA + hA, voffA, cm);
    if (wr == 1) PG8_BAR;
    PG8_WAIT_V(4); PG8_BAR;
    PG8_STAGE(PG8_SB(1, 0), cB + kstep, voffB, cm); PG8_STAGE(PG8_SA(1, 0), cA + kstep, voffA, cm); PG8_STAGE(PG8_SB(1, 1), cB + hB + kstep, voffB, cm);
    PG8_WAIT_V(6); PG8_BAR;
    for (;;) {
        const bool has_next = S.next(ui + 1, nxt);
        const char* nA = has_next ? nxt.A : cA; const char* nB = has_next ? nxt.B : cB;
        const unsigned nm = (MIX && has_next) ? (nxt.sm ? 0u : ~1023u) : cm;
        const size_t nhA = (MIX && has_next) ? (nxt.sm ? (size_t)131072 : (size_t)262144) : hA, nhB = MIX ? nhA : hB;
#pragma unroll 1
        for (int t = 0; t < nt; t += 2) {
            const bool last = (t == nt - 2);
            const char* a1 = cA + (size_t)(t + 1) * kstep;
            const char* a2 = last ? nA : cA + (size_t)(t + 2) * kstep; const char* b2 = last ? nB : cB + (size_t)(t + 2) * kstep;
            const char* a3 = a2 + kstep; const char* b3 = b2 + kstep;
            const unsigned m2 = (MIX && last) ? nm : cm; const size_t h2A = (MIX && last) ? nhA : hA, h2B = (MIX && last) ? nhB : hB;
            PG8_LDB(B0, 0, 0); PG8_SCHED; PG8_LDA(At, 0, 0); PG8_STAGE(PG8_SA(1, 1), a1 + hA, voffA, cm);
            PG8_WAIT_L(8); PG8_BAR; PG8_WAIT_L(0); PG8_MMA(0, 0, At, B0); PG8_BAR; PG8_SCHED;
            PG8_LDB(B1, 0, 1); PG8_STAGE(PG8_SB(0, 0), b2, voffB, m2);
            PG8_BAR; PG8_WAIT_L(0); PG8_MMA(0, 1, At, B1); PG8_BAR;
            PG8_LDA(At, 0, 1); PG8_STAGE(PG8_SA(0, 0), a2, voffA, m2);
            PG8_BAR; PG8_WAIT_L(0); PG8_MMA(1, 0, At, B0); PG8_BAR; PG8_SCHED;
            PG8_STAGE(PG8_SB(0, 1), b2 + h2B, voffB, m2);
            PG8_WAIT_V(6); PG8_BAR; PG8_MMA(1, 1, At, B1); PG8_BAR;
            PG8_LDB(B0, 1, 0); PG8_SCHED; PG8_LDA(At, 1, 0); PG8_STAGE(PG8_SA(0, 1), a2 + h2A, voffA, m2);
            PG8_WAIT_L(8); PG8_BAR; PG8_WAIT_L(0); PG8_MMA(0, 0, At, B0); PG8_BAR; PG8_SCHED;
            PG8_LDB(B1, 1, 1); PG8_STAGE(PG8_SB(1, 0), b3, voffB, m2);
            PG8_BAR; PG8_WAIT_L(0); PG8_MMA(0, 1, At, B1); PG8_BAR;
            PG8_LDA(At, 1, 1); PG8_STAGE(PG8_SA(1, 0), a3, voffA, m2);
            PG8_BAR; PG8_WAIT_L(0); PG8_MMA(1, 0, At, B0); PG8_BAR; PG8_SCHED;
            PG8_STAGE(PG8_SB(1, 1), b3 + h2B, voffB, m2);
            PG8_WAIT_V(6); PG8_BAR; PG8_MMA(1, 1, At, B1); PG8_BAR;
        }
        {
            int row0 = cur.pm * BM + wr * 64 + fr; asm volatile("" : "+v"(row0));
            const typename F::UCtx uc = E.unit_ctx(cur.pn, wc, fq, cur.g);
            typename F::Pre pre = E.row_pre(row0, fq, cur.pn, wc, cur.g);
#pragma unroll
            for (int rg = 0; rg < 8; ++rg) { const int ai = rg >> 2, m = rg & 3;
                int row = cur.pm * BM + ai * HALF + wr * 64 + m * 16 + fr;
                asm volatile("" : "+v"(row));
                typename F::Pre pre_n = pre;
                if (rg < 7) { int rown = cur.pm * BM + ((rg + 1) >> 2) * HALF + wr * 64 + ((rg + 1) & 3) * 16 + fr; asm volatile("" : "+v"(rown)); pre_n = E.row_pre(rown, fq, cur.pn, wc, cur.g); }
                asm volatile("" ::: "memory");
                typename F::State st; E.row_begin(st, pre);
#pragma unroll
                for (int n = 0; n < 2; ++n) { E.op(st, uc, row, cur.pn, cur.g, wc * 32 + 8 * fq + 4 * n, acc[ai][0][m][n], acc[ai][1][m][n]); }
                E.row_end(st, row, cur.pn, wc);
                pre = pre_n;
            }
        }
        if (!has_next) break;
        if constexpr (F::ACC_INIT) E.init(acc, nxt.pm, nxt.pn, wr, wc, fr, fq); else if (!MIX || cur.fin) {
#pragma unroll
        for (int a = 0; a < 2; ++a)
#pragma unroll
            for (int b = 0; b < 2; ++b)
#pragma unroll
                for (int m = 0; m < 4; ++m)
#pragma unroll
                    for (int n = 0; n < 2; ++n) acc[a][b][m][n] = (f32x4){0.f, 0.f, 0.f, 0.f};
        }
        cur = nxt; cA = nA; cB = nB; ++ui;
        if (MIX) { cm = nm; hA = nhA; hB = nhB; nt = cur.sm ? 8 : 16; }
    }
    PG8_WAIT_V(0);
    if (wr == 0) PG8_BAR;
    PG8_BAR;
#undef PG8_SA
#undef PG8_SB
#undef PG8_STAGE
#undef PG8_LDA
#undef PG8_LDB
#undef PG8_MMA
#undef PG8_WAIT_V
#undef PG8_WAIT_L
#undef PG8_BAR
#undef PG8_SCHED
}

template <class F>
__device__ __forceinline__ void gemm_phase(LAS unsigned char* lds, const int lda, const int ldb, const int nt, const Sched& S, const F& E) { gemm_phase_t<F, Sched, false>(lds, lda, ldb, nt, S, E); }

template <class F>
__device__ __forceinline__ void thin_gemm(LAS unsigned char* lds, const bf16_t* A, const int lda, const bf16_t* Bt, const int ldb, const int K, const int nN, const int bd, const F& E, const int bi, const int nb) {
    const int tid = otid(), wid = tid >> 6, lane = tid & 63, fr = lane & 15, fq = lane >> 4;
    LAS f32x4* red = (LAS f32x4*)lds;
    const int nitems = 8 * nN * 4, kw = K >> 3;
    if (bi >= 0) for (int item = bi; item < nitems; item += nb) {
        const int rg = item & 7, wc = (item >> 3) & 3, pn = item >> 5;
        const bf16_t* ap = A + (size_t)(MP + 16 * rg + fr) * lda + (bd ? (pn >> 1) * 256 : 0) + wid * kw + 8 * fq;
        const bf16_t* bp[4];
#pragma unroll
        for (int n = 0; n < 4; ++n) bp[n] = Bt + (size_t)(256 * pn + 128 * (n >> 1) + 32 * wc + 8 * (fr >> 2) + 4 * (n & 1) + (fr & 3)) * ldb + wid * kw + 8 * fq;
        f32x4 acc[4];
#pragma unroll
        for (int n = 0; n < 4; ++n) acc[n] = (f32x4){0.f, 0.f, 0.f, 0.f};
        for (int kb = 0; kb < kw; kb += 128) {
            bf16x8 av[4], bv[4][4];
#pragma unroll
            for (int i = 0; i < 4; ++i) if (kb + 32 * i < kw) { av[i] = *(const bf16x8*)(ap + kb + 32 * i);
#pragma unroll
                for (int n = 0; n < 4; ++n) bv[i][n] = *(const bf16x8*)(bp[n] + kb + 32 * i); }
#pragma unroll
            for (int i = 0; i < 4; ++i) if (kb + 32 * i < kw) {
#pragma unroll
                for (int n = 0; n < 4; ++n) acc[n] = __builtin_amdgcn_mfma_f32_16x16x32_bf16(bv[i][n], av[i], acc[n], 0, 0, 0); }
        }
#pragma unroll
        for (int n = 0; n < 4; ++n) red[(wid * 4 + n) * 64 + lane] = acc[n];
        __syncthreads();
        if (wid == 0) {
            f32x4 sv[4];
#pragma unroll
            for (int n = 0; n < 4; ++n) { f32x4 s = red[n * 64 + lane];
#pragma unroll
                for (int w = 1; w < 8; ++w) s += red[(w * 4 + n) * 64 + lane];
                sv[n] = s; }
            const int row = MP + 16 * rg + fr; typename F::State st; E.row_begin(st, E.row_pre(row, fq, pn, wc, 0));
            const typename F::UCtx uc = E.unit_ctx(pn, wc, fq, 0);
#pragma unroll
            for (int n = 0; n < 2; ++n) E.op(st, uc, row, pn, 0, wc * 32 + 8 * fq + 4 * n, sv[n], sv[2 + n]);
            E.row_end(st, row, pn, wc);
        }
        __syncthreads();
    }
}

__device__ __forceinline__ void thin_merge(LAS unsigned char* lds, const bf16_t* YA, const bf16_t* YB, const bf16_t* YC, const bf16_t* WPA, const bf16_t* WPB, const bf16_t* WPC,
                                           const unsigned char* g8, bf16_t* mrg, const int bi, const int nb) {
    const int tid = otid(), wid = tid >> 6, lane = tid & 63, fr = lane & 15, fq = lane >> 4;
    LAS f32x4* red = (LAS f32x4*)lds;
    for (int item = bi; item < 8 * 4 * 4; item += nb) {
        const int rg = item & 7, wc = (item >> 3) & 3, pn = item >> 5, row = MP + 16 * rg + fr;
        int brow[4];
#pragma unroll
        for (int n = 0; n < 4; ++n) brow[n] = 256 * pn + 128 * (n >> 1) + 32 * wc + 8 * (fr >> 2) + 4 * (n & 1) + (fr & 3);
        f32x4 tot[4];
#pragma unroll
        for (int n = 0; n < 4; ++n) tot[n] = (f32x4){0.f, 0.f, 0.f, 0.f};
#pragma unroll
        for (int seg = 0; seg < 3; ++seg) {
            const bf16_t* A = seg == 0 ? YA : (seg == 1 ? YB : YC); const bf16_t* B = seg == 0 ? WPA : (seg == 1 ? WPB : WPC);
            const int K = seg == 0 ? 1024 : 512, kw = K >> 3, nst = kw >> 5;
            bf16x8 av[4], bv[4][4]; unsigned gw[4];
#pragma unroll
            for (int i = 0; i < 4; ++i) if (i < nst) { av[i] = *(const bf16x8*)(A + (size_t)row * K + wid * kw + 32 * i + 8 * fq);
#pragma unroll
                for (int n = 0; n < 4; ++n) bv[i][n] = *(const bf16x8*)(B + (size_t)brow[n] * K + wid * kw + 32 * i + 8 * fq); }
#pragma unroll
            for (int n = 0; n < 4; ++n) gw[n] = *(const unsigned*)(g8 + g8row(row) + seg * 1024 + 256 * pn + 128 * (n >> 1) + 32 * wc + 8 * fq + 4 * (n & 1));
            f32x4 acc[4];
#pragma unroll
            for (int n = 0; n < 4; ++n) acc[n] = (f32x4){0.f, 0.f, 0.f, 0.f};
#pragma unroll
            for (int i = 0; i < 4; ++i) if (i < nst) {
#pragma unroll
                for (int n = 0; n < 4; ++n) acc[n] = __builtin_amdgcn_mfma_f32_16x16x32_bf16(bv[i][n], av[i], acc[n], 0, 0, 0); }
#pragma unroll
            for (int n = 0; n < 4; ++n) tot[n] += acc[n] * ((f32x4){(float)(gw[n] & 255u), (float)((gw[n] >> 8) & 255u), (float)((gw[n] >> 16) & 255u), (float)(gw[n] >> 24)} * (1.0f / 255.0f));
        }
#pragma unroll
        for (int n = 0; n < 4; ++n) red[(wid * 4 + n) * 64 + lane] = tot[n];
        __syncthreads();
        if (wid == 0) {
#pragma unroll
            for (int n = 0; n < 4; ++n) { f32x4 sv = red[n * 64 + lane];
#pragma unroll
                for (int w = 1; w < 8; ++w) sv += red[(w * 4 + n) * 64 + lane];
                store4(mrg + (size_t)row * 1024 + 256 * pn + 128 * (n >> 1) + 32 * wc + 8 * fq + 4 * (n & 1), sv); }
        }
        __syncthreads();
    }
}

__device__ __forceinline__ f32x4 load4(const bf16_t* p) { const u32x2 w = *(const u32x2*)p; return (f32x4){__uint_as_float(w.x << 16), __uint_as_float(w.x & 0xffff0000u), __uint_as_float(w.y << 16), __uint_as_float(w.y & 0xffff0000u)}; }
__device__ __forceinline__ f32x4 sigm4(const f32x4 x) { return (f32x4){sigm(x[0]), sigm(x[1]), sigm(x[2]), sigm(x[3])}; }
__device__ __forceinline__ float row_rs4(const float* rsq, int row, int fq) {
    const f32x4 a = *(const f32x4*)(rsq + (size_t)row * 16 + fq * 4); float s = (a[0] + a[1]) + (a[2] + a[3]);
    s += __shfl_xor(s, 16); s += __shfl_xor(s, 32); return rsqrtf(s * (1.0f / 1024.0f) + EPS);
}
__device__ __forceinline__ float rs_from4(const f32x4 a) { float s = (a[0] + a[1]) + (a[2] + a[3]); s += __shfl_xor(s, 16); s += __shfl_xor(s, 32); return rsqrtf(s * (1.0f / 1024.0f) + EPS); }
__device__ __forceinline__ float row_rs(const float* rsq, int row) {
    const f32x4* p = (const f32x4*)(rsq + (size_t)row * 16); const f32x4 a = p[0], b = p[1], c = p[2], d = p[3];
    const float s = ((a[0] + a[1]) + (a[2] + a[3])) + ((b[0] + b[1]) + (b[2] + b[3])) + ((c[0] + c[1]) + (c[2] + c[3])) + ((d[0] + d[1]) + (d[2] + d[3]));
    return rsqrtf(s * (1.0f / 1024.0f) + EPS);
}
struct StNone { };
struct StF { float x; };
struct F1 {
    typedef StF State;
    static constexpr bool ACC_INIT = false;
    typedef StNone UCtx;
    __device__ __forceinline__ UCtx unit_ctx(int, int, int, int) const { return UCtx(); }
    const float* rsq; bf16_t* ua; bf16_t* glu; bf16_t* ucg; bf16_t* ucs;
    typedef f32x4 Pre;
    __device__ __forceinline__ Pre row_pre(int row, int fq, int, int, int) const { return *(const f32x4*)(rsq + (size_t)row * 16 + fq * 4); }
    __device__ __forceinline__ void row_begin(State& st, const Pre& p) const { st.x = rs_from4(p); }
    __device__ __forceinline__ void row_end(State&, int, int, int) const {}
    __device__ __forceinline__ void op(State& st, const UCtx& uc, int row, int pn, int, int lc, f32x4& a, f32x4& b) const {
        if (row >= MT) return;
        const f32x4 va = a * st.x, vb = b * st.x;
        if (pn < 4) { bf16_t* p = ua + (size_t)row * 1024 + pn * 256 + lc; store4(p, va); store4(p + 128, vb); }
        else if (pn < 8) store4(glu + (size_t)row * 512 + (pn - 4) * 128 + lc, va * sigm4(vb));
        else {
#pragma unroll
            for (int h = 0; h < 2; ++h) { const int cc = (pn - 8) * 256 + lc + 128 * h; bf16_t* dst;
                if (row < MP) dst = ucg + ((size_t)(cc >> 4) * NCHK + (row >> 4)) * KS5 + (row & 15) * 16 + (cc & 15);
                else dst = ucs + (size_t)(row - MP) * 512 + cc;
                store4(dst, h ? vb : va); }
        }
    }
};
struct StU4 { u32x4 v; };
struct F2 {
    typedef StU4 State; typedef StU4 Pre;
    static constexpr bool ACC_INIT = false;
    struct UCtx { f32x4 brg[2], big[2], lm[2]; };
    __device__ __forceinline__ UCtx unit_ctx(int pn, int wc, int fq, int) const { UCtx u; const int ch = pn * 128 + wc * 32 + 8 * fq;
#pragma unroll
        for (int n = 0; n < 2; ++n) { u.brg[n] = *(const f32x4*)(b_rg + ch + 4 * n); u.big[n] = *(const f32x4*)(b_ig + ch + 4 * n); u.lm[n] = *(const f32x4*)(lam + ch + 4 * n); }
        return u; }
    const bf16_t* ca; const float* b_rg; const float* b_ig; const float* lam; const float* h0; bf16_t* la; bf16_t* bx; float* out_h;
    __device__ __forceinline__ Pre row_pre(int row, int fq, int pn, int wc, int) const { Pre p; p.v = *(const u32x4*)(ca + (size_t)row * 1024 + pn * 128 + wc * 32 + 8 * fq); return p; }
    __device__ __forceinline__ void row_begin(State& st, const Pre& p) const { st = p; }
    __device__ __forceinline__ void row_end(State&, int, int, int) const {}
    __device__ __forceinline__ void op(State& st, const UCtx& uc, int row, int pn, int, int lc, f32x4& a, f32x4& b) const {
        const int ch0 = pn * 128 + lc, n = (lc >> 2) & 1; const unsigned w0 = n ? st.v.z : st.v.x, w1 = n ? st.v.w : st.v.y;
        const f32x4 c4 = (f32x4){__uint_as_float(w0 << 16), __uint_as_float(w0 & 0xffff0000u), __uint_as_float(w1 << 16), __uint_as_float(w1 & 0xffff0000u)};
        const f32x4 r = sigm4(a + uc.brg[n]), ig = sigm4(b + uc.big[n]), l_a = r * uc.lm[n];
        f32x4 bxv;
#pragma unroll
        for (int j = 0; j < 4; ++j) bxv[j] = __builtin_amdgcn_sqrtf(fmaxf(1.0f - __expf(2.0f * l_a[j]), 0.f)) * ig[j] * c4[j];
        if (row < MP) { store4(la + (size_t)row * 1024 + ch0, l_a); store4(bx + (size_t)row * 1024 + ch0, bxv); }
        else { const size_t o = (size_t)(row - MP) * 1024 + ch0; const f32x4 hp = *(const f32x4*)(h0 + o); f32x4 h;
#pragma unroll
            for (int j = 0; j < 4; ++j) h[j] = __expf(l_a[j]) * hp[j] + bxv[j];
            *(f32x4*)(out_h + o) = h; store4(la + (size_t)row * 1024 + ch0, h); }
    }
};
struct FEnd {
    typedef StNone State;
    static constexpr bool ACC_INIT = false;
    typedef StNone UCtx;
    __device__ __forceinline__ UCtx unit_ctx(int, int, int, int) const { return UCtx(); }
    float* ends;
    typedef StNone Pre;
    __device__ __forceinline__ Pre row_pre(int, int, int, int, int) const { return Pre(); }
    __device__ __forceinline__ void row_begin(State&, const Pre&) const {}
    __device__ __forceinline__ void row_end(State&, int, int, int) const {}
    __device__ __forceinline__ void op(State&, const UCtx& uc, int row, int, int g, int lc, f32x4& a, f32x4&) const { *(f32x4*)(ends + ((size_t)g * NCHK + row) * 128 + lc) = a; }
};
__device__ __forceinline__ float gelu_tanh(float x) { const float u = 0.7978845608028654f * (x + 0.044715f * x * x * x); return x * sigm(2.0f * u); }
struct StU8 { u32x2 v[4]; };
struct FS5 {
    typedef StU8 State; typedef StU8 Pre;
    static constexpr bool ACC_INIT = false;
    struct UCtx { f32x4 d[2]; };
    __device__ __forceinline__ UCtx unit_ctx(int, int, int fq, int g) const { UCtx u; u.d[0] = *(const f32x4*)(dsk + g * 16 + ((8 * fq) & 15)); u.d[1] = *(const f32x4*)(dsk + g * 16 + ((8 * fq + 4) & 15)); return u; }
    const bf16_t* ucg; const float* dsk; bf16_t* yc0;
    __device__ __forceinline__ Pre row_pre(int row, int fq, int, int wc, int g) const { Pre p; const bf16_t* base = ucg + ((size_t)g * NCHK + row) * KS5 + wc * 32 + 8 * fq;
#pragma unroll
        for (int n = 0; n < 2; ++n)
#pragma unroll
            for (int h = 0; h < 2; ++h) p.v[n * 2 + h] = *(const u32x2*)(base + 128 * h + 4 * n);
        return p; }
    __device__ __forceinline__ void row_begin(State& st, const Pre& p) const { st = p; }
    __device__ __forceinline__ void row_end(State&, int, int, int) const {}
    __device__ __forceinline__ void op(State& st, const UCtx& uc, int row, int, int g, int lc, f32x4& a, f32x4& b) const {
        const int n = (lc >> 2) & 1;
#pragma unroll
        for (int h = 0; h < 2; ++h) { const int col = lc + 128 * h, i = col >> 4, c0 = col & 15; const u32x2 w = st.v[n * 2 + h];
            const f32x4 u4 = (f32x4){__uint_as_float(w.x << 16), __uint_as_float(w.x & 0xffff0000u), __uint_as_float(w.y << 16), __uint_as_float(w.y & 0xffff0000u)};
            const f32x4 y = (h ? b : a) + uc.d[n] * u4;
            store4(yc0 + (size_t)(row * 16 + i) * 512 + g * 16 + c0, (f32x4){gelu_tanh(y[0]), gelu_tanh(y[1]), gelu_tanh(y[2]), gelu_tanh(y[3])}); }
    }
};
struct F4 {
    typedef StU8 State; typedef StU8 Pre;
    static constexpr bool ACC_INIT = false;
    struct UCtx { f32x4 b[2][2]; };
    __device__ __forceinline__ UCtx unit_ctx(int pn, int wc, int fq, int) const { UCtx u; const float* p = bg + pn * 256 + wc * 32 + 8 * fq;
#pragma unroll
        for (int n = 0; n < 2; ++n)
#pragma unroll
            for (int h = 0; h < 2; ++h) u.b[n][h] = *(const f32x4*)(p + 128 * h + 4 * n);
        return u; }
    const bf16_t* yc0; const float* bg; bf16_t* yc;
    __device__ __forceinline__ Pre row_pre(int row, int fq, int pn, int wc, int) const { Pre p; const bf16_t* base = yc0 + (size_t)row * 512 + pn * 256 + wc * 32 + 8 * fq;
#pragma unroll
        for (int n = 0; n < 2; ++n)
#pragma unroll
            for (int h = 0; h < 2; ++h) p.v[n * 2 + h] = *(const u32x2*)(base + 128 * h + 4 * n);
        return p; }
    __device__ __forceinline__ void row_begin(State& st, const Pre& p) const { st = p; }
    __device__ __forceinline__ void row_end(State&, int, int, int) const {}
    __device__ __forceinline__ void op(State& st, const UCtx& uc, int row, int pn, int, int lc, f32x4& a, f32x4& b) const {
        const int n = (lc >> 2) & 1;
#pragma unroll
        for (int h = 0; h < 2; ++h) { const int col = pn * 256 + lc + 128 * h; const u32x2 w = st.v[n * 2 + h];
            const f32x4 y4 = (f32x4){__uint_as_float(w.x << 16), __uint_as_float(w.x & 0xffff0000u), __uint_as_float(w.y << 16), __uint_as_float(w.y & 0xffff0000u)};
            store4(yc + (size_t)row * 512 + col, y4 * sigm4((h ? b : a) + uc.b[n][h])); }
    }
};
struct FG8 {
    typedef StF State;
    static constexpr bool ACC_INIT = false;
    struct UCtx { f32x4 b[2][2]; };
    __device__ __forceinline__ UCtx unit_ctx(int pn, int wc, int fq, int) const { UCtx u; const float* p = bgate + pn * 256 + wc * 32 + 8 * fq;
#pragma unroll
        for (int n = 0; n < 2; ++n)
#pragma unroll
            for (int h = 0; h < 2; ++h) u.b[n][h] = *(const f32x4*)(p + 128 * h + 4 * n);
        return u; }
    const float* rsq; const float* bgate; unsigned char* g8;
    typedef f32x4 Pre;
    __device__ __forceinline__ Pre row_pre(int row, int fq, int, int, int) const { return *(const f32x4*)(rsq + (size_t)row * 16 + fq * 4); }
    __device__ __forceinline__ void row_begin(State& st, const Pre& p) const { st.x = rs_from4(p); }
    __device__ __forceinline__ void row_end(State&, int, int, int) const {}
    __device__ __forceinline__ void op(State& st, const UCtx& uc, int row, int pn, int, int lc, f32x4& a, f32x4& b) const {
#pragma unroll
        for (int h = 0; h < 2; ++h) { const int col = pn * 256 + lc + 128 * h; f32x4 g = sigm4((h ? b : a) * st.x + uc.b[(lc >> 2) & 1][h]) * 255.0f + 0.5f; g = __builtin_elementwise_max(g, (f32x4){1.f, 1.f, 1.f, 1.f});
            *(unsigned*)(g8 + g8row(row) + col) = (unsigned)g[0] | ((unsigned)g[1] << 8) | ((unsigned)g[2] << 16) | ((unsigned)g[3] << 24); }
    }
};
struct StG { unsigned w[8]; };
struct FMS {
    typedef StG State; typedef StG Pre;
    static constexpr bool ACC_INIT = false;
    typedef StNone UCtx;
    __device__ __forceinline__ UCtx unit_ctx(int, int, int, int) const { return UCtx(); }
    const unsigned char* g8; bf16_t* mrg;
    __device__ __forceinline__ Pre row_pre(int row, int fq, int pn, int wc, int seg) const { Pre p; const unsigned char* base = g8 + g8row(row) + seg * 1024 + pn * 256 + wc * 32 + 8 * fq;
#pragma unroll
        for (int n = 0; n < 2; ++n)
#pragma unroll
            for (int h = 0; h < 2; ++h) { p.w[(n * 2 + h) * 2] = *(const unsigned*)(base + 128 * h + 4 * n); p.w[(n * 2 + h) * 2 + 1] = (seg < 2) ? *(const unsigned*)(base + 1024 + 128 * h + 4 * n) : 0x01010101u; }
        return p; }
    __device__ __forceinline__ void row_begin(State& st, const Pre& p) const { st = p; }
    __device__ __forceinline__ void row_end(State&, int, int, int) const {}
    __device__ __forceinline__ void op(State& st, const UCtx& uc, int row, int pn, int seg, int lc, f32x4& a, f32x4& b) const {
        const int n = (lc >> 2) & 1;
#pragma unroll
        for (int h = 0; h < 2; ++h) { const unsigned gn = st.w[(n * 2 + h) * 2], gd = st.w[(n * 2 + h) * 2 + 1]; f32x4& v = h ? b : a;
            const f32x4 num = (f32x4){(float)(gn & 255u), (float)((gn >> 8) & 255u), (float)((gn >> 16) & 255u), (float)(gn >> 24)};
            if (seg < 2) { const f32x4 den = (f32x4){(float)(gd & 255u), (float)((gd >> 8) & 255u), (float)((gd >> 16) & 255u), (float)(gd >> 24)};
                v = v * num * (f32x4){__builtin_amdgcn_rcpf(den[0]), __builtin_amdgcn_rcpf(den[1]), __builtin_amdgcn_rcpf(den[2]), __builtin_amdgcn_rcpf(den[3])}; }
            else store4(mrg + (size_t)row * 1024 + pn * 256 + lc + 128 * h, v * num * (1.0f / 255.0f)); }
    }
};
template <bool RES> struct F6T {
    typedef StF State;
    static constexpr bool ACC_INIT = !RES;
    typedef StNone UCtx;
    __device__ __forceinline__ UCtx unit_ctx(int, int, int, int) const { return UCtx(); }
    const float* xs_p; const float* xs_s; float* xd; bf16_t* xb; float* rsq;
    typedef StNone Pre;
    __device__ __forceinline__ Pre row_pre(int, int, int, int, int) const { return Pre(); }
    __device__ __forceinline__ void row_begin(State& st, const Pre&) const { st.x = 0.f; }
    __device__ __forceinline__ void row_end(State& st, int row, int pn, int wc) const {
        float ss = st.x; ss += __shfl_xor(ss, 16); ss += __shfl_xor(ss, 32);
        if ((__lane_id()) < 16) rsq[(size_t)row * 16 + pn * 4 + wc] = ss; }
    __device__ __forceinline__ void init(f32x4 (&acc)[2][2][4][2], int pm, int pn, int wr, int wc, int fr, int fq) const {
#pragma unroll
        for (int ai = 0; ai < 2; ++ai)
#pragma unroll
            for (int m = 0; m < 4; ++m) { const int row = pm * BM + ai * HALF + wr * 64 + m * 16 + fr;
                const float* src = ((row < MP) ? xs_p + (size_t)row * 1024 : xs_s + (size_t)(row - MP) * 1024) + pn * 256 + wc * 32 + 8 * fq;
#pragma unroll
                for (int bj = 0; bj < 2; ++bj)
#pragma unroll
                    for (int n = 0; n < 2; ++n) acc[ai][bj][m][n] = *(const f32x4*)(src + 128 * bj + 4 * n); }
    }
    __device__ __forceinline__ void op(State& st, const UCtx& uc, int row, int pn, int, int lc, f32x4& a, f32x4& b) const {
        const float* src = (row < MP) ? xs_p + (size_t)row * 1024 : xs_s + (size_t)(row - MP) * 1024;
#pragma unroll
        for (int h = 0; h < 2; ++h) { const int col = pn * 256 + lc + 128 * h; f32x4 v = (h ? b : a); if (RES) v += *(const f32x4*)(src + col);
            st.x += (v[0] * v[0] + v[1] * v[1]) + (v[2] * v[2] + v[3] * v[3]);
            *(f32x4*)(xd + (size_t)row * 1024 + col) = v; store4(xb + (size_t)row * 1024 + col, v); }
    }
};
struct F7 {
    typedef StF State;
    static constexpr bool ACC_INIT = false;
    typedef StNone UCtx;
    __device__ __forceinline__ UCtx unit_ctx(int, int, int, int) const { return UCtx(); }
    const float* rsq; bf16_t* act;
    typedef f32x4 Pre;
    __device__ __forceinline__ Pre row_pre(int row, int fq, int, int, int) const { return *(const f32x4*)(rsq + (size_t)row * 16 + fq * 4); }
    __device__ __forceinline__ void row_begin(State& st, const Pre& p) const { st.x = rs_from4(p); }
    __device__ __forceinline__ void row_end(State&, int, int, int) const {}
    __device__ __forceinline__ void op(State& st, const UCtx& uc, int row, int pn, int, int lc, f32x4& a, f32x4& b) const {
        if (row >= MT) return;
        const f32x4 gte = a * st.x, up = b * st.x; store4(act + (size_t)row * DFF + pn * 128 + lc, gte * sigm4(gte) * up);
    }
};

template <int MODE> __device__ __forceinline__ int srccol(int n) {
    if (MODE == 1) { if (n >= 1024 && n < 2048) { const int q = (n - 1024) >> 8, r = (n - 1024) & 255; return r < 128 ? 1024 + 128 * q + r : 1536 + 128 * q + (r - 128); } return n; }
    if (MODE == 2) { const int t = n >> 8, r = n & 255; return r < 128 ? 128 * t + r : DFF + 128 * t + (r - 128); }
    return n;
}
template <int MODE>
__device__ __forceinline__ int conv_T(LAS float* tile, const float* src, int ldsrc, const float* scale, bf16_t* dst, int ldd, int N, int K, int nb, int bi, int base) {
    const int tid = otid(), ntn = N >> 8, ntiles = ntn * (K >> 6);
    int t = bi - (base % nb); if (t < 0) t += nb;
    const int q = tid & 63, kr = tid >> 6; f32x4 v[8]; float sc8[8];
#define CT_LOAD(tt) do { const int n0_ = ((tt) % ntn) << 8, k0_ = ((tt) / ntn) << 6, sc_ = srccol<MODE>(n0_ + 4 * q); \
        _Pragma("unroll") for (int i = 0; i < 8; ++i) { v[i] = *(const f32x4*)(src + (size_t)(k0_ + i * 8 + kr) * ldsrc + sc_); sc8[i] = scale ? scale[k0_ + i * 8 + kr] : 1.0f; } } while (0)
    if (t < ntiles) CT_LOAD(t);
    for (; t < ntiles; t += nb) {
        const int n0 = (t % ntn) << 8, k0 = (t / ntn) << 6;
#pragma unroll
        for (int i = 0; i < 8; ++i) *(LAS f32x4*)(tile + (i * 8 + kr) * 260 + 4 * q) = v[i] * sc8[i];
        __syncthreads();
        if (t + nb < ntiles) CT_LOAD(t + nb);
        { const int n = tid >> 1, kh = tid & 1;
#pragma unroll
          for (int j4 = 0; j4 < 4; ++j4) { float w[8];
#pragma unroll
              for (int j = 0; j < 8; ++j) w[j] = tile[(kh * 32 + j4 * 8 + j) * 260 + n];
              store8(dst + (size_t)(n0 + n) * ldd + k0 + kh * 32 + j4 * 8, w); } }
        __syncthreads();
    }
#undef CT_LOAD
    return base + ntiles;
}

__device__ __forceinline__ void s5_build(KArgsP a, int l, int g, LAS unsigned char* lds, const int part, const int nparts) {
    const int tid = otid();
    LAS float* apr = (LAS float*)lds; LAS float* api = apr + 17 * 64; LAS float* bbr = api + 17 * 64; LAS float* bbi = bbr + 1024;
    LAS float* ccr = bbi + 1024; LAS float* cci = ccr + 1024; LAS float* kk = cci + 1024;
    const float* lam_re = a->in[20] + (size_t)(l * 32 + g) * 64; const float* lam_im = a->in[21] + (size_t)(l * 32 + g) * 64;
    const float dt = expf(a->in[22][l * 32 + g]);
    bf16_t* TF = (bf16_t*)(a->ws + OFF_TF); bf16_t* ET = (bf16_t*)(a->ws + OFF_ET); float* TAB = (float*)(a->ws + OFF_TAB);
    for (int idx = tid; idx < 17 * 64; idx += 512) { const int d = idx >> 6, p = idx & 63; const float lr = lam_re[p], li = lam_im[p];
        const float mag = expf((float)d * lr * dt);
        double x = (double)d * (double)li * (double)dt; x -= 6.283185307179586 * rint(x * 0.15915494309189535); const float xr = (float)x;
        apr[idx] = mag * cosf(xr); api[idx] = mag * sinf(xr); }
    __syncthreads();
    for (int idx = tid; idx < 1024; idx += 512) { const int p = idx >> 4; const float lr = lam_re[p], li = lam_im[p], ar = apr[64 + p], ai = api[64 + p], den = lr * lr + li * li;
        const float qr = ((ar - 1.0f) * lr + ai * li) / den, qi = (ai * lr - (ar - 1.0f) * li) / den;
        const float br = a->in[23][(size_t)(l * 32 + g) * 1024 + idx], bi = a->in[24][(size_t)(l * 32 + g) * 1024 + idx];
        bbr[idx] = qr * br - qi * bi; bbi[idx] = qr * bi + qi * br;
        ccr[idx] = a->in[25][(size_t)(l * 32 + g) * 1024 + idx]; cci[idx] = a->in[26][(size_t)(l * 32 + g) * 1024 + idx]; }
    __syncthreads();
    if (part == 0 && tid < 64) { TAB[(g * 64 + tid) * 2] = apr[64 + tid]; TAB[(g * 64 + tid) * 2 + 1] = api[64 + tid]; TAB[4096 + (g * 64 + tid) * 2] = apr[16 * 64 + tid]; TAB[4096 + (g * 64 + tid) * 2 + 1] = api[16 * 64 + tid]; }
    if (part == 0) for (int idx = tid; idx < 1024; idx += 512) { TAB[8192 + ((size_t)g * 1024 + idx) * 2] = bbr[idx]; TAB[8192 + ((size_t)g * 1024 + idx) * 2 + 1] = bbi[idx]; }
    for (int idx = tid; idx < 4096; idx += 512) { const int d = idx >> 8, c = (idx >> 4) & 15, c2 = idx & 15; float s = 0.f;
        for (int p = 0; p < 64; ++p) { const float Pr = apr[d * 64 + p], Pi = api[d * 64 + p], Br = bbr[p * 16 + c2], Bi = bbi[p * 16 + c2];
            const float Wr = Pr * Br - Pi * Bi, Wi = Pr * Bi + Pi * Br; s += ccr[c * 64 + p] * Wr - cci[c * 64 + p] * Wi; }
        kk[idx] = s; }
    __syncthreads();
    const int tfn = 256 / nparts, etn = 128 / nparts;
    for (int idx = part * tfn * KS5 + tid; idx < (part + 1) * tfn * KS5; idx += 512) { const int n = idx / KS5, k = idx % KS5, i = n >> 4, c = n & 15; float v;
        if (k < 256) { const int j = k >> 4, c2 = k & 15; v = (i >= j) ? kk[(i - j) * 256 + c * 16 + c2] : 0.f; }
        else if (k < 320) { const int p = k - 256; v = ccr[c * 64 + p] * apr[(i + 1) * 64 + p] - cci[c * 64 + p] * api[(i + 1) * 64 + p]; }
        else { const int p = k - 320; v = -(ccr[c * 64 + p] * api[(i + 1) * 64 + p] + cci[c * 64 + p] * apr[(i + 1) * 64 + p]); }
        TF[((size_t)g * 256 + n) * KS5 + k] = f2bf(v); }
    for (int idx = part * etn * 256 + tid; idx < (part + 1) * etn * 256; idx += 512) { const int n = idx >> 8, k = idx & 255, p = n & 63, j = k >> 4, c2 = k & 15, d = 15 - j;
        const float Pr = apr[d * 64 + p], Pi = api[d * 64 + p], Br = bbr[p * 16 + c2], Bi = bbi[p * 16 + c2];
        ET[((size_t)g * 128 + n) * 256 + k] = f2bf(n < 64 ? (Pr * Br - Pi * Bi) : (Pr * Bi + Pi * Br)); }
    if (g == 31 && part == 0) for (int idx = tid; idx < 128 * 256; idx += 512) ET[(size_t)32 * 128 * 256 + idx] = 0;
    __syncthreads();
}

__device__ __forceinline__ void phase0(KArgsP a, int l, LAS unsigned char* lds) {
    const int tid = otid(), blk = blockIdx.x, nblk = gridDim.x;
    LAS float* tile = (LAS float*)lds; unsigned char* ws = a->ws;
    const int nsb = (nblk >= 256) ? 128 : 0, nb = nblk - nsb;
    if (blk < nb) { int base = 0;
        base = conv_T<1>(tile, a->in[8] + (size_t)l * 1024 * INW, INW, a->in[7] + l * 1024, (bf16_t*)(ws + OFF_WIN), 1024, INW, 1024, nb, blk, base);
        base = conv_T<2>(tile, a->in[36] + (size_t)l * 1024 * INW, INW, a->in[35] + l * 1024, (bf16_t*)(ws + OFF_WF1), 1024, INW, 1024, nb, blk, base);
        base = conv_T<0>(tile, a->in[37] + (size_t)l * DFF * 1024, 1024, nullptr, (bf16_t*)(ws + OFF_WF2), DFF, 1024, DFF, nb, blk, base);
        base = conv_T<0>(tile, a->in[31] + (size_t)l * 1024 * 1024, 1024, nullptr, (bf16_t*)(ws + OFF_WPA), 1024, 1024, 1024, nb, blk, base);
        base = conv_T<0>(tile, a->in[34] + (size_t)l * 1024 * 1024, 1024, nullptr, (bf16_t*)(ws + OFF_WOUT), 1024, 1024, 1024, nb, blk, base);
        base = conv_T<0>(tile, a->in[32] + (size_t)l * 512 * 1024, 1024, nullptr, (bf16_t*)(ws + OFF_WPB), 512, 1024, 512, nb, blk, base);
        base = conv_T<0>(tile, a->in[33] + (size_t)l * 512 * 1024, 1024, nullptr, (bf16_t*)(ws + OFF_WPC), 512, 1024, 512, nb, blk, base);
        base = conv_T<0>(tile, a->in[28] + (size_t)l * 512 * 512, 512, nullptr, (bf16_t*)(ws + OFF_WGLU), 512, 512, 512, nb, blk, base);
    }
    { bf16_t* wgt = (bf16_t*)(ws + OFF_WGT); const float* wrg = a->in[11] + (size_t)l * 8 * 128 * 128; const float* wig = a->in[13] + (size_t)l * 8 * 128 * 128;
      for (int idx = blk * 512 + tid; idx < 2048 * 256; idx += nblk * 512) { const int n = idx >> 8, k = idx & 255, h = n >> 8, s = (n >> 7) & 1, j = n & 127; float v = 0.f;
          if ((k >> 7) == (h & 1)) v = (s ? wig : wrg)[((size_t)h * 128 + (k & 127)) * 128 + j];
          wgt[idx] = f2bf(v); } }
    { float* TAB = (float*)(ws + OFF_TAB); for (int idx = blk * 512 + tid; idx < 1024; idx += nblk * 512) TAB[TAB_LAM + idx] = -8.0f * log1pf(expf(-a->in[15][l * 1024 + idx])); }
    if (nsb) { if (blk >= nb) s5_build(a, l, (blk - nb) >> 2, lds, (blk - nb) & 3, 4); } else { for (int g = blk; g < 32; g += nblk) s5_build(a, l, g, lds, 0, 1); }
    if (l == 0) {
        bf16_t* xb = (bf16_t*)(ws + OFF_XB); float* rsq = (float*)(ws + OFF_RSQ); const int wv = tid >> 6, lane = tid & 63;
        f32x4 vn[4]; const int rstep = nblk * 8; int row = blk * 8 + wv;
        if (row < MT) { const float* src = (row < MP) ? a->in[0] + (size_t)row * 1024 : a->in[1] + (size_t)(row - MP) * 1024;
#pragma unroll
            for (int i = 0; i < 4; ++i) vn[i] = *(const f32x4*)(src + i * 256 + lane * 4); }
        for (; row < MT; row += rstep) { f32x4 vc[4]; float ss = 0.f;
#pragma unroll
            for (int i = 0; i < 4; ++i) vc[i] = vn[i];
            if (row + rstep < MT) { const int rn = row + rstep; const float* src = (rn < MP) ? a->in[0] + (size_t)rn * 1024 : a->in[1] + (size_t)(rn - MP) * 1024;
#pragma unroll
                for (int i = 0; i < 4; ++i) vn[i] = *(const f32x4*)(src + i * 256 + lane * 4); }
#pragma unroll
            for (int i = 0; i < 4; ++i) { const f32x4 v = vc[i]; ss += v[0] * v[0] + v[1] * v[1] + v[2] * v[2] + v[3] * v[3];
                u32x2 w; w.x = cvt_pk_bf16(v[0], v[1]); w.y = cvt_pk_bf16(v[2], v[3]); *(u32x2*)(xb + (size_t)row * 1024 + i * 256 + lane * 4) = w; }
            ss = wave_sum(ss); if (lane < 16) rsq[(size_t)row * 16 + lane] = (lane == 0) ? ss : 0.f; }
    }
}

__device__ __forceinline__ void conv_a_phase(KArgsP a, int l) {
    const bf16_t* ua = (const bf16_t*)(a->ws + OFF_SA); bf16_t* ca = (bf16_t*)(a->ws + OFF_SB);
    const float* w = a->in[9] + (size_t)l * 4 * 1024; const float* bias = a->in[10] + (size_t)l * 1024;
    const int tid = otid();
    const int c8 = (tid & 127) * 8;
    float wv[4][8], bv[8];
#pragma unroll
    for (int k = 0; k < 4; ++k) { const f32x4 p = *(const f32x4*)(w + k * 1024 + c8), q = *(const f32x4*)(w + k * 1024 + c8 + 4);
#pragma unroll
        for (int j = 0; j < 4; ++j) { wv[k][j] = p[j]; wv[k][4 + j] = q[j]; } }
    { const f32x4 p = *(const f32x4*)(bias + c8), q = *(const f32x4*)(bias + c8 + 4);
#pragma unroll
      for (int j = 0; j < 4; ++j) { bv[j] = p[j]; bv[4 + j] = q[j]; } }
    const int step = gridDim.x * 512; int idx = blockIdx.x * 512 + tid;
    u32x4 xv[4];
    if (idx < MT * 128) { const int row = idx >> 7;
#pragma unroll
        for (int k = 0; k < 4; ++k) { const int rr = row - 3 + k; xv[k] = *(const u32x4*)(ua + (size_t)(rr < 0 ? 0 : rr) * 1024 + c8); } }
    for (; idx < MT * 128; idx += step) {
        const int row = idx >> 7; float acc[8], x[8]; u32x4 xc[4];
#pragma unroll
        for (int k = 0; k < 4; ++k) xc[k] = xv[k];
        if (idx + step < MT * 128) { const int rown = (idx + step) >> 7;
#pragma unroll
            for (int k = 0; k < 4; ++k) { const int rr = rown - 3 + k; xv[k] = *(const u32x4*)(ua + (size_t)(rr < 0 ? 0 : rr) * 1024 + c8); } }
#pragma unroll
        for (int j = 0; j < 8; ++j) acc[j] = bv[j];
        unpack8(xc[3], x);
        if (row < MP) { const int t = row & (SEQ - 1), b = row >> 11;
#pragma unroll
            for (int k = 0; k < 4; ++k) { if (t - 3 + k >= 0) { float xk[8]; unpack8(xc[k], xk);
#pragma unroll
                for (int j = 0; j < 8; ++j) acc[j] += wv[k][j] * xk[j]; } }
            if (t >= SEQ - 3) { float* o = a->out + O_PLC + (((size_t)l * NBATCH + b) * 3 + (t - (SEQ - 3))) * 1024 + c8;
#pragma unroll
                for (int j = 0; j < 8; ++j) o[j] = x[j]; }
        } else { const int s = row - MP; const float* st = a->in[2] + ((size_t)l * MS + s) * 3 * 1024 + c8; float* o = a->out + O_SLC + ((size_t)l * MS + s) * 3 * 1024 + c8;
#pragma unroll
            for (int j = 0; j < 8; ++j) { const float s0 = st[j], s1 = st[1024 + j], s2 = st[2048 + j];
                acc[j] += wv[0][j] * s0 + wv[1][j] * s1 + wv[2][j] * s2 + wv[3][j] * x[j]; o[j] = s1; o[1024 + j] = s2; o[2048 + j] = x[j]; }
        }
        store8(ca + (size_t)row * 1024 + c8, acc);
    }
}

__device__ __forceinline__ void cfm_phase(KArgsP a, int l, LAS unsigned char* lds) {
    const int tid = otid(), half = tid >> 8, cp = tid & 255, wv = tid >> 6, lane = tid & 63;
    const bf16_t* glu = (const bf16_t*)(a->ws + OFF_SE); bf16_t* yb = (bf16_t*)(a->ws + OFF_YB);
    LAS unsigned* in = (LAS unsigned*)lds;
    LAS float* part = (LAS float*)(lds + 62 * 1024);
    const float* wdw = a->in[16] + (size_t)l * 31 * 512 + 2 * cp;
    typedef float f32x2 __attribute__((ext_vector_type(2)));
    LAS f32x2* wl = (LAS f32x2*)(lds + 65536);
    for (int idx = tid; idx < 31 * 256; idx += 512) { const f32x2 wk = *(const f32x2*)(a->in[16] + (size_t)l * 31 * 512 + 2 * idx);
        u32x2 pk; pk.x = cvt_pk_bf16(wk.x, 0.f); pk.y = cvt_pk_bf16(0.f, wk.y); ((LAS u32x2*)wl)[idx] = pk; }
    const float bs0 = a->in[17][l * 512 + 2 * cp], bs1 = a->in[17][l * 512 + 2 * cp + 1];
    const float lg0 = a->in[18][l * 512 + 2 * cp], lg1 = a->in[18][l * 512 + 2 * cp + 1], lb0 = a->in[19][l * 512 + 2 * cp], lb1 = a->in[19][l * 512 + 2 * cp + 1];
    u32x4 pv[8];
#define CFM_LOAD(tl) do { const int b_ = (tl) >> 6, t0_ = ((tl) & 63) * 32; \
        _Pragma("unroll") for (int i = 0; i < 8; ++i) { const int idx = tid + 512 * i, r = idx >> 6, c16 = idx & 63, t = t0_ - 30 + r; pv[i] = (u32x4){0u, 0u, 0u, 0u}; \
            if (idx < 62 * 64 && t >= 0) pv[i] = *(const u32x4*)(glu + ((size_t)b_ * SEQ + t) * 512 + c16 * 8); } } while (0)
    if ((int)blockIdx.x < 512) CFM_LOAD((int)blockIdx.x);
    const int ntl = (gridDim.x == 256) ? 768 : 512 + 64;
    for (int tile0 = blockIdx.x; tile0 < ntl; tile0 += gridDim.x) {
        int tile = tile0;
        if (gridDim.x == 256 && tile0 >= 512) { tile = 512 + (((int)blockIdx.x + 64) & 255); if (tile >= 512 + 64) continue; }
        if (tile < 512) {
            const int b = tile >> 6, t0 = (tile & 63) * 32;
#pragma unroll
            for (int i = 0; i < 8; ++i) { const int idx = tid + 512 * i; if (idx < 62 * 64) *(LAS u32x4*)(in + (idx >> 6) * 256 + (idx & 63) * 4) = pv[i]; }
            if (tile + (int)gridDim.x < 512) CFM_LOAD(tile + (int)gridDim.x);
            __syncthreads();
            float val0[16], val1[16];
#pragma unroll
            for (int j = 0; j < 16; ++j) { val0[j] = bs0; val1[j] = bs1; }
#pragma unroll 1
            for (int k = 0; k < 31; ++k) { const u32x2 wk = ((const LAS u32x2*)wl)[k * 256 + cp]; const LAS unsigned* ip = in + (half * 16 + k) * 256 + cp;
#pragma unroll
                for (int j = 0; j < 16; ++j) { const unsigned xw = ip[j * 256];
                    asm("v_dot2c_f32_bf16 %0, %1, %2" : "+v"(val0[j]) : "v"(xw), "v"(wk.x));
                    asm("v_dot2c_f32_bf16 %0, %1, %2" : "+v"(val1[j]) : "v"(xw), "v"(wk.y)); } }
#pragma unroll
            for (int ti = 0; ti < 16; ++ti) { float s = val0[ti] + val1[ti], q = val0[ti] * val0[ti] + val1[ti] * val1[ti]; s = wave_sum(s); q = wave_sum(q);
                if (lane == 0) { part[((half * 16 + ti) * 4 + (wv & 3)) * 2] = s; part[((half * 16 + ti) * 4 + (wv & 3)) * 2 + 1] = q; } }
            if (t0 + 32 == SEQ) {
                float* o = a->out + O_PCC + ((size_t)l * NBATCH + b) * 30 * 512;
                for (int idx = tid; idx < 30 * 256; idx += 512) { const int r = idx >> 8, c = idx & 255; const unsigned xw = in[(32 + r) * 256 + c]; o[r * 512 + 2 * c] = __uint_as_float(xw << 16); o[r * 512 + 2 * c + 1] = __uint_as_float(xw & 0xffff0000u); } }
            __syncthreads();
#pragma unroll
            for (int ti = 0; ti < 16; ++ti) { const LAS float* pp = part + (half * 16 + ti) * 8; const float S = (pp[0] + pp[2]) + (pp[4] + pp[6]), Q = (pp[1] + pp[3]) + (pp[5] + pp[7]);
                const float mean = S * (1.0f / 512.0f), var = fmaxf(Q * (1.0f / 512.0f) - mean * mean, 0.f), rstd = rsqrtf(var + EPS);
                float y0 = (val0[ti] - mean) * rstd * lg0 + lb0, y1 = (val1[ti] - mean) * rstd * lg1 + lb1; y0 *= sigm(y0); y1 *= sigm(y1);
                *(unsigned*)(yb + ((size_t)b * SEQ + t0 + half * 16 + ti) * 512 + 2 * cp) = cvt_pk_bf16(y0, y1); }
            __syncthreads();
        } else {
            const int s = (tile - 512) * 2 + half; const float* st = a->in[4] + ((size_t)l * MS + s) * 30 * 512 + 2 * cp; float* o = a->out + O_SCC + ((size_t)l * MS + s) * 30 * 512 + 2 * cp;
            float a0 = bs0, a1 = bs1;
#pragma unroll 2
            for (int k = 0; k < 30; ++k) { const float x0 = st[k * 512], x1 = st[k * 512 + 1]; a0 += wdw[k * 512] * x0; a1 += wdw[k * 512 + 1] * x1; if (k >= 1) { o[(k - 1) * 512] = x0; o[(k - 1) * 512 + 1] = x1; } }
            { const unsigned xw = *(const unsigned*)(glu + (size_t)(MP + s) * 512 + 2 * cp); const float x0 = __uint_as_float(xw << 16), x1 = __uint_as_float(xw & 0xffff0000u);
              a0 += wdw[30 * 512] * x0; a1 += wdw[30 * 512 + 1] * x1; o[29 * 512] = x0; o[29 * 512 + 1] = x1; }
            float sm = wave_sum(a0 + a1), q = wave_sum(a0 * a0 + a1 * a1);
            if (lane == 0) { part[(half * 4 + (wv & 3)) * 2] = sm; part[(half * 4 + (wv & 3)) * 2 + 1] = q; }
            __syncthreads();
            { const LAS float* pp = part + half * 8; const float S = (pp[0] + pp[2]) + (pp[4] + pp[6]), Q = (pp[1] + pp[3]) + (pp[5] + pp[7]);
              const float mean = S * (1.0f / 512.0f), var = fmaxf(Q * (1.0f / 512.0f) - mean * mean, 0.f), rstd = rsqrtf(var + EPS);
              float y0 = (a0 - mean) * rstd * lg0 + lb0, y1 = (a1 - mean) * rstd * lg1 + lb1; y0 *= sigm(y0); y1 *= sigm(y1);
              *(unsigned*)(yb + (size_t)(MP + s) * 512 + 2 * cp) = cvt_pk_bf16(y0, y1); }
            __syncthreads();
        }
    }
}

#undef CFM_LOAD
__device__ __forceinline__ void s5_sample(KArgsP a, int l) {
    const int tid = otid(); const int wv = tid >> 6, p = tid & 63; const float* TAB = (const float*)(a->ws + OFF_TAB);
    const bf16_t* ucs = (const bf16_t*)(a->ws + OFF_UCS); bf16_t* yc0 = (bf16_t*)(a->ws + OFF_SE);
    for (int w = blockIdx.x * 8 + wv; w < MS * 32; w += gridDim.x * 8) { const int s = w >> 5, g = w & 31;
        float u[16]; load8(ucs + (size_t)s * 512 + g * 16, u); load8(ucs + (size_t)s * 512 + g * 16 + 8, u + 8);
        const float ar = TAB[(g * 64 + p) * 2], ai = TAB[(g * 64 + p) * 2 + 1]; const float* bb = TAB + 8192 + ((size_t)g * 1024 + p * 16) * 2;
        const size_t si = (((size_t)l * MS + s) * 32 + g) * 64 + p; const float s0r = a->in[5][si], s0i = a->in[6][si];
        float xr = ar * s0r - ai * s0i, xi = ar * s0i + ai * s0r;
#pragma unroll
        for (int c = 0; c < 16; ++c) { xr += bb[2 * c] * u[c]; xi += bb[2 * c + 1] * u[c]; }
        a->out[O_SSR + si] = xr; a->out[O_SSI + si] = xi;
        const float* cr = a->in[25] + (size_t)(l * 32 + g) * 1024; const float* ci = a->in[26] + (size_t)(l * 32 + g) * 1024; float mine = 0.f;
#pragma unroll
        for (int c = 0; c < 16; ++c) { const float t = wave_sum(cr[c * 64 + p] * xr - ci[c * 64 + p] * xi); if (p == c) mine = t; }
        float up = 0.f;
#pragma unroll
        for (int c = 0; c < 16; ++c) up = (p == c) ? u[c] : up;
        if (p < 16) yc0[(size_t)(MP + s) * 512 + g * 16 + p] = f2bf(gelu_tanh(mine + a->in[27][l * 512 + g * 16 + p] * up));
    }
}

__device__ __forceinline__ void s5_carry_bg(KArgsP a, int l, LAS unsigned char* lds, const int b, const int g) {
    const int tid = otid(), seg = tid >> 6, p = tid & 63; const float* TAB = (const float*)(a->ws + OFF_TAB);
    const float* ends = (const float*)(a->ws + OFF_SF); bf16_t* ucg = (bf16_t*)(a->ws + OFF_UCG); LAS float* sT = (LAS float*)lds;
    {
        const float ar = TAB[4096 + (g * 64 + p) * 2], ai = TAB[4096 + (g * 64 + p) * 2 + 1];
        const size_t c0 = (size_t)g * NCHK + b * 128 + seg * 16; float er[16], ei[16];
#pragma unroll
        for (int k = 0; k < 16; ++k) { er[k] = ends[(c0 + k) * 128 + p]; ei[k] = ends[(c0 + k) * 128 + 64 + p]; }
        float Lr[17], Li[17]; Lr[0] = 0.f; Li[0] = 0.f;
#pragma unroll
        for (int k = 0; k < 16; ++k) { Lr[k + 1] = ar * Lr[k] - ai * Li[k] + er[k]; Li[k + 1] = ar * Li[k] + ai * Lr[k] + ei[k]; }
        sT[(seg * 64 + p) * 2] = Lr[16]; sT[(seg * 64 + p) * 2 + 1] = Li[16];
        __syncthreads();
        float br = ar, bi = ai;
#pragma unroll
        for (int i = 0; i < 4; ++i) { const float t = br * br - bi * bi; bi = 2.f * br * bi; br = t; }
        float Sr = 0.f, Si = 0.f;
        for (int s2 = 0; s2 < seg; ++s2) { const float tr = sT[(s2 * 64 + p) * 2], ti = sT[(s2 * 64 + p) * 2 + 1]; const float nr = br * Sr - bi * Si + tr; Si = br * Si + bi * Sr + ti; Sr = nr; }
        float pr = 1.f, pi = 0.f;
#pragma unroll
        for (int k = 0; k < 16; ++k) { const float vr = Lr[k] + pr * Sr - pi * Si, vi = Li[k] + pr * Si + pi * Sr;
            ucg[(c0 + k) * KS5 + 256 + p] = f2bf(vr); ucg[(c0 + k) * KS5 + 320 + p] = f2bf(vi);
            const float t = pr * ar - pi * ai; pi = pr * ai + pi * ar; pr = t; }
        if (seg == 7) { const size_t o = (((size_t)l * NBATCH + b) * 32 + g) * 64 + p; a->out[O_PSR + o] = Lr[16] + br * Sr - bi * Si; a->out[O_PSI + o] = Li[16] + br * Si + bi * Sr; }
        __syncthreads();
    }
}
__device__ __forceinline__ void s5_carry(KArgsP a, int l, LAS unsigned char* lds) { for (int w = blockIdx.x; w < NBATCH * 32; w += gridDim.x) s5_carry_bg(a, l, lds, w >> 5, w & 31); }

__device__ __forceinline__ void lru_scan(KArgsP a, int l, LAS unsigned char* lds, bf16_t* dst_alt) {
    const int tid = otid(), cq = tid & 7, chunk = tid >> 3;
    bf16_t* la = (bf16_t*)(a->ws + OFF_SA); const bf16_t* bx = (const bf16_t*)(a->ws + OFF_SC);
    LAS f32x4* sP = (LAS f32x4*)lds; LAS f32x4* sH = sP + 64 * 8;
    for (int w = blockIdx.x; w < NBATCH * 32; w += gridDim.x) { const int b = w >> 5, cg_ = w & 31;
        const size_t base = ((size_t)b * SEQ + chunk * 32) * 1024 + cg_ * 32 + cq * 4;
        f32x4 P = (f32x4){1.f, 1.f, 1.f, 1.f}, h = (f32x4){0.f, 0.f, 0.f, 0.f};
        u32x2 lw[32], bw[32];
#pragma unroll
        for (int j = 0; j < 32; ++j) { lw[j] = *(const u32x2*)(la + base + (size_t)j * 1024); bw[j] = *(const u32x2*)(bx + base + (size_t)j * 1024); }
#pragma unroll
        for (int j = 0; j < 32; ++j) { const f32x4 av = (f32x4){__expf(bf2f(lw[j].x & 0xffffu)), __expf(bf2f(lw[j].x >> 16)), __expf(bf2f(lw[j].y & 0xffffu)), __expf(bf2f(lw[j].y >> 16))};
            const f32x4 bv = (f32x4){bf2f(bw[j].x & 0xffffu), bf2f(bw[j].x >> 16), bf2f(bw[j].y & 0xffffu), bf2f(bw[j].y >> 16)};
            h = av * h + bv; P = P * av; }
        sP[chunk * 8 + cq] = P; sH[chunk * 8 + cq] = h;
        __syncthreads();
        f32x4 cin = (f32x4){0.f, 0.f, 0.f, 0.f};
        for (int c2 = 0; c2 < chunk; ++c2) cin = sP[c2 * 8 + cq] * cin + sH[c2 * 8 + cq];
        h = cin;
#pragma unroll
        for (int j = 0; j < 32; ++j) { asm volatile("" : "+v"(lw[j].x), "+v"(lw[j].y), "+v"(bw[j].x), "+v"(bw[j].y));
            const f32x4 av = (f32x4){__expf(bf2f(lw[j].x & 0xffffu)), __expf(bf2f(lw[j].x >> 16)), __expf(bf2f(lw[j].y & 0xffffu)), __expf(bf2f(lw[j].y >> 16))};
            const f32x4 bv = (f32x4){bf2f(bw[j].x & 0xffffu), bf2f(bw[j].x >> 16), bf2f(bw[j].y & 0xffffu), bf2f(bw[j].y >> 16)};
            h = av * h + bv; u32x2 o; o.x = cvt_pk_bf16(h[0], h[1]); o.y = cvt_pk_bf16(h[2], h[3]); *(u32x2*)(dst_alt + base + (size_t)j * 1024) = o; }
        if (chunk == 63) *(f32x4*)(a->out + O_PLH + ((size_t)l * NBATCH + b) * 1024 + cg_ * 32 + cq * 4) = h;
        __syncthreads();
    }
}


#define XB_TMO      128
#define XB_XCNT(j)  (256  + 64 * (j))
#define XB_XSUB(j)  (1280 + 64 * (j))
#define XB_XGEN(j)  (2304 + 64 * (j))
#define XB_TOP      3328
#define XB_TOPGEN   3392
#define XCD_BAR_WORDS 3456
#define XB_SPIN_CAP (1u << 18)
__device__ __forceinline__ unsigned xb_ld(unsigned* p)              { return __hip_atomic_load(p, __ATOMIC_RELAXED, __HIP_MEMORY_SCOPE_AGENT); }
__device__ __forceinline__ unsigned xb_add(unsigned* p, unsigned v) { return __hip_atomic_fetch_add(p, v, __ATOMIC_RELAXED, __HIP_MEMORY_SCOPE_AGENT); }
__device__ __forceinline__ unsigned xb_xcc_id() { return (unsigned)__builtin_amdgcn_s_getreg((3 << 11) | 20) & 0xFu; }
#define XB_SPIN(cond, bar) do { unsigned _sp = 0; while (cond) { __builtin_amdgcn_s_sleep(1); \
    if ((++_sp & 255u) == 0u) { if (xb_ld(&(bar)[XB_TMO])) break; if (_sp > XB_SPIN_CAP) { atomicAdd(&(bar)[XB_TMO], 1u); break; } } } } while (0)
__device__ __forceinline__ void xcd_barrier_complete(unsigned* bar, unsigned x, unsigned& nloc, unsigned& nx) {
    const unsigned G = gridDim.x * gridDim.y * gridDim.z;
    unsigned sum, cnt, mine, sp = 0u;
    for (;;) {
        sum = 0u; cnt = 0u; mine = 0u;
#pragma unroll
        for (unsigned j = 0; j < 16; ++j) { const unsigned c = xb_ld(&bar[XB_XCNT(j)]); sum += c; cnt += (c > 0u) ? 1u : 0u; mine = (j == x) ? c : mine; }
        if (sum == G) break;
        __builtin_amdgcn_s_sleep(1);
        if ((++sp & 255u) == 0u) { if (xb_ld(&bar[XB_TMO])) break; if (sp > XB_SPIN_CAP) { atomicAdd(&bar[XB_TMO], 1u); break; } }
    }
    nloc = mine > 0u ? mine : 1u; nx = cnt > 0u ? cnt : 1u;
}
__device__ __forceinline__ void xcd_barrier(unsigned* bar, volatile LAS unsigned* st) {
    asm volatile("s_waitcnt vmcnt(0)" ::: "memory");
    __syncthreads();
    if (threadIdx.x == 0) {
        const unsigned x = xb_xcc_id();
        __builtin_amdgcn_s_waitcnt(0);
        unsigned nloc = st[0], nx = st[1];
        if (nloc == 0u) { xcd_barrier_complete(bar, x, nloc, nx); st[0] = nloc; st[1] = nx; }
        const unsigned old = xb_add(&bar[XB_XSUB(x)], 1u);
        const unsigned gen = old / nloc;
        if (old + 1u == (gen + 1u) * nloc) {
            __builtin_amdgcn_fence(__ATOMIC_RELEASE, "agent");
            asm volatile("s_waitcnt vmcnt(0)" ::: "memory");
            const unsigned og = xb_add(&bar[XB_TOP], 1u);
            const unsigned tg = og / nx;
            if (og + 1u == (tg + 1u) * nx) xb_add(&bar[XB_TOPGEN], 1u);
            else XB_SPIN(xb_ld(&bar[XB_TOPGEN]) == tg, bar);
            __builtin_amdgcn_fence(__ATOMIC_ACQUIRE, "agent");
            xb_add(&bar[XB_XGEN(x)], 1u);
            asm volatile("s_waitcnt vmcnt(0)" ::: "memory");
        } else {
            XB_SPIN(xb_ld(&bar[XB_XGEN(x)]) == gen, bar);
            __builtin_amdgcn_fence(__ATOMIC_ACQUIRE, "agent");
            asm volatile("s_waitcnt vmcnt(0)" ::: "memory");
        }
    }
    __syncthreads();
}

#ifndef PROBE_DUP
#define PROBE_DUP -1
#endif
#define REP(k) for (int rep_ = 0; rep_ < ((PROBE_DUP) == (k) ? 2 : 1); ++rep_)
#define XBAR() xcd_barrier((unsigned*)(kargs()->ws + OFF_BAR), (volatile LAS unsigned*)(lds + 131072 + 512))
#define GSYNC() do { XBAR(); if ((PROBE_DUP) == 100) XBAR(); } while (0)
#ifndef PH_ONLY
#define PH_ON(n) true
#else
#define PH_ON(n) ((n) == PH_ONLY)
#endif
__global__ void __launch_bounds__(512) fwd_megakernel(KArgs a_by_value) {
    extern __shared__ __attribute__((aligned(16))) unsigned char lds_raw[];
    LAS unsigned char* lds = (LAS unsigned char*)lds_raw;
    cg::grid_group grid = cg::this_grid();
    { volatile LAS unsigned* st = (volatile LAS unsigned*)(lds + 131072 + 512); if (threadIdx.x == 0) { st[0] = 0u; st[1] = 0u; }
      if (blockIdx.x == 0) { unsigned* bar = (unsigned*)(kargs()->ws + OFF_BAR);
          for (int i = threadIdx.x; i < XCD_BAR_WORDS; i += 512) __hip_atomic_store(bar + i, 0u, __ATOMIC_RELAXED, __HIP_MEMORY_SCOPE_AGENT); }
      __syncthreads(); }
    grid.sync();
    if (threadIdx.x == 0) (void)xb_add((unsigned*)(kargs()->ws + OFF_BAR) + XB_XCNT(xb_xcc_id()), 1u);
#define WSB(off) ((bf16_t*)(ws + (off)))
#define PH_HEAD KArgsP a = kargs(); unsigned char* ws = a->ws; const int G = gridDim.x, c = oblk(); (void)G; (void)c; (void)ws;

    for (int l = 0; l < NLAYER; ++l) {
        REP(0) if (PH_ON(0)) { PH_HEAD phase0(a, l, lds); }
        GSYNC();
        REP(1) if (PH_ON(1)) { PH_HEAD
          Sched S{65, 10, 1, G, c, 0, (const char*)WSB(OFF_XB), (const char*)WSB(OFF_WIN), 0, 0, (size_t)256 * 1024 * 2, (size_t)256 * 1024 * 2};
          F1 f{(const float*)(ws + OFF_RSQ), WSB(OFF_SA), WSB(OFF_SE), WSB(OFF_UCG), WSB(OFF_UCS)};
          gemm_phase(lds, 1024, 1024, 16, S, f); }
        GSYNC();
        REP(20) if (PH_ON(20)) { PH_HEAD conv_a_phase(a, l); }
        REP(21) if (PH_ON(21)) { PH_HEAD cfm_phase(a, l, lds); }
        REP(22) if (PH_ON(22)) { PH_HEAD
          Sched S{4, 1, 32, G, c, 0, (const char*)WSB(OFF_UCG), (const char*)(ws + OFF_ET), (size_t)NCHK * KS5 * 2, (size_t)128 * 256 * 2, (size_t)256 * KS5 * 2, 0};
          FEnd f{(float*)(ws + OFF_SF)};
          gemm_phase(lds, KS5, 256, 4, S, f);
          if (G == 256) { Unit u; if (S.next(0, u)) { s5_carry_bg(a, l, lds, 2 * u.pm, u.g); s5_carry_bg(a, l, lds, 2 * u.pm + 1, u.g); } } }
        GSYNC();
        if (gridDim.x == 256) {
            REP(3) if (PH_ON(3)) { PH_HEAD
              const bool lo = c < 128;
              Sched S{64, 8, 1, 128, lo ? c : c - 128, 1, (const char*)WSB(OFF_SB), (const char*)(ws + OFF_WGT), 0, 0, (size_t)256 * 1024 * 2, (size_t)256 * 256 * 2, lo ? 0L : 384L, lo ? 384L : 512L};
              F2 f{WSB(OFF_SB), a->in[12] + l * 1024, a->in[14] + l * 1024, (const float*)(ws + OFF_TAB) + TAB_LAM, a->in[3] + (size_t)l * MS * 1024, WSB(OFF_SA), WSB(OFF_SC), a->out + O_SLH + (size_t)l * MS * 1024};
              gemm_phase(lds, 1024, 256, 4, S, f);
              thin_gemm(lds, WSB(OFF_SB), 1024, WSB(OFF_WGT), 256, 256, 8, 1, f, c, G); }
            REP(41) if (PH_ON(41)) { PH_HEAD
              if (c >= 128) { Sched S{4, 1, 32, G, c - 128, 0, (const char*)WSB(OFF_UCG), (const char*)(ws + OFF_TF), (size_t)NCHK * KS5 * 2, (size_t)256 * KS5 * 2, (size_t)256 * KS5 * 2, 0};
                FS5 f{WSB(OFF_UCG), a->in[27] + l * 512, WSB(OFF_SE)};
                gemm_phase(lds, KS5, KS5, 6, S, f); } }
            REP(23) if (PH_ON(23)) { PH_HEAD s5_sample(a, l); }
            GSYNC();
            REP(4) if (PH_ON(4)) { PH_HEAD lru_scan(a, l, lds, WSB(OFF_SA)); }
        } else {
        REP(3) if (PH_ON(3)) { PH_HEAD
          Sched S{64, 8, 1, G, c, 1, (const char*)WSB(OFF_SB), (const char*)(ws + OFF_WGT), 0, 0, (size_t)256 * 1024 * 2, (size_t)256 * 256 * 2};
          F2 f{WSB(OFF_SB), a->in[12] + l * 1024, a->in[14] + l * 1024, (const float*)(ws + OFF_TAB) + TAB_LAM, a->in[3] + (size_t)l * MS * 1024, WSB(OFF_SA), WSB(OFF_SC), a->out + O_SLH + (size_t)l * MS * 1024};
          gemm_phase(lds, 1024, 256, 4, S, f);
          thin_gemm(lds, WSB(OFF_SB), 1024, WSB(OFF_WGT), 256, 256, 8, 1, f, c, G); }
        REP(31) if (PH_ON(31)) { PH_HEAD s5_carry(a, l, lds); }
        GSYNC();
        REP(4) if (PH_ON(4)) { PH_HEAD lru_scan(a, l, lds, ((PROBE_DUP) == 4 && rep_ == 0) ? WSB(OFF_SB) : WSB(OFF_SA)); }
        REP(23) if (PH_ON(23)) { PH_HEAD s5_sample(a, l); }
        REP(41) if (PH_ON(41)) { PH_HEAD
          Sched S{4, 1, 32, G, c, 0, (const char*)WSB(OFF_UCG), (const char*)(ws + OFF_TF), (size_t)NCHK * KS5 * 2, (size_t)256 * KS5 * 2, (size_t)256 * KS5 * 2, 0};
          FS5 f{WSB(OFF_UCG), a->in[27] + l * 512, WSB(OFF_SE)};
          gemm_phase(lds, KS5, KS5, 6, S, f); }
        GSYNC();
        }
        REP(5) if (PH_ON(5)) {
            { PH_HEAD
              Sched S{64, 2, 1, G, c, 0, (const char*)WSB(OFF_SE), (const char*)(ws + OFF_WGLU), 0, 0, (size_t)256 * 512 * 2, (size_t)256 * 512 * 2};
              F4 f{WSB(OFF_SE), a->in[29] + l * 512, WSB(OFF_SF)};
              gemm_phase(lds, 512, 512, 8, S, f);
              const int hb = G >> 1;
              thin_gemm(lds, WSB(OFF_SE), 512, WSB(OFF_WGLU), 512, 512, 2, 0, f, c >= hb ? c - hb : -1, G - hb); }
            { PH_HEAD
              const int hb = G >> 1, cr = c >= hb ? c - hb : c + (G - hb);
              const bf16_t* Wg = WSB(OFF_WIN) + (size_t)2560 * 1024;
              Sched S{64, 12, 1, G, cr, 0, (const char*)WSB(OFF_XB), (const char*)Wg, 0, 0, (size_t)256 * 1024 * 2, (size_t)256 * 1024 * 2};
              FG8 f{(const float*)(ws + OFF_RSQ), a->in[30] + l * 3072, ws + OFF_GT8};
              gemm_phase(lds, 1024, 1024, 16, S, f);
              thin_gemm(lds, WSB(OFF_XB), 1024, Wg, 1024, 1024, 12, 0, f, c >= hb ? c - hb : -1, G - hb); }
        }
        GSYNC();
        REP(6) if (PH_ON(6)) {
            { PH_HEAD
              SchedM3 S{G, c, (const char*)WSB(OFF_SA), (const char*)WSB(OFF_YB), (const char*)WSB(OFF_SF), (const char*)WSB(OFF_WPA), (const char*)WSB(OFF_WPB), (const char*)WSB(OFF_WPC)};
              FMS f{ws + OFF_GT8, WSB(OFF_MRG)};
              gemm_phase_t<FMS, SchedM3, true>(lds, 1024, 1024, 16, S, f); }
            { PH_HEAD
              thin_merge(lds, WSB(OFF_SA), WSB(OFF_YB), WSB(OFF_SF), WSB(OFF_WPA), WSB(OFF_WPB), WSB(OFF_WPC), ws + OFF_GT8, WSB(OFF_MRG), c, G); }
        }
        GSYNC();
        if (PH_ON(7)) { PH_HEAD
          Sched S{64, 4, 1, G, c, 0, (const char*)WSB(OFF_MRG), (const char*)(ws + OFF_WOUT), 0, 0, (size_t)256 * 1024 * 2, (size_t)256 * 1024 * 2};
          F6T<false> f{l == 0 ? a->in[0] : a->out, l == 0 ? a->in[1] : a->out + (size_t)MP * 1024, a->out, WSB(OFF_XB), (float*)(ws + OFF_RSQ2)};
          gemm_phase(lds, 1024, 1024, 16, S, f);
          F6T<true> ft{f.xs_p, f.xs_s, f.xd, f.xb, f.rsq};
          thin_gemm(lds, WSB(OFF_MRG), 1024, WSB(OFF_WOUT), 1024, 1024, 4, 0, ft, c, G); }
        GSYNC();
        REP(8) if (PH_ON(8)) { PH_HEAD
          Sched S{65, 22, 1, G, c, 0, (const char*)WSB(OFF_XB), (const char*)(ws + OFF_WF1), 0, 0, (size_t)256 * 1024 * 2, (size_t)256 * 1024 * 2};
          F7 f{(const float*)(ws + OFF_RSQ2), WSB(OFF_SA)};
          gemm_phase(lds, 1024, 1024, 16, S, f); }
        GSYNC();
        if (PH_ON(9)) { PH_HEAD
          Sched S{64, 4, 1, G, c, 0, (const char*)WSB(OFF_SA), (const char*)(ws + OFF_WF2), 0, 0, (size_t)256 * DFF * 2, (size_t)256 * DFF * 2};
          F6T<false> f{a->out, a->out + (size_t)MP * 1024, a->out, WSB(OFF_XB), (float*)(ws + OFF_RSQ)};
          gemm_phase(lds, DFF, DFF, DFF / 64, S, f);
          F6T<true> ft{f.xs_p, f.xs_s, f.xd, f.xb, f.rsq};
          thin_gemm(lds, WSB(OFF_SA), DFF, WSB(OFF_WF2), DFF, DFF, 4, 0, ft, c, G); }
        GSYNC();
    }
    { PH_HEAD const int tid = otid(); const int wv = tid >> 6, lane = tid & 63; const float* gf = a->in[38]; const float* RSQ = (const float*)(ws + OFF_RSQ);
      f32x4 vn[4], pn4; const int rstep = gridDim.x * 8; int row = blockIdx.x * 8 + wv; f32x4 gv[4];
#pragma unroll
      for (int i = 0; i < 4; ++i) gv[i] = *(const f32x4*)(gf + i * 256 + lane * 4);
      if (row < MT) { pn4 = *(const f32x4*)(RSQ + (size_t)row * 16 + (lane & 3) * 4);
#pragma unroll
          for (int i = 0; i < 4; ++i) vn[i] = *(const f32x4*)(a->out + (size_t)row * 1024 + i * 256 + lane * 4); }
      for (; row < MT; row += rstep) { f32x4 vc[4]; const f32x4 pc = pn4;
#pragma unroll
          for (int i = 0; i < 4; ++i) vc[i] = vn[i];
          if (row + rstep < MT) { const int rn = row + rstep; pn4 = *(const f32x4*)(RSQ + (size_t)rn * 16 + (lane & 3) * 4);
#pragma unroll
              for (int i = 0; i < 4; ++i) vn[i] = *(const f32x4*)(a->out + (size_t)rn * 1024 + i * 256 + lane * 4); }
          float sq = (pc[0] + pc[1]) + (pc[2] + pc[3]); sq += __shfl_xor(sq, 1); sq += __shfl_xor(sq, 2);
          const float rs = rsqrtf(sq * (1.0f / 1024.0f) + EPS); float* x = a->out + (size_t)row * 1024;
#pragma unroll
          for (int i = 0; i < 4; ++i) *(f32x4*)(x + i * 256 + lane * 4) = vc[i] * rs * gv[i]; } }
}

extern "C" void kernel_launch(void* const* d_in, const int* in_sizes, int n_in, void* d_out, int out_size, void* d_ws, size_t ws_size, hipStream_t stream) {
    static int grid_blocks = 0;
    if (!grid_blocks) {
        int dev = 0, cus = 0, per_cu = 0;
        hipGetDevice(&dev);
        hipDeviceGetAttribute(&cus, hipDeviceAttributeMultiprocessorCount, dev);
        hipFuncSetAttribute((const void*)fwd_megakernel, hipFuncAttributeMaxDynamicSharedMemorySize, LDS_BYTES);
        hipOccupancyMaxActiveBlocksPerMultiprocessor(&per_cu, (const void*)fwd_megakernel, 512, LDS_BYTES);
        if (per_cu < 1) { fprintf(stderr, "occupancy query says %d blocks/CU\n", per_cu); per_cu = 1; }
        if (per_cu > 1) per_cu = 1;
        grid_blocks = cus * per_cu;
        if (n_in != 39 || ws_size < WS_END) fprintf(stderr, "kernel_launch: unexpected n_in %d / ws_size %zu (need %zu)\n", n_in, ws_size, (size_t)WS_END);
    }
    KArgs a{};
    for (int i = 0; i < 39; ++i) a.in[i] = (const float*)d_in[i];
    a.out = (float*)d_out; a.ws = (unsigned char*)d_ws;
    void* args[] = {&a};
    hipError_t e = hipLaunchCooperativeKernel((const void*)fwd_megakernel, dim3(grid_blocks), dim3(512), args, LDS_BYTES, stream);
    if (e != hipSuccess) fprintf(stderr, "cooperative launch failed: %s (grid %d)\n", hipGetErrorString(e), grid_blocks);
}
```

```cpp
#include <hip/hip_runtime.h>
#include <hip/hip_cooperative_groups.h>
#include <cstdio>
namespace cg = cooperative_groups;

#define LAS __attribute__((address_space(3)))
typedef unsigned short bf16_t;
typedef short bf16x8 __attribute__((ext_vector_type(8)));
typedef float f32x4 __attribute__((ext_vector_type(4)));
typedef unsigned u32x4 __attribute__((ext_vector_type(4)));
typedef unsigned u32x2 __attribute__((ext_vector_type(2)));

constexpr int D = 1024, SEQ = 2048, NBATCH = 8, MP = 16384, MS = 128, MT = MP + MS;
constexpr int INW = 5632, DFF = 2816, WB = 512, NG = 32, NPC = 64, NLAYER = 2;
constexpr int NCHK = 1024;
constexpr int KS5 = 384;
constexpr float EPS = 1e-6f;

constexpr size_t O_PLC = 16908288, O_PLH = 16957440, O_PCC = 16973824, O_PSR = 17219584, O_PSI = 17252352,
                 O_SLC = 17285120, O_SLH = 18071552, O_SCC = 18333696, O_SSR = 22265856, O_SSI = 22790144;

constexpr size_t SZ34 = (size_t)MT * 1024 * 2, SZ17 = (size_t)MT * 512 * 2;
constexpr size_t OFF_WIN = 0;
constexpr size_t OFF_WGT = OFF_WIN + (size_t)5632 * 1024 * 2;
constexpr size_t OFF_WGLU = OFF_WGT + (size_t)2048 * 256 * 2;
constexpr size_t OFF_WPA = OFF_WGLU + (size_t)512 * 512 * 2;
constexpr size_t OFF_WPB = OFF_WPA + (size_t)1024 * 1024 * 2;
constexpr size_t OFF_WPC = OFF_WPB + (size_t)1024 * 512 * 2;
constexpr size_t OFF_WOUT = OFF_WPC + (size_t)1024 * 512 * 2;
constexpr size_t OFF_WF1 = OFF_WOUT + (size_t)1024 * 1024 * 2;
constexpr size_t OFF_WF2 = OFF_WF1 + (size_t)5632 * 1024 * 2;
constexpr size_t OFF_TF = OFF_WF2 + (size_t)1024 * 2816 * 2;
constexpr size_t OFF_ET = OFF_TF + (size_t)32 * 256 * KS5 * 2;
constexpr size_t OFF_TAB = OFF_ET + (size_t)(32 * 128 + 128) * 256 * 2;
constexpr int TAB_LAM = 4096 + 4096 + 65536;
constexpr size_t OFF_RSQ = OFF_TAB + (size_t)(TAB_LAM + 1024) * 4;
constexpr size_t OFF_RSQ2 = OFF_RSQ + (size_t)MT * 16 * 4;
constexpr size_t OFF_XB = OFF_RSQ2 + (size_t)MT * 16 * 4;
constexpr size_t OFF_SA = OFF_XB + SZ34;
constexpr size_t OFF_SB = OFF_SA + SZ34;
constexpr size_t OFF_SC = OFF_SB + SZ34;
constexpr size_t OFF_UCG = OFF_SC + SZ34;
constexpr size_t OFF_UCS = OFF_UCG + (size_t)32 * 1024 * KS5 * 2;
constexpr size_t OFF_SE = OFF_UCS + (size_t)128 * 512 * 2;
constexpr size_t OFF_YB = OFF_SE + SZ17;
constexpr size_t OFF_SF = OFF_YB + SZ17;
constexpr size_t SZG8 = (((size_t)MT * 3072) + 255) & ~(size_t)255;
constexpr size_t OFF_GT8 = OFF_SB;
constexpr int G8_SPLIT = 11008;
static_assert((size_t)G8_SPLIT * 3072 == SZ34 && (size_t)(MT - G8_SPLIT) * 3072 <= (size_t)32 * 1024 * KS5 * 2, "gate array placement");
constexpr size_t OFF_MRG = OFF_SC;
constexpr size_t OFF_BAR = OFF_SF + SZ17;
constexpr size_t WS_END = OFF_BAR + 16384;
static_assert((size_t)32 * 1024 * 128 * 4 <= SZ17, "ends fits");
static_assert((size_t)MT * 2816 * 2 <= 3 * SZ34, "act fits");
static_assert(WS_END <= (size_t)256 * 1024 * 1024, "workspace");

constexpr int LDS_BYTES = 128 * 1024 + 1024;

struct KArgs { const float* in[39]; float* out; unsigned char* ws; };
typedef const __attribute__((address_space(4))) KArgs* KArgsP;
__device__ __forceinline__ KArgsP kargs() { auto p = __builtin_amdgcn_kernarg_segment_ptr(); asm volatile("" : "+s"(p)); return (KArgsP)p; }

__device__ __forceinline__ unsigned cvt_pk_bf16(float lo, float hi) { unsigned r; asm volatile("v_cvt_pk_bf16_f32 %0, %1, %2" : "=v"(r) : "v"(lo), "v"(hi)); return r; }
__device__ __forceinline__ bf16_t f2bf(float f) { return (bf16_t)(cvt_pk_bf16(f, 0.f) & 0xffffu); }
__device__ __forceinline__ float bf2f(unsigned b) { return __uint_as_float(b << 16); }
__device__ __forceinline__ void store8(bf16_t* p, const float* v) { u32x4 w; w.x = cvt_pk_bf16(v[0], v[1]); w.y = cvt_pk_bf16(v[2], v[3]); w.z = cvt_pk_bf16(v[4], v[5]); w.w = cvt_pk_bf16(v[6], v[7]); *(u32x4*)p = w; }
__device__ __forceinline__ void store4(bf16_t* p, const f32x4 v) { u32x2 w; w.x = cvt_pk_bf16(v[0], v[1]); w.y = cvt_pk_bf16(v[2], v[3]); *(u32x2*)p = w; }
struct PkSt { u32x2 pk[2]; };
template <int SLOT> __device__ __forceinline__ void wstore(PkSt& ps, const int n, bf16_t* p, const f32x4 v) {
    u32x2 w; w.x = cvt_pk_bf16(v[0], v[1]); w.y = cvt_pk_bf16(v[2], v[3]);
    if (n == 0) ps.pk[SLOT] = w; else { u32x4 q; q.x = ps.pk[SLOT].x; q.y = ps.pk[SLOT].y; q.z = w.x; q.w = w.y; *(u32x4*)(p - 4) = q; }
}
__device__ __forceinline__ void unpack8(const u32x4 w, float* v) {
    v[0] = __uint_as_float(w.x << 16); v[1] = __uint_as_float(w.x & 0xffff0000u); v[2] = __uint_as_float(w.y << 16); v[3] = __uint_as_float(w.y & 0xffff0000u);
    v[4] = __uint_as_float(w.z << 16); v[5] = __uint_as_float(w.z & 0xffff0000u); v[6] = __uint_as_float(w.w << 16); v[7] = __uint_as_float(w.w & 0xffff0000u); }
__device__ __forceinline__ void load8(const bf16_t* p, float* v) { unpack8(*(const u32x4*)p, v); }
__device__ __forceinline__ size_t g8row(int row) { return (size_t)row * 3072 + (row >= G8_SPLIT ? SZ34 : (size_t)0); }
__device__ __forceinline__ float sigm(float x) { return __builtin_amdgcn_rcpf(1.0f + __expf(-x)); }
__device__ __forceinline__ float wave_sum(float v) { for (int o = 32; o >= 1; o >>= 1) v += __shfl_xor(v, o); return v; }

__device__ __forceinline__ int otid() { int t = threadIdx.x; asm volatile("" : "+v"(t)); return t; }
__device__ __forceinline__ int oblk() { int t = blockIdx.x; asm volatile("" : "+s"(t)); return t; }
constexpr int BM = 256, BK = 64, HALF = 128, HTB = HALF * BK * 2, NXCD = 8, WGM = 8;
__device__ __forceinline__ int lds_byte(int r, int c) { const int st = (r >> 4) * 2 + (c >> 5), rr = r & 15, cc = c & 31, ob = rr * 64 + cc * 2; return st * 1024 + (ob ^ (((ob >> 9) & 1) << 5)); }
__device__ __forceinline__ void stage_rc(int b, int& R, int& C) { const int st = b / 1024, sb = b % 1024, swz = sb ^ (((sb >> 9) & 1) << 5); R = (st >> 1) * 16 + swz / 64; C = (st & 1) * 32 + (swz % 64) / 2; }
__device__ __forceinline__ int perm32(int rho) { const int n = rho >> 4, i = rho & 15; return 8 * (i >> 2) + 4 * n + (i & 3); }

struct Unit { int pm, pn, g, sm, fin; const char* A; const char* B; };
struct Sched {
    int nM, nN, nGrp, G, c, bd; const char* A;     const char* B; size_t a_g, b_g, a_pm, b_pn; long L0 = 0, Lend = (1L << 40);
    __device__ __forceinline__ bool next(int i, Unit& u) const {
        const long L = L0 + (long)i * G + c; const int nwg = nM * nN; if (L >= (long)nwg * nGrp || L >= Lend) return false;
        const int g = (int)(L / nwg); int wgid = (int)(L % nwg);
        { const int q = nwg / NXCD, r = nwg % NXCD, xcd = wgid % NXCD, off = wgid / NXCD; wgid = (xcd < r ? xcd * (q + 1) : r * (q + 1) + (xcd - r) * q) + off; }
        const int nig = WGM * nN, gid = wgid / nig, fm = gid * WGM, gsz = (nM - fm) < WGM ? (nM - fm) : WGM;
        u.pm = fm + ((wgid % nig) % gsz); u.pn = (wgid % nig) / gsz; u.g = g; u.sm = 0; u.fin = 1;
        u.A = A + (size_t)g * a_g + (size_t)u.pm * a_pm + (bd ? (size_t)(u.pn >> 1) * 512 : 0); u.B = B + (size_t)g * b_g + (size_t)u.pn * b_pn; return true;
    }
};

struct SchedM3 {
    int G, c; const char* YA; const char* YB; const char* YC; const char* WPA; const char* WPB; const char* WPC;
    __device__ __forceinline__ bool next(int i, Unit& u) const {
        const int rnd = i / 3, seg = i - rnd * 3; int wgid = c + rnd * G; if (wgid >= 256) return false;
        { const int q = 256 / NXCD, xcd = wgid % NXCD, off = wgid / NXCD; wgid = xcd * q + off; }
        const int nig = WGM * 4, gid = wgid / nig, fm = gid * WGM;
        u.pm = fm + ((wgid % nig) % WGM); u.pn = (wgid % nig) / WGM; u.g = seg; u.sm = seg ? 1 : 0; u.fin = (seg == 2);
        const size_t pa = (size_t)u.pm * 256 * 2, pb = (size_t)u.pn * 256 * 2;
        if (seg == 0) { u.A = YA + pa * 1024; u.B = WPA + pb * 1024; }
        else if (seg == 1) { u.A = YB + pa * 512; u.B = WPB + pb * 512; }
        else { u.A = YC + pa * 512; u.B = WPC + pb * 512; }
        return true;
    }
};

template <class F, class SC, bool MIX>
__device__ __forceinline__ void gemm_phase_t(LAS unsigned char* lds, const int lda, const int ldb, const int nt_, const SC& S, const F& E) {
    const int tid = otid(), wid = __builtin_amdgcn_readfirstlane(tid >> 6), lane = tid & 63, wr = wid >> 2, wc = wid & 3, fr = lane & 15, fq = lane >> 4;
    unsigned voffA[2], voffB[2];
#pragma unroll
    for (int i = 0; i < 2; ++i) { int R, C; stage_rc(tid * 16 + i * 8192, R, C); const int Rb = (R & ~31) + perm32(R & 31);
        voffA[i] = (unsigned)(R * (MIX ? 512 : lda) + C) * 2u; voffB[i] = (unsigned)(Rb * (MIX ? 512 : ldb) + C) * 2u; }
    const size_t kstep = (size_t)(BK * 2);
    const size_t hA0 = (size_t)HALF * lda * 2, hB0 = (size_t)HALF * ldb * 2;
    const unsigned ldsw = (unsigned)wid * 1024u;
    const int aoff = lds_byte(wr * 64 + fr, fq * 8), boff = lds_byte(wc * 32 + fr, fq * 8);
#define PG8_SA(b, h) (((b) * 2 + (h)) * HTB)
#define PG8_SB(b, h) ((4 + (b) * 2 + (h)) * HTB)
#define PG8_STAGE(bufoff, gbase, voff, m2) do { _Pragma("unroll") for (int _i = 0; _i < 2; ++_i) \
        __builtin_amdgcn_global_load_lds((const unsigned*)((const char*)(gbase) + ((voff)[_i] + ((voff)[_i] & (m2)))), (LAS unsigned*)(lds + (bufoff) + ldsw + _i * 8192), 16, 0, 0); } while (0)
#define PG8_LDA(dst, b, h) do { _Pragma("unroll") for (int m = 0; m < 4; ++m) _Pragma("unroll") for (int k = 0; k < 2; ++k) dst[m][k] = *(const LAS bf16x8*)(lds + PG8_SA(b, h) + aoff + m * 2048 + k * 1024); } while (0)
#define PG8_LDB(dst, b, h) do { _Pragma("unroll") for (int n = 0; n < 2; ++n) _Pragma("unroll") for (int k = 0; k < 2; ++k) dst[n][k] = *(const LAS bf16x8*)(lds + PG8_SB(b, h) + boff + n * 2048 + k * 1024); } while (0)
#define PG8_MMA(ai, bj, At, Bt) do { __builtin_amdgcn_s_setprio(1); _Pragma("unroll") for (int m = 0; m < 4; ++m) _Pragma("unroll") for (int n = 0; n < 2; ++n) _Pragma("unroll") for (int k = 0; k < 2; ++k) \
        acc[ai][bj][m][n] = __builtin_amdgcn_mfma_f32_16x16x32_bf16(Bt[n][k], At[m][k], acc[ai][bj][m][n], 0, 0, 0); __builtin_amdgcn_s_setprio(0); } while (0)
#define PG8_WAIT_V(n) asm volatile("s_waitcnt vmcnt(" #n ")" ::: "memory")
#define PG8_WAIT_L(n) asm volatile("s_waitcnt lgkmcnt(" #n ")" ::: "memory")
#define PG8_BAR __builtin_amdgcn_s_barrier()
#define PG8_SCHED __builtin_amdgcn_sched_barrier(0)
    Unit cur, nxt; int ui = 0;
    if (!S.next(0, cur)) return;
    f32x4 acc[2][2][4][2];
    if constexpr (F::ACC_INIT) E.init(acc, cur.pm, cur.pn, wr, wc, fr, fq); else {
#pragma unroll
    for (int a = 0; a < 2; ++a)
#pragma unroll
        for (int b = 0; b < 2; ++b)
#pragma unroll
            for (int m = 0; m < 4; ++m)
#pragma unroll
                for (int n = 0; n < 2; ++n) acc[a][b][m][n] = (f32x4){0.f, 0.f, 0.f, 0.f};
    }
    bf16x8 At[4][2], B0[2][2], B1[2][2];
    const char* cA = cur.A; const char* cB = cur.B;
    unsigned cm = (MIX && !cur.sm) ? ~1023u : 0u; size_t hA = MIX ? (cur.sm ? (size_t)131072 : (size_t)262144) : hA0, hB = MIX ? hA : hB0; int nt = MIX ? (cur.sm ? 8 : 16) : nt_;
    PG8_STAGE(PG8_SB(0, 0), cB, voffB, cm); PG8_STAGE(PG8_SA(0, 0), cA, voffA, cm); PG8_STAGE(PG8_SB(0, 1), cB + hB, voffB, cm); PG8_STAGE(PG8_SA(0, 1), cA + hA, voffA, cm);
    if (wr == 1) PG8_BAR;
    PG8_WAIT_V(4); PG8_BAR;
    PG8_STAGE(PG8_SB(1, 0), cB + kstep, voffB, cm); PG8_STAGE(PG8_SA(1, 0), cA + kstep, voffA, cm); PG8_STAGE(PG8_SB(1, 1), cB + hB + kstep, voffB, cm);
    PG8_WAIT_V(6); PG8_BAR;
    for (;;) {
        const bool has_next = S.next(ui + 1, nxt);
        const char* nA = has_next ? nxt.A : cA; const char* nB = has_next ? nxt.B : cB;
        const unsigned nm = (MIX && has_next) ? (nxt.sm ? 0u : ~1023u) : cm;
        const size_t nhA = (MIX && has_next) ? (nxt.sm ? (size_t)131072 : (size_t)262144) : hA, nhB = MIX ? nhA : hB;
#pragma unroll 1
        for (int t = 0; t < nt; t += 2) {
            const bool last = (t == nt - 2);
            const char* a1 = cA + (size_t)(t + 1) * kstep;
            const char* a2 = last ? nA : cA + (size_t)(t + 2) * kstep; const char* b2 = last ? nB : cB + (size_t)(t + 2) * kstep;
            const char* a3 = a2 + kstep; const char* b3 = b2 + kstep;
            const unsigned m2 = (MIX && last) ? nm : cm; const size_t h2A = (MIX && last) ? nhA : hA, h2B = (MIX && last) ? nhB : hB;
            PG8_LDB(B0, 0, 0); PG8_SCHED; PG8_LDA(At, 0, 0); PG8_STAGE(PG8_SA(1, 1), a1 + hA, voffA, cm);
            PG8_WAIT_L(8); PG8_BAR; PG8_WAIT_L(0); PG8_MMA(0, 0, At, B0); PG8_BAR; PG8_SCHED;
            PG8_LDB(B1, 0, 1); PG8_STAGE(PG8_SB(0, 0), b2, voffB, m2);
            PG8_BAR; PG8_WAIT_L(0); PG8_MMA(0, 1, At, B1); PG8_BAR;
            PG8_LDA(At, 0, 1); PG8_STAGE(PG8_SA(0, 0), a2, voffA, m2);
            PG8_BAR; PG8_WAIT_L(0); PG8_MMA(1, 0, At, B0); PG8_BAR; PG8_SCHED;
            PG8_STAGE(PG8_SB(0, 1), b2 + h2B, voffB, m2);
            PG8_WAIT_V(6); PG8_BAR; PG8_MMA(1, 1, At, B1); PG8_BAR;
            PG8_LDB(B0, 1, 0); PG8_SCHED; PG8_LDA(At, 1, 0); PG8_STAGE(PG8_SA(0, 1), a2 + h2A, voffA, m2);
            PG8_WAIT_L(8); PG8_BAR; PG8_WAIT_L(0); PG8_MMA(0, 0, At, B0); PG8_BAR; PG8_SCHED;
            PG8_LDB(B1, 1, 1); PG8_STAGE(PG8_SB(1, 0), b3, voffB, m2);
            PG8_BAR; PG8_WAIT_L(0); PG8_MMA(0, 1, At, B1); PG8_BAR;
            PG8_LDA(At, 1, 1); PG8_STAGE(PG8_SA(1, 0), a3, voffA, m2);
            PG8_BAR; PG8_WAIT_L(0); PG8_MMA(1, 0, At, B0); PG8_BAR; PG8_SCHED;
            PG8_STAGE(PG8_SB(1, 1), b3 + h2B, voffB, m2);
            PG8_WAIT_V(6); PG8_BAR; PG8_MMA(1, 1, At, B1); PG8_BAR;
        }
        {
            int row0 = cur.pm * BM + wr * 64 + fr; asm volatile("" : "+v"(row0));
            const typename F::UCtx uc = E.unit_ctx(cur.pn, wc, fq, cur.g);
            typename F::Pre pre = E.row_pre(row0, fq, cur.pn, wc, cur.g);
#pragma unroll
            for (int rg = 0; rg < 8; ++rg) { const int ai = rg >> 2, m = rg & 3;
                int row = cur.pm * BM + ai * HALF + wr * 64 + m * 16 + fr;
                asm volatile("" : "+v"(row));
                typename F::Pre pre_n = pre;
                if (rg < 7) { int rown = cur.pm * BM + ((rg + 1) >> 2) * HALF + wr * 64 + ((rg + 1) & 3) * 16 + fr; asm volatile("" : "+v"(rown)); pre_n = E.row_pre(rown, fq, cur.pn, wc, cur.g); }
                asm volatile("" ::: "memory");
                typename F::State st; E.row_begin(st, pre); PkSt ps;
#pragma unroll
                for (int n = 0; n < 2; ++n) { E.op(st, ps, uc, row, cur.pn, cur.g, wc * 32 + 8 * fq + 4 * n, n, acc[ai][0][m][n], acc[ai][1][m][n]); }
                E.row_end(st, row, cur.pn, wc);
                pre = pre_n;
            }
        }
        if (!has_next) break;
        if constexpr (F::ACC_INIT) E.init(acc, nxt.pm, nxt.pn, wr, wc, fr, fq); else if (!MIX || cur.fin) {
#pragma unroll
        for (int a = 0; a < 2; ++a)
#pragma unroll
            for (int b = 0; b < 2; ++b)
#pragma unroll
                for (int m = 0; m < 4; ++m)
#pragma unroll
                    for (int n = 0; n < 2; ++n) acc[a][b][m][n] = (f32x4){0.f, 0.f, 0.f, 0.f};
        }
        cur = nxt; cA = nA; cB = nB; ++ui;
        if (MIX) { cm = nm; hA = nhA; hB = nhB; nt = cur.sm ? 8 : 16; }
    }
    PG8_WAIT_V(0);
    if (wr == 0) PG8_BAR;
    PG8_BAR;
#undef PG8_SA
#undef PG8_SB
#undef PG8_STAGE
#undef PG8_LDA
#undef PG8_LDB
#undef PG8_MMA
#undef PG8_WAIT_V
#undef PG8_WAIT_L
#undef PG8_BAR
#undef PG8_SCHED
}

template <class F>
__device__ __forceinline__ void gemm_phase(LAS unsigned char* lds, const int lda, const int ldb, const int nt, const Sched& S, const F& E) { gemm_phase_t<F, Sched, false>(lds, lda, ldb, nt, S, E); }

template <class F>
__device__ __forceinline__ void thin_gemm(LAS unsigned char* lds, const bf16_t* A, const int lda, const bf16_t* Bt, const int ldb, const int K, const int nN, const int bd, const F& E, const int bi, const int nb) {
    const int tid = otid(), wid = tid >> 6, lane = tid & 63, fr = lane & 15, fq = lane >> 4;
    LAS f32x4* red = (LAS f32x4*)lds;
    const int nitems = 8 * nN * 4, kw = K >> 3;
    if (bi >= 0) for (int item = bi; item < nitems; item += nb) {
        const int rg = item & 7, wc = (item >> 3) & 3, pn = item >> 5;
        const bf16_t* ap = A + (size_t)(MP + 16 * rg + fr) * lda + (bd ? (pn >> 1) * 256 : 0) + wid * kw + 8 * fq;
        const bf16_t* bp[4];
#pragma unroll
        for (int n = 0; n < 4; ++n) bp[n] = Bt + (size_t)(256 * pn + 128 * (n >> 1) + 32 * wc + 8 * (fr >> 2) + 4 * (n & 1) + (fr & 3)) * ldb + wid * kw + 8 * fq;
        f32x4 acc[4];
#pragma unroll
        for (int n = 0; n < 4; ++n) acc[n] = (f32x4){0.f, 0.f, 0.f, 0.f};
        for (int kb = 0; kb < kw; kb += 128) {
            bf16x8 av[4], bv[4][4];
#pragma unroll
            for (int i = 0; i < 4; ++i) if (kb + 32 * i < kw) { av[i] = *(const bf16x8*)(ap + kb + 32 * i);
#pragma unroll
                for (int n = 0; n < 4; ++n) bv[i][n] = *(const bf16x8*)(bp[n] + kb + 32 * i); }
#pragma unroll
            for (int i = 0; i < 4; ++i) if (kb + 32 * i < kw) {
#pragma unroll
                for (int n = 0; n < 4; ++n) acc[n] = __builtin_amdgcn_mfma_f32_16x16x32_bf16(bv[i][n], av[i], acc[n], 0, 0, 0); }
        }
#pragma unroll
        for (int n = 0; n < 4; ++n) red[(wid * 4 + n) * 64 + lane] = acc[n];
        __syncthreads();
        if (wid == 0) {
            f32x4 sv[4];
#pragma unroll
            for (int n = 0; n < 4; ++n) { f32x4 s = red[n * 64 + lane];
#pragma unroll
                for (int w = 1; w < 8; ++w) s += red[(w * 4 + n) * 64 + lane];
                sv[n] = s; }
            const int row = MP + 16 * rg + fr; typename F::State st; E.row_begin(st, E.row_pre(row, fq, pn, wc, 0));
            const typename F::UCtx uc = E.unit_ctx(pn, wc, fq, 0);
            PkSt ps;
#pragma unroll
            for (int n = 0; n < 2; ++n) E.op(st, ps, uc, row, pn, 0, wc * 32 + 8 * fq + 4 * n, n, sv[n], sv[2 + n]);
            E.row_end(st, row, pn, wc);
        }
        __syncthreads();
    }
}

__device__ __forceinline__ void thin_merge(LAS unsigned char* lds, const bf16_t* YA, const bf16_t* YB, const bf16_t* YC, const bf16_t* WPA, const bf16_t* WPB, const bf16_t* WPC,
                                           const unsigned char* g8, bf16_t* mrg, const int bi, const int nb) {
    const int tid = otid(), wid = tid >> 6, lane = tid & 63, fr = lane & 15, fq = lane >> 4;
    LAS f32x4* red = (LAS f32x4*)lds;
    for (int item = bi; item < 8 * 4 * 4; item += nb) {
        const int rg = item & 7, wc = (item >> 3) & 3, pn = item >> 5, row = MP + 16 * rg + fr;
        int brow[4];
#pragma unroll
        for (int n = 0; n < 4; ++n) brow[n] = 256 * pn + 128 * (n >> 1) + 32 * wc + 8 * (fr >> 2) + 4 * (n & 1) + (fr & 3);
        f32x4 tot[4];
#pragma unroll
        for (int n = 0; n < 4; ++n) tot[n] = (f32x4){0.f, 0.f, 0.f, 0.f};
#pragma unroll
        for (int seg = 0; seg < 3; ++seg) {
            const bf16_t* A = seg == 0 ? YA : (seg == 1 ? YB : YC); const bf16_t* B = seg == 0 ? WPA : (seg == 1 ? WPB : WPC);
            const int K = seg == 0 ? 1024 : 512, kw = K >> 3, nst = kw >> 5;
            bf16x8 av[4], bv[4][4]; unsigned gw[4];
#pragma unroll
            for (int i = 0; i < 4; ++i) if (i < nst) { av[i] = *(const bf16x8*)(A + (size_t)row * K + wid * kw + 32 * i + 8 * fq);
#pragma unroll
                for (int n = 0; n < 4; ++n) bv[i][n] = *(const bf16x8*)(B + (size_t)brow[n] * K + wid * kw + 32 * i + 8 * fq); }
#pragma unroll
            for (int n = 0; n < 4; ++n) gw[n] = *(const unsigned*)(g8 + g8row(row) + seg * 1024 + 256 * pn + 128 * (n >> 1) + 32 * wc + 8 * fq + 4 * (n & 1));
            f32x4 acc[4];
#pragma unroll
            for (int n = 0; n < 4; ++n) acc[n] = (f32x4){0.f, 0.f, 0.f, 0.f};
#pragma unroll
            for (int i = 0; i < 4; ++i) if (i < nst) {
#pragma unroll
                for (int n = 0; n < 4; ++n) acc[n] = __builtin_amdgcn_mfma_f32_16x16x32_bf16(bv[i][n], av[i], acc[n], 0, 0, 0); }
#pragma unroll
            for (int n = 0; n < 4; ++n) tot[n] += acc[n] * ((f32x4){(float)(gw[n] & 255u), (float)((gw[n] >> 8) & 255u), (float)((gw[n] >> 16) & 255u), (float)(gw[n] >> 24)} * (1.0f / 255.0f));
        }
#pragma unroll
        for (int n = 0; n < 4; ++n) red[(wid * 4 + n) * 64 + lane] = tot[n];
        __syncthreads();
        if (wid == 0) {
#pragma unroll
            for (int n = 0; n < 4; ++n) { f32x4 sv = red[n * 64 + lane];
#pragma unroll
                for (int w = 1; w < 8; ++w) sv += red[(w * 4 + n) * 64 + lane];
                store4(mrg + (size_t)row * 1024 + 256 * pn + 128 * (n >> 1) + 32 * wc + 8 * fq + 4 * (n & 1), sv); }
        }
        __syncthreads();
    }
}

__device__ __forceinline__ f32x4 load4(const bf16_t* p) { const u32x2 w = *(const u32x2*)p; return (f32x4){__uint_as_float(w.x << 16), __uint_as_float(w.x & 0xffff0000u), __uint_as_float(w.y << 16), __uint_as_float(w.y & 0xffff0000u)}; }
__device__ __forceinline__ f32x4 sigm4(const f32x4 x) { return (f32x4){sigm(x[0]), sigm(x[1]), sigm(x[2]), sigm(x[3])}; }
__device__ __forceinline__ float row_rs4(const float* rsq, int row, int fq) {
    const f32x4 a = *(const f32x4*)(rsq + (size_t)row * 16 + fq * 4); float s = (a[0] + a[1]) + (a[2] + a[3]);
    s += __shfl_xor(s, 16); s += __shfl_xor(s, 32); return rsqrtf(s * (1.0f / 1024.0f) + EPS);
}
__device__ __forceinline__ float rs_from4(const f32x4 a) { float s = (a[0] + a[1]) + (a[2] + a[3]); s += __shfl_xor(s, 16); s += __shfl_xor(s, 32); return rsqrtf(s * (1.0f / 1024.0f) + EPS); }
__device__ __forceinline__ float row_rs(const float* rsq, int row) {
    const f32x4* p = (const f32x4*)(rsq + (size_t)row * 16); const f32x4 a = p[0], b = p[1], c = p[2], d = p[3];
    const float s = ((a[0] + a[1]) + (a[2] + a[3])) + ((b[0] + b[1]) + (b[2] + b[3])) + ((c[0] + c[1]) + (c[2] + c[3])) + ((d[0] + d[1]) + (d[2] + d[3]));
    return rsqrtf(s * (1.0f / 1024.0f) + EPS);
}
struct StNone { };
struct StF { float x; };
struct F1 {
    typedef StF State;
    static constexpr bool ACC_INIT = false;
    typedef StNone UCtx;
    __device__ __forceinline__ UCtx unit_ctx(int, int, int, int) const { return UCtx(); }
    const float* rsq; bf16_t* ua; bf16_t* glu; bf16_t* ucg; bf16_t* ucs;
    typedef f32x4 Pre;
    __device__ __forceinline__ Pre row_pre(int row, int fq, int, int, int) const { return *(const f32x4*)(rsq + (size_t)row * 16 + fq * 4); }
    __device__ __forceinline__ void row_begin(State& st, const Pre& p) const { st.x = rs_from4(p); }
    __device__ __forceinline__ void row_end(State&, int, int, int) const {}
    __device__ __forceinline__ void op(State& st, PkSt& ps, const UCtx& uc, int row, int pn, int, int lc, const int n, f32x4& a, f32x4& b) const {
        if (row >= MT) return;
        const f32x4 va = a * st.x, vb = b * st.x;
        if (pn < 4) { bf16_t* p = ua + (size_t)row * 1024 + pn * 256 + lc; wstore<0>(ps, n, p, va); wstore<1>(ps, n, p + 128, vb); }
        else if (pn < 8) wstore<0>(ps, n, glu + (size_t)row * 512 + (pn - 4) * 128 + lc, va * sigm4(vb));
        else {
#pragma unroll
            for (int h = 0; h < 2; ++h) { const int cc = (pn - 8) * 256 + lc + 128 * h; bf16_t* dst;
                if (row < MP) dst = ucg + ((size_t)(cc >> 4) * NCHK + (row >> 4)) * KS5 + (row & 15) * 16 + (cc & 15);
                else dst = ucs + (size_t)(row - MP) * 512 + cc;
                if (h) wstore<1>(ps, n, dst, vb); else wstore<0>(ps, n, dst, va); }
        }
    }
};
struct StU4 { u32x4 v; };
struct F2 {
    typedef StU4 State; typedef StU4 Pre;
    static constexpr bool ACC_INIT = false;
    struct UCtx { f32x4 brg[2], big[2], lm[2]; };
    __device__ __forceinline__ UCtx unit_ctx(int pn, int wc, int fq, int) const { UCtx u; const int ch = pn * 128 + wc * 32 + 8 * fq;
#pragma unroll
        for (int n = 0; n < 2; ++n) { u.brg[n] = *(const f32x4*)(b_rg + ch + 4 * n); u.big[n] = *(const f32x4*)(b_ig + ch + 4 * n); u.lm[n] = *(const f32x4*)(lam + ch + 4 * n); }
        return u; }
    const bf16_t* ca; const float* b_rg; const float* b_ig; const float* lam; const float* h0; bf16_t* la; bf16_t* bx; float* out_h;
    __device__ __forceinline__ Pre row_pre(int row, int fq, int pn, int wc, int) const { Pre p; p.v = *(const u32x4*)(ca + (size_t)row * 1024 + pn * 128 + wc * 32 + 8 * fq); return p; }
    __device__ __forceinline__ void row_begin(State& st, const Pre& p) const { st = p; }
    __device__ __forceinline__ void row_end(State&, int, int, int) const {}
    __device__ __forceinline__ void op(State& st, PkSt& ps, const UCtx& uc, int row, int pn, int, int lc, const int n, f32x4& a, f32x4& b) const {
        const int ch0 = pn * 128 + lc; const unsigned w0 = n ? st.v.z : st.v.x, w1 = n ? st.v.w : st.v.y;
        const f32x4 c4 = (f32x4){__uint_as_float(w0 << 16), __uint_as_float(w0 & 0xffff0000u), __uint_as_float(w1 << 16), __uint_as_float(w1 & 0xffff0000u)};
        const f32x4 r = sigm4(a + uc.brg[n]), ig = sigm4(b + uc.big[n]), l_a = r * uc.lm[n];
        f32x4 bxv;
#pragma unroll
        for (int j = 0; j < 4; ++j) bxv[j] = __builtin_amdgcn_sqrtf(fmaxf(1.0f - __expf(2.0f * l_a[j]), 0.f)) * ig[j] * c4[j];
        if (row < MP) { wstore<0>(ps, n, la + (size_t)row * 1024 + ch0, l_a); wstore<1>(ps, n, bx + (size_t)row * 1024 + ch0, bxv); }
        else { const size_t o = (size_t)(row - MP) * 1024 + ch0; const f32x4 hp = *(const f32x4*)(h0 + o); f32x4 h;
#pragma unroll
            for (int j = 0; j < 4; ++j) h[j] = __expf(l_a[j]) * hp[j] + bxv[j];
            *(f32x4*)(out_h + o) = h; wstore<0>(ps, n, la + (size_t)row * 1024 + ch0, h); }
    }
};
struct FEnd {
    typedef StNone State;
    static constexpr bool ACC_INIT = false;
    typedef StNone UCtx;
    __device__ __forceinline__ UCtx unit_ctx(int, int, int, int) const { return UCtx(); }
    float* ends;
    typedef StNone Pre;
    __device__ __forceinline__ Pre row_pre(int, int, int, int, int) const { return Pre(); }
    __device__ __forceinline__ void row_begin(State&, const Pre&) const {}
    __device__ __forceinline__ void row_end(State&, int, int, int) const {}
    __device__ __forceinline__ void op(State&, PkSt& ps, const UCtx& uc, int row, int, int g, int lc, const int n, f32x4& a, f32x4&) const { *(f32x4*)(ends + ((size_t)g * NCHK + row) * 128 + lc) = a; }
};
__device__ __forceinline__ float gelu_tanh(float x) { const float u = 0.7978845608028654f * (x + 0.044715f * x * x * x); return x * sigm(2.0f * u); }
struct StU8 { u32x2 v[4]; };
struct FS5 {
    typedef StU8 State; typedef StU8 Pre;
    static constexpr bool ACC_INIT = false;
    struct UCtx { f32x4 d[2]; };
    __device__ __forceinline__ UCtx unit_ctx(int, int, int fq, int g) const { UCtx u; u.d[0] = *(const f32x4*)(dsk + g * 16 + ((8 * fq) & 15)); u.d[1] = *(const f32x4*)(dsk + g * 16 + ((8 * fq + 4) & 15)); return u; }
    const bf16_t* ucg; const float* dsk; bf16_t* yc0;
    __device__ __forceinline__ Pre row_pre(int row, int fq, int, int wc, int g) const { Pre p; const bf16_t* base = ucg + ((size_t)g * NCHK + row) * KS5 + wc * 32 + 8 * fq;
#pragma unroll
        for (int n = 0; n < 2; ++n)
#pragma unroll
            for (int h = 0; h < 2; ++h) p.v[n * 2 + h] = *(const u32x2*)(base + 128 * h + 4 * n);
        return p; }
    __device__ __forceinline__ void row_begin(State& st, const Pre& p) const { st = p; }
    __device__ __forceinline__ void row_end(State&, int, int, int) const {}
    __device__ __forceinline__ void op(State& st, PkSt& ps, const UCtx& uc, int row, int, int g, int lc, const int n, f32x4& a, f32x4& b) const {
#pragma unroll
        for (int h = 0; h < 2; ++h) { const int col = lc + 128 * h, i = col >> 4, c0 = col & 15; const u32x2 w = st.v[n * 2 + h];
            const f32x4 u4 = (f32x4){__uint_as_float(w.x << 16), __uint_as_float(w.x & 0xffff0000u), __uint_as_float(w.y << 16), __uint_as_float(w.y & 0xffff0000u)};
            const f32x4 y = (h ? b : a) + uc.d[n] * u4;
            const f32x4 gy = (f32x4){gelu_tanh(y[0]), gelu_tanh(y[1]), gelu_tanh(y[2]), gelu_tanh(y[3])}; bf16_t* dp = yc0 + (size_t)(row * 16 + i) * 512 + g * 16 + c0;
            if (h) wstore<1>(ps, n, dp, gy); else wstore<0>(ps, n, dp, gy); }
    }
};
struct F4 {
    typedef StU8 State; typedef StU8 Pre;
    static constexpr bool ACC_INIT = false;
    struct UCtx { f32x4 b[2][2]; };
    __device__ __forceinline__ UCtx unit_ctx(int pn, int wc, int fq, int) const { UCtx u; const float* p = bg + pn * 256 + wc * 32 + 8 * fq;
#pragma unroll
        for (int n = 0; n < 2; ++n)
#pragma unroll
            for (int h = 0; h < 2; ++h) u.b[n][h] = *(const f32x4*)(p + 128 * h + 4 * n);
        return u; }
    const bf16_t* yc0; const float* bg; bf16_t* yc;
    __device__ __forceinline__ Pre row_pre(int row, int fq, int pn, int wc, int) const { Pre p; const bf16_t* base = yc0 + (size_t)row * 512 + pn * 256 + wc * 32 + 8 * fq;
#pragma unroll
        for (int n = 0; n < 2; ++n)
#pragma unroll
            for (int h = 0; h < 2; ++h) p.v[n * 2 + h] = *(const u32x2*)(base + 128 * h + 4 * n);
        return p; }
    __device__ __forceinline__ void row_begin(State& st, const Pre& p) const { st = p; }
    __device__ __forceinline__ void row_end(State&, int, int, int) const {}
    __device__ __forceinline__ void op(State& st, PkSt& ps, const UCtx& uc, int row, int pn, int, int lc, const int n, f32x4& a, f32x4& b) const {
#pragma unroll
        for (int h = 0; h < 2; ++h) { const int col = pn * 256 + lc + 128 * h; const u32x2 w = st.v[n * 2 + h];
            const f32x4 y4 = (f32x4){__uint_as_float(w.x << 16), __uint_as_float(w.x & 0xffff0000u), __uint_as_float(w.y << 16), __uint_as_float(w.y & 0xffff0000u)};
            const f32x4 yo = y4 * sigm4((h ? b : a) + uc.b[n][h]); if (h) wstore<1>(ps, n, yc + (size_t)row * 512 + col, yo); else wstore<0>(ps, n, yc + (size_t)row * 512 + col, yo); }
    }
};
struct FG8 {
    typedef StF State;
    static constexpr bool ACC_INIT = false;
    struct UCtx { f32x4 b[2][2]; };
    __device__ __forceinline__ UCtx unit_ctx(int pn, int wc, int fq, int) const { UCtx u; const float* p = bgate + pn * 256 + wc * 32 + 8 * fq;
#pragma unroll
        for (int n = 0; n < 2; ++n)
#pragma unroll
            for (int h = 0; h < 2; ++h) u.b[n][h] = *(const f32x4*)(p + 128 * h + 4 * n);
        return u; }
    const float* rsq; const float* bgate; unsigned char* g8;
    typedef f32x4 Pre;
    __device__ __forceinline__ Pre row_pre(int row, int fq, int, int, int) const { return *(const f32x4*)(rsq + (size_t)row * 16 + fq * 4); }
    __device__ __forceinline__ void row_begin(State& st, const Pre& p) const { st.x = rs_from4(p); }
    __device__ __forceinline__ void row_end(State&, int, int, int) const {}
    __device__ __forceinline__ void op(State& st, PkSt& ps, const UCtx& uc, int row, int pn, int, int lc, const int n, f32x4& a, f32x4& b) const {
#pragma unroll
        for (int h = 0; h < 2; ++h) { const int col = pn * 256 + lc + 128 * h; f32x4 g = sigm4((h ? b : a) * st.x + uc.b[(lc >> 2) & 1][h]) * 255.0f + 0.5f; g = __builtin_elementwise_max(g, (f32x4){1.f, 1.f, 1.f, 1.f});
            *(unsigned*)(g8 + g8row(row) + col) = (unsigned)g[0] | ((unsigned)g[1] << 8) | ((unsigned)g[2] << 16) | ((unsigned)g[3] << 24); }
    }
};
struct StG { unsigned w[8]; };
struct FMS {
    typedef StG State; typedef StG Pre;
    static constexpr bool ACC_INIT = false;
    typedef StNone UCtx;
    __device__ __forceinline__ UCtx unit_ctx(int, int, int, int) const { return UCtx(); }
    const unsigned char* g8; bf16_t* mrg;
    __device__ __forceinline__ Pre row_pre(int row, int fq, int pn, int wc, int seg) const { Pre p; const unsigned char* base = g8 + g8row(row) + seg * 1024 + pn * 256 + wc * 32 + 8 * fq;
#pragma unroll
        for (int n = 0; n < 2; ++n)
#pragma unroll
            for (int h = 0; h < 2; ++h) { p.w[(n * 2 + h) * 2] = *(const unsigned*)(base + 128 * h + 4 * n); p.w[(n * 2 + h) * 2 + 1] = (seg < 2) ? *(const unsigned*)(base + 1024 + 128 * h + 4 * n) : 0x01010101u; }
        return p; }
    __device__ __forceinline__ void row_begin(State& st, const Pre& p) const { st = p; }
    __device__ __forceinline__ void row_end(State&, int, int, int) const {}
    __device__ __forceinline__ void op(State& st, PkSt& ps, const UCtx& uc, int row, int pn, int seg, int lc, const int n, f32x4& a, f32x4& b) const {
#pragma unroll
        for (int h = 0; h < 2; ++h) { const unsigned gn = st.w[(n * 2 + h) * 2], gd = st.w[(n * 2 + h) * 2 + 1]; f32x4& v = h ? b : a;
            const f32x4 num = (f32x4){(float)(gn & 255u), (float)((gn >> 8) & 255u), (float)((gn >> 16) & 255u), (float)(gn >> 24)};
            if (seg < 2) { const f32x4 den = (f32x4){(float)(gd & 255u), (float)((gd >> 8) & 255u), (float)((gd >> 16) & 255u), (float)(gd >> 24)};
                v = v * num * (f32x4){__builtin_amdgcn_rcpf(den[0]), __builtin_amdgcn_rcpf(den[1]), __builtin_amdgcn_rcpf(den[2]), __builtin_amdgcn_rcpf(den[3])}; }
            else { const f32x4 mo = v * num * (1.0f / 255.0f); bf16_t* dp = mrg + (size_t)row * 1024 + pn * 256 + lc + 128 * h; if (h) wstore<1>(ps, n, dp, mo); else wstore<0>(ps, n, dp, mo); } }
    }
};
template <bool RES> struct F6T {
    typedef StF State;
    static constexpr bool ACC_INIT = !RES;
    typedef StNone UCtx;
    __device__ __forceinline__ UCtx unit_ctx(int, int, int, int) const { return UCtx(); }
    const float* xs_p; const float* xs_s; float* xd; bf16_t* xb; float* rsq;
    typedef StNone Pre;
    __device__ __forceinline__ Pre row_pre(int, int, int, int, int) const { return Pre(); }
    __device__ __forceinline__ void row_begin(State& st, const Pre&) const { st.x = 0.f; }
    __device__ __forceinline__ void row_end(State& st, int row, int pn, int wc) const {
        float ss = st.x; ss += __shfl_xor(ss, 16); ss += __shfl_xor(ss, 32);
        if ((__lane_id()) < 16) rsq[(size_t)row * 16 + pn * 4 + wc] = ss; }
    __device__ __forceinline__ void init(f32x4 (&acc)[2][2][4][2], int pm, int pn, int wr, int wc, int fr, int fq) const {
#pragma unroll
        for (int ai = 0; ai < 2; ++ai)
#pragma unroll
            for (int m = 0; m < 4; ++m) { const int row = pm * BM + ai * HALF + wr * 64 + m * 16 + fr;
                const float* src = ((row < MP) ? xs_p + (size_t)row * 1024 : xs_s + (size_t)(row - MP) * 1024) + pn * 256 + wc * 32 + 8 * fq;
#pragma unroll
                for (int bj = 0; bj < 2; ++bj)
#pragma unroll
                    for (int n = 0; n < 2; ++n) acc[ai][bj][m][n] = *(const f32x4*)(src + 128 * bj + 4 * n); }
    }
    __device__ __forceinline__ void op(State& st, PkSt& ps, const UCtx& uc, int row, int pn, int, int lc, const int n, f32x4& a, f32x4& b) const {
        const float* src = (row < MP) ? xs_p + (size_t)row * 1024 : xs_s + (size_t)(row - MP) * 1024;
#pragma unroll
        for (int h = 0; h < 2; ++h) { const int col = pn * 256 + lc + 128 * h; f32x4 v = (h ? b : a); if (RES) v += *(const f32x4*)(src + col);
            st.x += (v[0] * v[0] + v[1] * v[1]) + (v[2] * v[2] + v[3] * v[3]);
            *(f32x4*)(xd + (size_t)row * 1024 + col) = v; if (h) wstore<1>(ps, n, xb + (size_t)row * 1024 + col, v); else wstore<0>(ps, n, xb + (size_t)row * 1024 + col, v); }
    }
};
struct F7 {
    typedef StF State;
    static constexpr bool ACC_INIT = false;
    typedef StNone UCtx;
    __device__ __forceinline__ UCtx unit_ctx(int, int, int, int) const { return UCtx(); }
    const float* rsq; bf16_t* act;
    typedef f32x4 Pre;
    __device__ __forceinline__ Pre row_pre(int row, int fq, int, int, int) const { return *(const f32x4*)(rsq + (size_t)row * 16 + fq * 4); }
    __device__ __forceinline__ void row_begin(State& st, const Pre& p) const { st.x = rs_from4(p); }
    __device__ __forceinline__ void row_end(State&, int, int, int) const {}
    __device__ __forceinline__ void op(State& st, PkSt& ps, const UCtx& uc, int row, int pn, int, int lc, const int n, f32x4& a, f32x4& b) const {
        if (row >= MT) return;
        const f32x4 gte = a * st.x, up = b * st.x; wstore<0>(ps, n, act + (size_t)row * DFF + pn * 128 + lc, gte * sigm4(gte) * up);
    }
};

template <int MODE> __device__ __forceinline__ int srccol(int n) {
    if (MODE == 1) { if (n >= 1024 && n < 2048) { const int q = (n - 1024) >> 8, r = (n - 1024) & 255; return r < 128 ? 1024 + 128 * q + r : 1536 + 128 * q + (r - 128); } return n; }
    if (MODE == 2) { const int t = n >> 8, r = n & 255; return r < 128 ? 128 * t + r : DFF + 128 * t + (r - 128); }
    return n;
}
template <int MODE>
__device__ __forceinline__ int conv_T(LAS float* tile, const float* src, int ldsrc, const float* scale, bf16_t* dst, int ldd, int N, int K, int nb, int bi, int base) {
    const int tid = otid(), ntn = N >> 8, ntiles = ntn * (K >> 6);
    int t = bi - (base % nb); if (t < 0) t += nb;
    const int q = tid & 63, kr = tid >> 6; f32x4 v[8]; float sc8[8];
#define CT_LOAD(tt) do { const int n0_ = ((tt) % ntn) << 8, k0_ = ((tt) / ntn) << 6, sc_ = srccol<MODE>(n0_ + 4 * q); \
        _Pragma("unroll") for (int i = 0; i < 8; ++i) { v[i] = *(const f32x4*)(src + (size_t)(k0_ + i * 8 + kr) * ldsrc + sc_); sc8[i] = scale ? scale[k0_ + i * 8 + kr] : 1.0f; } } while (0)
    if (t < ntiles) CT_LOAD(t);
    for (; t < ntiles; t += nb) {
        const int n0 = (t % ntn) << 8, k0 = (t / ntn) << 6;
#pragma unroll
        for (int i = 0; i < 8; ++i) *(LAS f32x4*)(tile + (i * 8 + kr) * 260 + 4 * q) = v[i] * sc8[i];
        __syncthreads();
        if (t + nb < ntiles) CT_LOAD(t + nb);
        { const int n = tid >> 1, kh = tid & 1;
#pragma unroll
          for (int j4 = 0; j4 < 4; ++j4) { float w[8];
#pragma unroll
              for (int j = 0; j < 8; ++j) w[j] = tile[(kh * 32 + j4 * 8 + j) * 260 + n];
              store8(dst + (size_t)(n0 + n) * ldd + k0 + kh * 32 + j4 * 8, w); } }
        __syncthreads();
    }
#undef CT_LOAD
    return base + ntiles;
}

__device__ __forceinline__ void s5_build(KArgsP a, int l, int g, LAS unsigned char* lds, const int part, const int nparts) {
    const int tid = otid();
    LAS float* apr = (LAS float*)lds; LAS float* api = apr + 17 * 64; LAS float* bbr = api + 17 * 64; LAS float* bbi = bbr + 1024;
    LAS float* ccr = bbi + 1024; LAS float* cci = ccr + 1024; LAS float* kk = cci + 1024;
    const float* lam_re = a->in[20] + (size_t)(l * 32 + g) * 64; const float* lam_im = a->in[21] + (size_t)(l * 32 + g) * 64;
    const float dt = expf(a->in[22][l * 32 + g]);
    bf16_t* TF = (bf16_t*)(a->ws + OFF_TF); bf16_t* ET = (bf16_t*)(a->ws + OFF_ET); float* TAB = (float*)(a->ws + OFF_TAB);
    for (int idx = tid; idx < 17 * 64; idx += 512) { const int d = idx >> 6, p = idx & 63; const float lr = lam_re[p], li = lam_im[p];
        const float mag = expf((float)d * lr * dt);
        double x = (double)d * (double)li * (double)dt; x -= 6.283185307179586 * rint(x * 0.15915494309189535); const float xr = (float)x;
        apr[idx] = mag * cosf(xr); api[idx] = mag * sinf(xr); }
    __syncthreads();
    for (int idx = tid; idx < 1024; idx += 512) { const int p = idx >> 4; const float lr = lam_re[p], li = lam_im[p], ar = apr[64 + p], ai = api[64 + p], den = lr * lr + li * li;
        const float qr = ((ar - 1.0f) * lr + ai * li) / den, qi = (ai * lr - (ar - 1.0f) * li) / den;
        const float br = a->in[23][(size_t)(l * 32 + g) * 1024 + idx], bi = a->in[24][(size_t)(l * 32 + g) * 1024 + idx];
        bbr[idx] = qr * br - qi * bi; bbi[idx] = qr * bi + qi * br;
        ccr[idx] = a->in[25][(size_t)(l * 32 + g) * 1024 + idx]; cci[idx] = a->in[26][(size_t)(l * 32 + g) * 1024 + idx]; }
    __syncthreads();
    if (part == 0 && tid < 64) { TAB[(g * 64 + tid) * 2] = apr[64 + tid]; TAB[(g * 64 + tid) * 2 + 1] = api[64 + tid]; TAB[4096 + (g * 64 + tid) * 2] = apr[16 * 64 + tid]; TAB[4096 + (g * 64 + tid) * 2 + 1] = api[16 * 64 + tid]; }
    if (part == 0) for (int idx = tid; idx < 1024; idx += 512) { TAB[8192 + ((size_t)g * 1024 + idx) * 2] = bbr[idx]; TAB[8192 + ((size_t)g * 1024 + idx) * 2 + 1] = bbi[idx]; }
    for (int idx = tid; idx < 4096; idx += 512) { const int d = idx >> 8, c = (idx >> 4) & 15, c2 = idx & 15; float s = 0.f;
        for (int p = 0; p < 64; ++p) { const float Pr = apr[d * 64 + p], Pi = api[d * 64 + p], Br = bbr[p * 16 + c2], Bi = bbi[p * 16 + c2];
            const float Wr = Pr * Br - Pi * Bi, Wi = Pr * Bi + Pi * Br; s += ccr[c * 64 + p] * Wr - cci[c * 64 + p] * Wi; }
        kk[idx] = s; }
    __syncthreads();
    const int tfn = 256 / nparts, etn = 128 / nparts;
    for (int idx = part * tfn * KS5 + tid; idx < (part + 1) * tfn * KS5; idx += 512) { const int n = idx / KS5, k = idx % KS5, i = n >> 4, c = n & 15; float v;
        if (k < 256) { const int j = k >> 4, c2 = k & 15; v = (i >= j) ? kk[(i - j) * 256 + c * 16 + c2] : 0.f; }
        else if (k < 320) { const int p = k - 256; v = ccr[c * 64 + p] * apr[(i + 1) * 64 + p] - cci[c * 64 + p] * api[(i + 1) * 64 + p]; }
        else { const int p = k - 320; v = -(ccr[c * 64 + p] * api[(i + 1) * 64 + p] + cci[c * 64 + p] * apr[(i + 1) * 64 + p]); }
        TF[((size_t)g * 256 + n) * KS5 + k] = f2bf(v); }
    for (int idx = part * etn * 256 + tid; idx < (part + 1) * etn * 256; idx += 512) { const int n = idx >> 8, k = idx & 255, p = n & 63, j = k >> 4, c2 = k & 15, d = 15 - j;
        const float Pr = apr[d * 64 + p], Pi = api[d * 64 + p], Br = bbr[p * 16 + c2], Bi = bbi[p * 16 + c2];
        ET[((size_t)g * 128 + n) * 256 + k] = f2bf(n < 64 ? (Pr * Br - Pi * Bi) : (Pr * Bi + Pi * Br)); }
    if (g == 31 && part == 0) for (int idx = tid; idx < 128 * 256; idx += 512) ET[(size_t)32 * 128 * 256 + idx] = 0;
    __syncthreads();
}

__device__ __forceinline__ void phase0(KArgsP a, int l, LAS unsigned char* lds) {
    const int tid = otid(), blk = blockIdx.x, nblk = gridDim.x;
    LAS float* tile = (LAS float*)lds; unsigned char* ws = a->ws;
    const int nsb = (nblk >= 256) ? 128 : 0, nb = nblk - nsb;
    if (blk < nb) { int base = 0;
        base = conv_T<1>(tile, a->in[8] + (size_t)l * 1024 * INW, INW, a->in[7] + l * 1024, (bf16_t*)(ws + OFF_WIN), 1024, INW, 1024, nb, blk, base);
        base = conv_T<2>(tile, a->in[36] + (size_t)l * 1024 * INW, INW, a->in[35] + l * 1024, (bf16_t*)(ws + OFF_WF1), 1024, INW, 1024, nb, blk, base);
        base = conv_T<0>(tile, a->in[37] + (size_t)l * DFF * 1024, 1024, nullptr, (bf16_t*)(ws + OFF_WF2), DFF, 1024, DFF, nb, blk, base);
        base = conv_T<0>(tile, a->in[31] + (size_t)l * 1024 * 1024, 1024, nullptr, (bf16_t*)(ws + OFF_WPA), 1024, 1024, 1024, nb, blk, base);
        base = conv_T<0>(tile, a->in[34] + (size_t)l * 1024 * 1024, 1024, nullptr, (bf16_t*)(ws + OFF_WOUT), 1024, 1024, 1024, nb, blk, base);
        base = conv_T<0>(tile, a->in[32] + (size_t)l * 512 * 1024, 1024, nullptr, (bf16_t*)(ws + OFF_WPB), 512, 1024, 512, nb, blk, base);
        base = conv_T<0>(tile, a->in[33] + (size_t)l * 512 * 1024, 1024, nullptr, (bf16_t*)(ws + OFF_WPC), 512, 1024, 512, nb, blk, base);
        base = conv_T<0>(tile, a->in[28] + (size_t)l * 512 * 512, 512, nullptr, (bf16_t*)(ws + OFF_WGLU), 512, 512, 512, nb, blk, base);
    }
    { bf16_t* wgt = (bf16_t*)(ws + OFF_WGT); const float* wrg = a->in[11] + (size_t)l * 8 * 128 * 128; const float* wig = a->in[13] + (size_t)l * 8 * 128 * 128;
      for (int idx = blk * 512 + tid; idx < 2048 * 256; idx += nblk * 512) { const int n = idx >> 8, k = idx & 255, h = n >> 8, s = (n >> 7) & 1, j = n & 127; float v = 0.f;
          if ((k >> 7) == (h & 1)) v = (s ? wig : wrg)[((size_t)h * 128 + (k & 127)) * 128 + j];
          wgt[idx] = f2bf(v); } }
    { float* TAB = (float*)(ws + OFF_TAB); for (int idx = blk * 512 + tid; idx < 1024; idx += nblk * 512) TAB[TAB_LAM + idx] = -8.0f * log1pf(expf(-a->in[15][l * 1024 + idx])); }
    if (nsb) { if (blk >= nb) s5_build(a, l, (blk - nb) >> 2, lds, (blk - nb) & 3, 4); } else { for (int g = blk; g < 32; g += nblk) s5_build(a, l, g, lds, 0, 1); }
    if (l == 0) {
        bf16_t* xb = (bf16_t*)(ws + OFF_XB); float* rsq = (float*)(ws + OFF_RSQ); const int wv = tid >> 6, lane = tid & 63;
        f32x4 vn[4]; const int rstep = nblk * 8; int row = blk * 8 + wv;
        if (row < MT) { const float* src = (row < MP) ? a->in[0] + (size_t)row * 1024 : a->in[1] + (size_t)(row - MP) * 1024;
#pragma unroll
            for (int i = 0; i < 4; ++i) vn[i] = *(const f32x4*)(src + i * 256 + lane * 4); }
        for (; row < MT; row += rstep) { f32x4 vc[4]; float ss = 0.f;
#pragma unroll
            for (int i = 0; i < 4; ++i) vc[i] = vn[i];
            if (row + rstep < MT) { const int rn = row + rstep; const float* src = (rn < MP) ? a->in[0] + (size_t)rn * 1024 : a->in[1] + (size_t)(rn - MP) * 1024;
#pragma unroll
                for (int i = 0; i < 4; ++i) vn[i] = *(const f32x4*)(src + i * 256 + lane * 4); }
#pragma unroll
            for (int i = 0; i < 4; ++i) { const f32x4 v = vc[i]; ss += v[0] * v[0] + v[1] * v[1] + v[2] * v[2] + v[3] * v[3];
                u32x2 w; w.x = cvt_pk_bf16(v[0], v[1]); w.y = cvt_pk_bf16(v[2], v[3]); *(u32x2*)(xb + (size_t)row * 1024 + i * 256 + lane * 4) = w; }
            ss = wave_sum(ss); if (lane < 16) rsq[(size_t)row * 16 + lane] = (lane == 0) ? ss : 0.f; }
    }
}

__device__ __forceinline__ void conv_a_phase(KArgsP a, int l) {
    const bf16_t* ua = (const bf16_t*)(a->ws + OFF_SA); bf16_t* ca = (bf16_t*)(a->ws + OFF_SB);
    const float* w = a->in[9] + (size_t)l * 4 * 1024; const float* bias = a->in[10] + (size_t)l * 1024;
    const int tid = otid();
    const int c8 = (tid & 127) * 8;
    float wv[4][8], bv[8];
#pragma unroll
    for (int k = 0; k < 4; ++k) { const f32x4 p = *(const f32x4*)(w + k * 1024 + c8), q = *(const f32x4*)(w + k * 1024 + c8 + 4);
#pragma unroll
        for (int j = 0; j < 4; ++j) { wv[k][j] = p[j]; wv[k][4 + j] = q[j]; } }
    { const f32x4 p = *(const f32x4*)(bias + c8), q = *(const f32x4*)(bias + c8 + 4);
#pragma unroll
      for (int j = 0; j < 4; ++j) { bv[j] = p[j]; bv[4 + j] = q[j]; } }
    const int step = gridDim.x * 512; int idx = blockIdx.x * 512 + tid;
    u32x4 xv[4];
    if (idx < MT * 128) { const int row = idx >> 7;
#pragma unroll
        for (int k = 0; k < 4; ++k) { const int rr = row - 3 + k; xv[k] = *(const u32x4*)(ua + (size_t)(rr < 0 ? 0 : rr) * 1024 + c8); } }
    for (; idx < MT * 128; idx += step) {
        const int row = idx >> 7; float acc[8], x[8]; u32x4 xc[4];
#pragma unroll
        for (int k = 0; k < 4; ++k) xc[k] = xv[k];
        if (idx + step < MT * 128) { const int rown = (idx + step) >> 7;
#pragma unroll
            for (int k = 0; k < 4; ++k) { const int rr = rown - 3 + k; xv[k] = *(const u32x4*)(ua + (size_t)(rr < 0 ? 0 : rr) * 1024 + c8); } }
#pragma unroll
        for (int j = 0; j < 8; ++j) acc[j] = bv[j];
        unpack8(xc[3], x);
        if (row < MP) { const int t = row & (SEQ - 1), b = row >> 11;
#pragma unroll
            for (int k = 0; k < 4; ++k) { if (t - 3 + k >= 0) { float xk[8]; unpack8(xc[k], xk);
#pragma unroll
                for (int j = 0; j < 8; ++j) acc[j] += wv[k][j] * xk[j]; } }
            if (t >= SEQ - 3) { float* o = a->out + O_PLC + (((size_t)l * NBATCH + b) * 3 + (t - (SEQ - 3))) * 1024 + c8;
#pragma unroll
                for (int j = 0; j < 8; ++j) o[j] = x[j]; }
        } else { const int s = row - MP; const float* st = a->in[2] + ((size_t)l * MS + s) * 3 * 1024 + c8; float* o = a->out + O_SLC + ((size_t)l * MS + s) * 3 * 1024 + c8;
#pragma unroll
            for (int j = 0; j < 8; ++j) { const float s0 = st[j], s1 = st[1024 + j], s2 = st[2048 + j];
                acc[j] += wv[0][j] * s0 + wv[1][j] * s1 + wv[2][j] * s2 + wv[3][j] * x[j]; o[j] = s1; o[1024 + j] = s2; o[2048 + j] = x[j]; }
        }
        store8(ca + (size_t)row * 1024 + c8, acc);
    }
}

__device__ __forceinline__ void cfm_phase(KArgsP a, int l, LAS unsigned char* lds) {
    const int tid = otid(), half = tid >> 8, cp = tid & 255, wv = tid >> 6, lane = tid & 63;
    const bf16_t* glu = (const bf16_t*)(a->ws + OFF_SE); bf16_t* yb = (bf16_t*)(a->ws + OFF_YB);
    LAS unsigned* in = (LAS unsigned*)lds;
    LAS float* part = (LAS float*)(lds + 62 * 1024);
    const float* wdw = a->in[16] + (size_t)l * 31 * 512 + 2 * cp;
    typedef float f32x2 __attribute__((ext_vector_type(2)));
    LAS f32x2* wl = (LAS f32x2*)(lds + 65536);
    for (int idx = tid; idx < 31 * 256; idx += 512) { const f32x2 wk = *(const f32x2*)(a->in[16] + (size_t)l * 31 * 512 + 2 * idx);
        u32x2 pk; pk.x = cvt_pk_bf16(wk.x, 0.f); pk.y = cvt_pk_bf16(0.f, wk.y); ((LAS u32x2*)wl)[idx] = pk; }
    const float bs0 = a->in[17][l * 512 + 2 * cp], bs1 = a->in[17][l * 512 + 2 * cp + 1];
    const float lg0 = a->in[18][l * 512 + 2 * cp], lg1 = a->in[18][l * 512 + 2 * cp + 1], lb0 = a->in[19][l * 512 + 2 * cp], lb1 = a->in[19][l * 512 + 2 * cp + 1];
    u32x4 pv[8];
#define CFM_LOAD(tl) do { const int b_ = (tl) >> 6, t0_ = ((tl) & 63) * 32; \
        _Pragma("unroll") for (int i = 0; i < 8; ++i) { const int idx = tid + 512 * i, r = idx >> 6, c16 = idx & 63, t = t0_ - 30 + r; pv[i] = (u32x4){0u, 0u, 0u, 0u}; \
            if (idx < 62 * 64 && t >= 0) pv[i] = *(const u32x4*)(glu + ((size_t)b_ * SEQ + t) * 512 + c16 * 8); } } while (0)
    if ((int)blockIdx.x < 512) CFM_LOAD((int)blockIdx.x);
    const int ntl = (gridDim.x == 256) ? 768 : 512 + 64;
    for (int tile0 = blockIdx.x; tile0 < ntl; tile0 += gridDim.x) {
        int tile = tile0;
        if (gridDim.x == 256 && tile0 >= 512) { tile = 512 + (((int)blockIdx.x + 64) & 255); if (tile >= 512 + 64) continue; }
        if (tile < 512) {
            const int b = tile >> 6, t0 = (tile & 63) * 32;
#pragma unroll
            for (int i = 0; i < 8; ++i) { const int idx = tid + 512 * i; if (idx < 62 * 64) *(LAS u32x4*)(in + (idx >> 6) * 256 + (idx & 63) * 4) = pv[i]; }
            if (tile + (int)gridDim.x < 512) CFM_LOAD(tile + (int)gridDim.x);
            __syncthreads();
            float val0[16], val1[16];
#pragma unroll
            for (int j = 0; j < 16; ++j) { val0[j] = bs0; val1[j] = bs1; }
#pragma unroll 1
            for (int k = 0; k < 31; ++k) { const u32x2 wk = ((const LAS u32x2*)wl)[k * 256 + cp]; const LAS unsigned* ip = in + (half * 16 + k) * 256 + cp;
#pragma unroll
                for (int j = 0; j < 16; ++j) { const unsigned xw = ip[j * 256];
                    asm("v_dot2c_f32_bf16 %0, %1, %2" : "+v"(val0[j]) : "v"(xw), "v"(wk.x));
                    asm("v_dot2c_f32_bf16 %0, %1, %2" : "+v"(val1[j]) : "v"(xw), "v"(wk.y)); } }
#pragma unroll
            for (int ti = 0; ti < 16; ++ti) { float s = val0[ti] + val1[ti], q = val0[ti] * val0[ti] + val1[ti] * val1[ti]; s = wave_sum(s); q = wave_sum(q);
                if (lane == 0) { part[((half * 16 + ti) * 4 + (wv & 3)) * 2] = s; part[((half * 16 + ti) * 4 + (wv & 3)) * 2 + 1] = q; } }
            if (t0 + 32 == SEQ) {
                float* o = a->out + O_PCC + ((size_t)l * NBATCH + b) * 30 * 512;
                for (int idx = tid; idx < 30 * 256; idx += 512) { const int r = idx >> 8, c = idx & 255; const unsigned xw = in[(32 + r) * 256 + c]; o[r * 512 + 2 * c] = __uint_as_float(xw << 16); o[r * 512 + 2 * c + 1] = __uint_as_float(xw & 0xffff0000u); } }
            __syncthreads();
#pragma unroll
            for (int ti = 0; ti < 16; ++ti) { const LAS float* pp = part + (half * 16 + ti) * 8; const float S = (pp[0] + pp[2]) + (pp[4] + pp[6]), Q = (pp[1] + pp[3]) + (pp[5] + pp[7]);
                const float mean = S * (1.0f / 512.0f), var = fmaxf(Q * (1.0f / 512.0f) - mean * mean, 0.f), rstd = rsqrtf(var + EPS);
                float y0 = (val0[ti] - mean) * rstd * lg0 + lb0, y1 = (val1[ti] - mean) * rstd * lg1 + lb1; y0 *= sigm(y0); y1 *= sigm(y1);
                *(unsigned*)(yb + ((size_t)b * SEQ + t0 + half * 16 + ti) * 512 + 2 * cp) = cvt_pk_bf16(y0, y1); }
            __syncthreads();
        } else {
            const int s = (tile - 512) * 2 + half; const float* st = a->in[4] + ((size_t)l * MS + s) * 30 * 512 + 2 * cp; float* o = a->out + O_SCC + ((size_t)l * MS + s) * 30 * 512 + 2 * cp;
            float a0 = bs0, a1 = bs1;
#pragma unroll 2
            for (int k = 0; k < 30; ++k) { const float x0 = st[k * 512], x1 = st[k * 512 + 1]; a0 += wdw[k * 512] * x0; a1 += wdw[k * 512 + 1] * x1; if (k >= 1) { o[(k - 1) * 512] = x0; o[(k - 1) * 512 + 1] = x1; } }
            { const unsigned xw = *(const unsigned*)(glu + (size_t)(MP + s) * 512 + 2 * cp); const float x0 = __uint_as_float(xw << 16), x1 = __uint_as_float(xw & 0xffff0000u);
              a0 += wdw[30 * 512] * x0; a1 += wdw[30 * 512 + 1] * x1; o[29 * 512] = x0; o[29 * 512 + 1] = x1; }
            float sm = wave_sum(a0 + a1), q = wave_sum(a0 * a0 + a1 * a1);
            if (lane == 0) { part[(half * 4 + (wv & 3)) * 2] = sm; part[(half * 4 + (wv & 3)) * 2 + 1] = q; }
            __syncthreads();
            { const LAS float* pp = part + half * 8; const float S = (pp[0] + pp[2]) + (pp[4] + pp[6]), Q = (pp[1] + pp[3]) + (pp[5] + pp[7]);
              const float mean = S * (1.0f / 512.0f), var = fmaxf(Q * (1.0f / 512.0f) - mean * mean, 0.f), rstd = rsqrtf(var + EPS);
              float y0 = (a0 - mean) * rstd * lg0 + lb0, y1 = (a1 - mean) * rstd * lg1 + lb1; y0 *= sigm(y0); y1 *= sigm(y1);
              *(unsigned*)(yb + (size_t)(MP + s) * 512 + 2 * cp) = cvt_pk_bf16(y0, y1); }
            __syncthreads();
        }
    }
}

#undef CFM_LOAD
__device__ __forceinline__ void s5_sample(KArgsP a, int l) {
    const int tid = otid(); const int wv = tid >> 6, p = tid & 63; const float* TAB = (const float*)(a->ws + OFF_TAB);
    const bf16_t* ucs = (const bf16_t*)(a->ws + OFF_UCS); bf16_t* yc0 = (bf16_t*)(a->ws + OFF_SE);
    for (int w = blockIdx.x * 8 + wv; w < MS * 32; w += gridDim.x * 8) { const int s = w >> 5, g = w & 31;
        float u[16]; load8(ucs + (size_t)s * 512 + g * 16, u); load8(ucs + (size_t)s * 512 + g * 16 + 8, u + 8);
        const float ar = TAB[(g * 64 + p) * 2], ai = TAB[(g * 64 + p) * 2 + 1]; const float* bb = TAB + 8192 + ((size_t)g * 1024 + p * 16) * 2;
        const size_t si = (((size_t)l * MS + s) * 32 + g) * 64 + p; const float s0r = a->in[5][si], s0i = a->in[6][si];
        float xr = ar * s0r - ai * s0i, xi = ar * s0i + ai * s0r;
#pragma unroll
        for (int c = 0; c < 16; ++c) { xr += bb[2 * c] * u[c]; xi += bb[2 * c + 1] * u[c]; }
        a->out[O_SSR + si] = xr; a->out[O_SSI + si] = xi;
        const float* cr = a->in[25] + (size_t)(l * 32 + g) * 1024; const float* ci = a->in[26] + (size_t)(l * 32 + g) * 1024; float mine = 0.f;
#pragma unroll
        for (int c = 0; c < 16; ++c) { const float t = wave_sum(cr[c * 64 + p] * xr - ci[c * 64 + p] * xi); if (p == c) mine = t; }
        float up = 0.f;
#pragma unroll
        for (int c = 0; c < 16; ++c) up = (p == c) ? u[c] : up;
        if (p < 16) yc0[(size_t)(MP + s) * 512 + g * 16 + p] = f2bf(gelu_tanh(mine + a->in[27][l * 512 + g * 16 + p] * up));
    }
}

__device__ __forceinline__ void s5_carry_bg(KArgsP a, int l, LAS unsigned char* lds, const int b, const int g) {
    const int tid = otid(), seg = tid >> 6, p = tid & 63; const float* TAB = (const float*)(a->ws + OFF_TAB);
    const float* ends = (const float*)(a->ws + OFF_SF); bf16_t* ucg = (bf16_t*)(a->ws + OFF_UCG); LAS float* sT = (LAS float*)lds;
    {
        const float ar = TAB[4096 + (g * 64 + p) * 2], ai = TAB[4096 + (g * 64 + p) * 2 + 1];
        const size_t c0 = (size_t)g * NCHK + b * 128 + seg * 16; float er[16], ei[16];
#pragma unroll
        for (int k = 0; k < 16; ++k) { er[k] = ends[(c0 + k) * 128 + p]; ei[k] = ends[(c0 + k) * 128 + 64 + p]; }
        float Lr[17], Li[17]; Lr[0] = 0.f; Li[0] = 0.f;
#pragma unroll
        for (int k = 0; k < 16; ++k) { Lr[k + 1] = ar * Lr[k] - ai * Li[k] + er[k]; Li[k + 1] = ar * Li[k] + ai * Lr[k] + ei[k]; }
        sT[(seg * 64 + p) * 2] = Lr[16]; sT[(seg * 64 + p) * 2 + 1] = Li[16];
        __syncthreads();
        float br = ar, bi = ai;
#pragma unroll
        for (int i = 0; i < 4; ++i) { const float t = br * br - bi * bi; bi = 2.f * br * bi; br = t; }
        float Sr = 0.f, Si = 0.f;
        for (int s2 = 0; s2 < seg; ++s2) { const float tr = sT[(s2 * 64 + p) * 2], ti = sT[(s2 * 64 + p) * 2 + 1]; const float nr = br * Sr - bi * Si + tr; Si = br * Si + bi * Sr + ti; Sr = nr; }
        float pr = 1.f, pi = 0.f;
#pragma unroll
        for (int k = 0; k < 16; ++k) { const float vr = Lr[k] + pr * Sr - pi * Si, vi = Li[k] + pr * Si + pi * Sr;
            ucg[(c0 + k) * KS5 + 256 + p] = f2bf(vr); ucg[(c0 + k) * KS5 + 320 + p] = f2bf(vi);
            const float t = pr * ar - pi * ai; pi = pr * ai + pi * ar; pr = t; }
        if (seg == 7) { const size_t o = (((size_t)l * NBATCH + b) * 32 + g) * 64 + p; a->out[O_PSR + o] = Lr[16] + br * Sr - bi * Si; a->out[O_PSI + o] = Li[16] + br * Si + bi * Sr; }
        __syncthreads();
    }
}
__device__ __forceinline__ void s5_carry(KArgsP a, int l, LAS unsigned char* lds) { for (int w = blockIdx.x; w < NBATCH * 32; w += gridDim.x) s5_carry_bg(a, l, lds, w >> 5, w & 31); }

__device__ __forceinline__ void lru_scan(KArgsP a, int l, LAS unsigned char* lds, bf16_t* dst_alt) {
    const int tid = otid(), cq = tid & 7, chunk = tid >> 3;
    bf16_t* la = (bf16_t*)(a->ws + OFF_SA); const bf16_t* bx = (const bf16_t*)(a->ws + OFF_SC);
    LAS f32x4* sP = (LAS f32x4*)lds; LAS f32x4* sH = sP + 64 * 8;
    for (int w = blockIdx.x; w < NBATCH * 32; w += gridDim.x) { const int b = w >> 5, cg_ = w & 31;
        const size_t base = ((size_t)b * SEQ + chunk * 32) * 1024 + cg_ * 32 + cq * 4;
        f32x4 P = (f32x4){1.f, 1.f, 1.f, 1.f}, h = (f32x4){0.f, 0.f, 0.f, 0.f};
        u32x2 lw[32], bw[32];
#pragma unroll
        for (int j = 0; j < 32; ++j) { lw[j] = *(const u32x2*)(la + base + (size_t)j * 1024); bw[j] = *(const u32x2*)(bx + base + (size_t)j * 1024); }
#pragma unroll
        for (int j = 0; j < 32; ++j) { const f32x4 av = (f32x4){__expf(bf2f(lw[j].x & 0xffffu)), __expf(bf2f(lw[j].x >> 16)), __expf(bf2f(lw[j].y & 0xffffu)), __expf(bf2f(lw[j].y >> 16))};
            const f32x4 bv = (f32x4){bf2f(bw[j].x & 0xffffu), bf2f(bw[j].x >> 16), bf2f(bw[j].y & 0xffffu), bf2f(bw[j].y >> 16)};
            h = av * h + bv; P = P * av; }
        sP[chunk * 8 + cq] = P; sH[chunk * 8 + cq] = h;
        __syncthreads();
        f32x4 cin = (f32x4){0.f, 0.f, 0.f, 0.f};
        for (int c2 = 0; c2 < chunk; ++c2) cin = sP[c2 * 8 + cq] * cin + sH[c2 * 8 + cq];
        h = cin;
#pragma unroll
        for (int j = 0; j < 32; ++j) { asm volatile("" : "+v"(lw[j].x), "+v"(lw[j].y), "+v"(bw[j].x), "+v"(bw[j].y));
            const f32x4 av = (f32x4){__expf(bf2f(lw[j].x & 0xffffu)), __expf(bf2f(lw[j].x >> 16)), __expf(bf2f(lw[j].y & 0xffffu)), __expf(bf2f(lw[j].y >> 16))};
            const f32x4 bv = (f32x4){bf2f(bw[j].x & 0xffffu), bf2f(bw[j].x >> 16), bf2f(bw[j].y & 0xffffu), bf2f(bw[j].y >> 16)};
            h = av * h + bv; u32x2 o; o.x = cvt_pk_bf16(h[0], h[1]); o.y = cvt_pk_bf16(h[2], h[3]); *(u32x2*)(dst_alt + base + (size_t)j * 1024) = o; }
        if (chunk == 63) *(f32x4*)(a->out + O_PLH + ((size_t)l * NBATCH + b) * 1024 + cg_ * 32 + cq * 4) = h;
        __syncthreads();
    }
}


#define XB_TMO      128
#define XB_XCNT(j)  (256  + 64 * (j))
#define XB_XSUB(j)  (1280 + 64 * (j))
#define XB_XGEN(j)  (2304 + 64 * (j))
#define XB_TOP      3328
#define XB_TOPGEN   3392
#define XCD_BAR_WORDS 3456
#define XB_SPIN_CAP (1u << 18)
__device__ __forceinline__ unsigned xb_ld(unsigned* p)              { return __hip_atomic_load(p, __ATOMIC_RELAXED, __HIP_MEMORY_SCOPE_AGENT); }
__device__ __forceinline__ unsigned xb_add(unsigned* p, unsigned v) { return __hip_atomic_fetch_add(p, v, __ATOMIC_RELAXED, __HIP_MEMORY_SCOPE_AGENT); }
__device__ __forceinline__ unsigned xb_xcc_id() { return (unsigned)__builtin_amdgcn_s_getreg((3 << 11) | 20) & 0xFu; }
#define XB_SPIN(cond, bar) do { unsigned _sp = 0; while (cond) { __builtin_amdgcn_s_sleep(1); \
    if ((++_sp & 255u) == 0u) { if (xb_ld(&(bar)[XB_TMO])) break; if (_sp > XB_SPIN_CAP) { atomicAdd(&(bar)[XB_TMO], 1u); break; } } } } while (0)
__device__ __forceinline__ void xcd_barrier_complete(unsigned* bar, unsigned x, unsigned& nloc, unsigned& nx) {
    const unsigned G = gridDim.x * gridDim.y * gridDim.z;
    unsigned sum, cnt, mine, sp = 0u;
    for (;;) {
        sum = 0u; cnt = 0u; mine = 0u;
#pragma unroll
        for (unsigned j = 0; j < 16; ++j) { const unsigned c = xb_ld(&bar[XB_XCNT(j)]); sum += c; cnt += (c > 0u) ? 1u : 0u; mine = (j == x) ? c : mine; }
        if (sum == G) break;
        __builtin_amdgcn_s_sleep(1);
        if ((++sp & 255u) == 0u) { if (xb_ld(&bar[XB_TMO])) break; if (sp > XB_SPIN_CAP) { atomicAdd(&bar[XB_TMO], 1u); break; } }
    }
    nloc = mine > 0u ? mine : 1u; nx = cnt > 0u ? cnt : 1u;
}
__device__ __forceinline__ void xcd_barrier(unsigned* bar, volatile LAS unsigned* st) {
    asm volatile("s_waitcnt vmcnt(0)" ::: "memory");
    __syncthreads();
    if (threadIdx.x == 0) {
        const unsigned x = xb_xcc_id();
        __builtin_amdgcn_s_waitcnt(0);
        unsigned nloc = st[0], nx = st[1];
        if (nloc == 0u) { xcd_barrier_complete(bar, x, nloc, nx); st[0] = nloc; st[1] = nx; }
        const unsigned old = xb_add(&bar[XB_XSUB(x)], 1u);
        const unsigned gen = old / nloc;
        if (old + 1u == (gen + 1u) * nloc) {
            __builtin_amdgcn_fence(__ATOMIC_RELEASE, "agent");
            asm volatile("s_waitcnt vmcnt(0)" ::: "memory");
            const unsigned og = xb_add(&bar[XB_TOP], 1u);
            const unsigned tg = og / nx;
            if (og + 1u == (tg + 1u) * nx) xb_add(&bar[XB_TOPGEN], 1u);
            else XB_SPIN(xb_ld(&bar[XB_TOPGEN]) == tg, bar);
            __builtin_amdgcn_fence(__ATOMIC_ACQUIRE, "agent");
            xb_add(&bar[XB_XGEN(x)], 1u);
            asm volatile("s_waitcnt vmcnt(0)" ::: "memory");
        } else {
            XB_SPIN(xb_ld(&bar[XB_XGEN(x)]) == gen, bar);
            __builtin_amdgcn_fence(__ATOMIC_ACQUIRE, "agent");
            asm volatile("s_waitcnt vmcnt(0)" ::: "memory");
        }
    }
    __syncthreads();
}

#ifndef PROBE_DUP
#define PROBE_DUP -1
#endif
#define REP(k) for (int rep_ = 0; rep_ < ((PROBE_DUP) == (k) ? 2 : 1); ++rep_)
#define XBAR() xcd_barrier((unsigned*)(kargs()->ws + OFF_BAR), (volatile LAS unsigned*)(lds + 131072 + 512))
#define GSYNC() do { XBAR(); if ((PROBE_DUP) == 100) XBAR(); } while (0)
#ifndef PH_ONLY
#define PH_ON(n) true
#else
#define PH_ON(n) ((n) == PH_ONLY)
#endif
__global__ void __launch_bounds__(512) fwd_megakernel(KArgs a_by_value) {
    extern __shared__ __attribute__((aligned(16))) unsigned char lds_raw[];
    LAS unsigned char* lds = (LAS unsigned char*)lds_raw;
    cg::grid_group grid = cg::this_grid();
    { volatile LAS unsigned* st = (volatile LAS unsigned*)(lds + 131072 + 512); if (threadIdx.x == 0) { st[0] = 0u; st[1] = 0u; }
      __syncthreads();
      if (threadIdx.x == 0) (void)xb_add((unsigned*)(kargs()->ws + OFF_BAR) + XB_XCNT(xb_xcc_id()), 1u); }
    grid.sync();
#define WSB(off) ((bf16_t*)(ws + (off)))
#define PH_HEAD KArgsP a = kargs(); unsigned char* ws = a->ws; const int G = gridDim.x, c = oblk(); (void)G; (void)c; (void)ws;

    for (int l = 0; l < NLAYER; ++l) {
        REP(0) if (PH_ON(0)) { PH_HEAD phase0(a, l, lds); }
        GSYNC();
        REP(1) if (PH_ON(1)) { PH_HEAD
          Sched S{65, 10, 1, G, c, 0, (const char*)WSB(OFF_XB), (const char*)WSB(OFF_WIN), 0, 0, (size_t)256 * 1024 * 2, (size_t)256 * 1024 * 2};
          F1 f{(const float*)(ws + OFF_RSQ), WSB(OFF_SA), WSB(OFF_SE), WSB(OFF_UCG), WSB(OFF_UCS)};
          gemm_phase(lds, 1024, 1024, 16, S, f); }
        GSYNC();
        REP(20) if (PH_ON(20)) { PH_HEAD conv_a_phase(a, l); }
        REP(21) if (PH_ON(21)) { PH_HEAD cfm_phase(a, l, lds); }
        REP(22) if (PH_ON(22)) { PH_HEAD
          Sched S{4, 1, 32, G, c, 0, (const char*)WSB(OFF_UCG), (const char*)(ws + OFF_ET), (size_t)NCHK * KS5 * 2, (size_t)128 * 256 * 2, (size_t)256 * KS5 * 2, 0};
          FEnd f{(float*)(ws + OFF_SF)};
          gemm_phase(lds, KS5, 256, 4, S, f);
          if (G == 256) { Unit u; if (S.next(0, u)) { s5_carry_bg(a, l, lds, 2 * u.pm, u.g); s5_carry_bg(a, l, lds, 2 * u.pm + 1, u.g); } } }
        GSYNC();
        if (gridDim.x == 256) {
            REP(3) if (PH_ON(3)) { PH_HEAD
              const bool lo = c < 128;
              Sched S{64, 8, 1, 128, lo ? c : c - 128, 1, (const char*)WSB(OFF_SB), (const char*)(ws + OFF_WGT), 0, 0, (size_t)256 * 1024 * 2, (size_t)256 * 256 * 2, lo ? 0L : 384L, lo ? 384L : 512L};
              F2 f{WSB(OFF_SB), a->in[12] + l * 1024, a->in[14] + l * 1024, (const float*)(ws + OFF_TAB) + TAB_LAM, a->in[3] + (size_t)l * MS * 1024, WSB(OFF_SA), WSB(OFF_SC), a->out + O_SLH + (size_t)l * MS * 1024};
              gemm_phase(lds, 1024, 256, 4, S, f);
              thin_gemm(lds, WSB(OFF_SB), 1024, WSB(OFF_WGT), 256, 256, 8, 1, f, c, G); }
            REP(41) if (PH_ON(41)) { PH_HEAD
              if (c >= 128) { Sched S{4, 1, 32, G, c - 128, 0, (const char*)WSB(OFF_UCG), (const char*)(ws + OFF_TF), (size_t)NCHK * KS5 * 2, (size_t)256 * KS5 * 2, (size_t)256 * KS5 * 2, 0};
                FS5 f{WSB(OFF_UCG), a->in[27] + l * 512, WSB(OFF_SE)};
                gemm_phase(lds, KS5, KS5, 6, S, f); } }
            REP(23) if (PH_ON(23)) { PH_HEAD s5_sample(a, l); }
            GSYNC();
            REP(4) if (PH_ON(4)) { PH_HEAD lru_scan(a, l, lds, WSB(OFF_SA)); }
        } else {
        REP(3) if (PH_ON(3)) { PH_HEAD
          Sched S{64, 8, 1, G, c, 1, (const char*)WSB(OFF_SB), (const char*)(ws + OFF_WGT), 0, 0, (size_t)256 * 1024 * 2, (size_t)256 * 256 * 2};
          F2 f{WSB(OFF_SB), a->in[12] + l * 1024, a->in[14] + l * 1024, (const float*)(ws + OFF_TAB) + TAB_LAM, a->in[3] + (size_t)l * MS * 1024, WSB(OFF_SA), WSB(OFF_SC), a->out + O_SLH + (size_t)l * MS * 1024};
          gemm_phase(lds, 1024, 256, 4, S, f);
          thin_gemm(lds, WSB(OFF_SB), 1024, WSB(OFF_WGT), 256, 256, 8, 1, f, c, G); }
        REP(31) if (PH_ON(31)) { PH_HEAD s5_carry(a, l, lds); }
        GSYNC();
        REP(4) if (PH_ON(4)) { PH_HEAD lru_scan(a, l, lds, ((PROBE_DUP) == 4 && rep_ == 0) ? WSB(OFF_SB) : WSB(OFF_SA)); }
        REP(23) if (PH_ON(23)) { PH_HEAD s5_sample(a, l); }
        REP(41) if (PH_ON(41)) { PH_HEAD
          Sched S{4, 1, 32, G, c, 0, (const char*)WSB(OFF_UCG), (const char*)(ws + OFF_TF), (size_t)NCHK * KS5 * 2, (size_t)256 * KS5 * 2, (size_t)256 * KS5 * 2, 0};
          FS5 f{WSB(OFF_UCG), a->in[27] + l * 512, WSB(OFF_SE)};
          gemm_phase(lds, KS5, KS5, 6, S, f); }
        GSYNC();
        }
        REP(5) if (PH_ON(5)) {
            { PH_HEAD
              Sched S{64, 2, 1, G, c, 0, (const char*)WSB(OFF_SE), (const char*)(ws + OFF_WGLU), 0, 0, (size_t)256 * 512 * 2, (size_t)256 * 512 * 2};
              F4 f{WSB(OFF_SE), a->in[29] + l * 512, WSB(OFF_SF)};
              gemm_phase(lds, 512, 512, 8, S, f);
              const int hb = G >> 1;
              thin_gemm(lds, WSB(OFF_SE), 512, WSB(OFF_WGLU), 512, 512, 2, 0, f, c >= hb ? c - hb : -1, G - hb); }
            { PH_HEAD
              const int hb = G >> 1, cr = c >= hb ? c - hb : c + (G - hb);
              const bf16_t* Wg = WSB(OFF_WIN) + (size_t)2560 * 1024;
              Sched S{64, 12, 1, G, cr, 0, (const char*)WSB(OFF_XB), (const char*)Wg, 0, 0, (size_t)256 * 1024 * 2, (size_t)256 * 1024 * 2};
              FG8 f{(const float*)(ws + OFF_RSQ), a->in[30] + l * 3072, ws + OFF_GT8};
              gemm_phase(lds, 1024, 1024, 16, S, f);
              thin_gemm(lds, WSB(OFF_XB), 1024, Wg, 1024, 1024, 12, 0, f, c >= hb ? c - hb : -1, G - hb); }
        }
        GSYNC();
        REP(6) if (PH_ON(6)) {
            { PH_HEAD
              SchedM3 S{G, c, (const char*)WSB(OFF_SA), (const char*)WSB(OFF_YB), (const char*)WSB(OFF_SF), (const char*)WSB(OFF_WPA), (const char*)WSB(OFF_WPB), (const char*)WSB(OFF_WPC)};
              FMS f{ws + OFF_GT8, WSB(OFF_MRG)};
              gemm_phase_t<FMS, SchedM3, true>(lds, 1024, 1024, 16, S, f); }
            { PH_HEAD
              thin_merge(lds, WSB(OFF_SA), WSB(OFF_YB), WSB(OFF_SF), WSB(OFF_WPA), WSB(OFF_WPB), WSB(OFF_WPC), ws + OFF_GT8, WSB(OFF_MRG), c, G); }
        }
        GSYNC();
        if (PH_ON(7)) { PH_HEAD
          Sched S{64, 4, 1, G, c, 0, (const char*)WSB(OFF_MRG), (const char*)(ws + OFF_WOUT), 0, 0, (size_t)256 * 1024 * 2, (size_t)256 * 1024 * 2};
          F6T<false> f{l == 0 ? a->in[0] : a->out, l == 0 ? a->in[1] : a->out + (size_t)MP * 1024, a->out, WSB(OFF_XB), (float*)(ws + OFF_RSQ2)};
          gemm_phase(lds, 1024, 1024, 16, S, f);
          F6T<true> ft{f.xs_p, f.xs_s, f.xd, f.xb, f.rsq};
          thin_gemm(lds, WSB(OFF_MRG), 1024, WSB(OFF_WOUT), 1024, 1024, 4, 0, ft, c, G); }
        GSYNC();
        REP(8) if (PH_ON(8)) { PH_HEAD
          Sched S{65, 22, 1, G, c, 0, (const char*)WSB(OFF_XB), (const char*)(ws + OFF_WF1), 0, 0, (size_t)256 * 1024 * 2, (size_t)256 * 1024 * 2};
          F7 f{(const float*)(ws + OFF_RSQ2), WSB(OFF_SA)};
          gemm_phase(lds, 1024, 1024, 16, S, f); }
        GSYNC();
        if (PH_ON(9)) { PH_HEAD
          Sched S{64, 4, 1, G, c, 0, (const char*)WSB(OFF_SA), (const char*)(ws + OFF_WF2), 0, 0, (size_t)256 * DFF * 2, (size_t)256 * DFF * 2};
          F6T<false> f{a->out, a->out + (size_t)MP * 1024, a->out, WSB(OFF_XB), (float*)(ws + OFF_RSQ)};
          gemm_phase(lds, DFF, DFF, DFF / 64, S, f);
          F6T<true> ft{f.xs_p, f.xs_s, f.xd, f.xb, f.rsq};
          thin_gemm(lds, WSB(OFF_SA), DFF, WSB(OFF_WF2), DFF, DFF, 4, 0, ft, c, G); }
        GSYNC();
    }
    { PH_HEAD const int tid = otid(); const int wv = tid >> 6, lane = tid & 63; const float* gf = a->in[38]; const float* RSQ = (const float*)(ws + OFF_RSQ);
      f32x4 vn[4], pn4; const int rstep = gridDim.x * 8; int row = blockIdx.x * 8 + wv; f32x4 gv[4];
#pragma unroll
      for (int i = 0; i < 4; ++i) gv[i] = *(const f32x4*)(gf + i * 256 + lane * 4);
      if (row < MT) { pn4 = *(const f32x4*)(RSQ + (size_t)row * 16 + (lane & 3) * 4);
#pragma unroll
          for (int i = 0; i < 4; ++i) vn[i] = *(const f32x4*)(a->out + (size_t)row * 1024 + i * 256 + lane * 4); }
      for (; row < MT; row += rstep) { f32x4 vc[4]; const f32x4 pc = pn4;
#pragma unroll
          for (int i = 0; i < 4; ++i) vc[i] = vn[i];
          if (row + rstep < MT) { const int rn = row + rstep; pn4 = *(const f32x4*)(RSQ + (size_t)rn * 16 + (lane & 3) * 4);
#pragma unroll
              for (int i = 0; i < 4; ++i) vn[i] = *(const f32x4*)(a->out + (size_t)rn * 1024 + i * 256 + lane * 4); }
          float sq = (pc[0] + pc[1]) + (pc[2] + pc[3]); sq += __shfl_xor(sq, 1); sq += __shfl_xor(sq, 2);
          const float rs = rsqrtf(sq * (1.0f / 1024.0f) + EPS); float* x = a->out + (size_t)row * 1024;
#pragma unroll
          for (int i = 0; i < 4; ++i) *(f32x4*)(x + i * 256 + lane * 4) = vc[i] * rs * gv[i]; } }
}

extern "C" void kernel_launch(void* const* d_in, const int* in_sizes, int n_in, void* d_out, int out_size, void* d_ws, size_t ws_size, hipStream_t stream) {
    static int grid_blocks = 0;
    if (!grid_blocks) {
        int dev = 0, cus = 0, per_cu = 0;
        hipGetDevice(&dev);
        hipDeviceGetAttribute(&cus, hipDeviceAttributeMultiprocessorCount, dev);
        hipFuncSetAttribute((const void*)fwd_megakernel, hipFuncAttributeMaxDynamicSharedMemorySize, LDS_BYTES);
        hipOccupancyMaxActiveBlocksPerMultiprocessor(&per_cu, (const void*)fwd_megakernel, 512, LDS_BYTES);
        if (per_cu < 1) { fprintf(stderr, "occupancy query says %d blocks/CU\n", per_cu); per_cu = 1; }
        if (per_cu > 1) per_cu = 1;
        grid_blocks = cus * per_cu;
        if (n_in != 39 || ws_size < WS_END) fprintf(stderr, "kernel_launch: unexpected n_in %d / ws_size %zu (need %zu)\n", n_in, ws_size, (size_t)WS_END);
    }
    (void)hipMemsetAsync((unsigned char*)d_ws + OFF_BAR, 0, 16384, stream);
    KArgs a{};
    for (int i = 0; i < 39; ++i) a.in[i] = (const float*)d_in[i];
    a.out = (float*)d_out; a.ws = (unsigned char*)d_ws;
    void* args[] = {&a};
    hipError_t e = hipLaunchCooperativeKernel((const void*)fwd_megakernel, dim3(grid_blocks), dim3(512), args, LDS_BYTES, stream);
    if (e != hipSuccess) fprintf(stderr, "cooperative launch failed: %s (grid %d)\n", hipGetErrorString(e), grid_blocks);
}
```

```cpp
#include <hip/hip_runtime.h>
#include <hip/hip_cooperative_groups.h>
#include <cstdio>
namespace cg = cooperative_groups;

#define LAS __attribute__((address_space(3)))
typedef unsigned short bf16_t;
typedef short bf16x8 __attribute__((ext_vector_type(8)));
typedef float f32x4 __attribute__((ext_vector_type(4)));
typedef unsigned u32x4 __attribute__((ext_vector_type(4)));
typedef unsigned u32x2 __attribute__((ext_vector_type(2)));

constexpr int D = 1024, SEQ = 2048, NBATCH = 8, MP = 16384, MS = 128, MT = MP + MS;
constexpr int INW = 5632, DFF = 2816, WB = 512, NG = 32, NPC = 64, NLAYER = 2;
constexpr int NCHK = 1024;
constexpr int KS5 = 384;
constexpr float EPS = 1e-6f;

constexpr size_t O_PLC = 16908288, O_PLH = 16957440, O_PCC = 16973824, O_PSR = 17219584, O_PSI = 17252352,
                 O_SLC = 17285120, O_SLH = 18071552, O_SCC = 18333696, O_SSR = 22265856, O_SSI = 22790144;

constexpr size_t SZ34 = (size_t)MT * 1024 * 2, SZ17 = (size_t)MT * 512 * 2;
constexpr size_t OFF_WIN = 0;
constexpr size_t OFF_WGT = OFF_WIN + (size_t)5632 * 1024 * 2;
constexpr size_t OFF_WGLU = OFF_WGT + (size_t)2048 * 256 * 2;
constexpr size_t OFF_WPA = OFF_WGLU + (size_t)512 * 512 * 2;
constexpr size_t OFF_WPB = OFF_WPA + (size_t)1024 * 1024 * 2;
constexpr size_t OFF_WPC = OFF_WPB + (size_t)1024 * 512 * 2;
constexpr size_t OFF_WOUT = OFF_WPC + (size_t)1024 * 512 * 2;
constexpr size_t OFF_WF1 = OFF_WOUT + (size_t)1024 * 1024 * 2;
constexpr size_t OFF_WF2 = OFF_WF1 + (size_t)5632 * 1024 * 2;
constexpr size_t OFF_TF = OFF_WF2 + (size_t)1024 * 2816 * 2;
constexpr size_t OFF_ET = OFF_TF + (size_t)32 * 256 * KS5 * 2;
constexpr size_t OFF_TAB = OFF_ET + (size_t)(32 * 128 + 128) * 256 * 2;
constexpr int TAB_LAM = 4096 + 4096 + 65536;
constexpr size_t OFF_RSQ = OFF_TAB + (size_t)(TAB_LAM + 1024) * 4;
constexpr size_t OFF_RSQ2 = OFF_RSQ + (size_t)MT * 16 * 4;
constexpr size_t OFF_XB = OFF_RSQ2 + (size_t)MT * 16 * 4;
constexpr size_t OFF_SA = OFF_XB + SZ34;
constexpr size_t OFF_SB = OFF_SA + SZ34;
constexpr size_t OFF_SC = OFF_SB + SZ34;
constexpr size_t OFF_UCG = OFF_SC + SZ34;
constexpr size_t OFF_UCS = OFF_UCG + (size_t)32 * 1024 * KS5 * 2;
constexpr size_t OFF_SE = OFF_UCS + (size_t)128 * 512 * 2;
constexpr size_t OFF_YB = OFF_SE + SZ17;
constexpr size_t OFF_SF = OFF_YB + SZ17;
constexpr size_t SZG8 = (((size_t)MT * 3072) + 255) & ~(size_t)255;
constexpr size_t OFF_GT8 = OFF_SB;
constexpr int G8_SPLIT = 11008;
static_assert((size_t)G8_SPLIT * 3072 == SZ34 && (size_t)(MT - G8_SPLIT) * 3072 <= (size_t)32 * 1024 * KS5 * 2, "gate array placement");
constexpr size_t OFF_MRG = OFF_SC;
constexpr size_t OFF_BAR = OFF_SF + SZ17;
constexpr size_t WS_END = OFF_BAR + 16384;
static_assert((size_t)32 * 1024 * 128 * 4 <= SZ17, "ends fits");
static_assert((size_t)MT * 2816 * 2 <= 3 * SZ34, "act fits");
static_assert(WS_END <= (size_t)256 * 1024 * 1024, "workspace");

constexpr int LDS_BYTES = 128 * 1024 + 1024;

struct KArgs { const float* in[39]; float* out; unsigned char* ws; };
typedef const __attribute__((address_space(4))) KArgs* KArgsP;
__device__ __forceinline__ KArgsP kargs() { auto p = __builtin_amdgcn_kernarg_segment_ptr(); asm volatile("" : "+s"(p)); return (KArgsP)p; }

__device__ __forceinline__ unsigned cvt_pk_bf16(float lo, float hi) { unsigned r; asm volatile("v_cvt_pk_bf16_f32 %0, %1, %2" : "=v"(r) : "v"(lo), "v"(hi)); return r; }
__device__ __forceinline__ bf16_t f2bf(float f) { return (bf16_t)(cvt_pk_bf16(f, 0.f) & 0xffffu); }
__device__ __forceinline__ float bf2f(unsigned b) { return __uint_as_float(b << 16); }
__device__ __forceinline__ void store8(bf16_t* p, const float* v) { u32x4 w; w.x = cvt_pk_bf16(v[0], v[1]); w.y = cvt_pk_bf16(v[2], v[3]); w.z = cvt_pk_bf16(v[4], v[5]); w.w = cvt_pk_bf16(v[6], v[7]); *(u32x4*)p = w; }
__device__ __forceinline__ void store4(bf16_t* p, const f32x4 v) { u32x2 w; w.x = cvt_pk_bf16(v[0], v[1]); w.y = cvt_pk_bf16(v[2], v[3]); *(u32x2*)p = w; }
struct PkSt { u32x2 pk[2]; };
template <int SLOT> __device__ __forceinline__ void wstore(PkSt& ps, const int n, bf16_t* p, const f32x4 v) {
    u32x2 w; w.x = cvt_pk_bf16(v[0], v[1]); w.y = cvt_pk_bf16(v[2], v[3]);
    if (n == 0) ps.pk[SLOT] = w; else { u32x4 q; q.x = ps.pk[SLOT].x; q.y = ps.pk[SLOT].y; q.z = w.x; q.w = w.y; *(u32x4*)(p - 4) = q; }
}
__device__ __forceinline__ void unpack8(const u32x4 w, float* v) {
    v[0] = __uint_as_float(w.x << 16); v[1] = __uint_as_float(w.x & 0xffff0000u); v[2] = __uint_as_float(w.y << 16); v[3] = __uint_as_float(w.y & 0xffff0000u);
    v[4] = __uint_as_float(w.z << 16); v[5] = __uint_as_float(w.z & 0xffff0000u); v[6] = __uint_as_float(w.w << 16); v[7] = __uint_as_float(w.w & 0xffff0000u); }
__device__ __forceinline__ void load8(const bf16_t* p, float* v) { unpack8(*(const u32x4*)p, v); }
__device__ __forceinline__ size_t g8row(int row) { return (size_t)row * 3072 + (row >= G8_SPLIT ? SZ34 : (size_t)0); }
__device__ __forceinline__ float sigm(float x) { return __builtin_amdgcn_rcpf(1.0f + __expf(-x)); }
__device__ __forceinline__ float wave_sum(float v) { for (int o = 32; o >= 1; o >>= 1) v += __shfl_xor(v, o); return v; }

__device__ __forceinline__ int otid() { int t = threadIdx.x; asm volatile("" : "+v"(t)); return t; }
__device__ __forceinline__ int oblk() { int t = blockIdx.x; asm volatile("" : "+s"(t)); return t; }
constexpr int BM = 256, BK = 64, HALF = 128, HTB = HALF * BK * 2, NXCD = 8, WGM = 8;
__device__ __forceinline__ int lds_byte(int r, int c) { const int st = (r >> 4) * 2 + (c >> 5), rr = r & 15, cc = c & 31, ob = rr * 64 + cc * 2; return st * 1024 + (ob ^ (((ob >> 9) & 1) << 5)); }
__device__ __forceinline__ void stage_rc(int b, int& R, int& C) { const int st = b / 1024, sb = b % 1024, swz = sb ^ (((sb >> 9) & 1) << 5); R = (st >> 1) * 16 + swz / 64; C = (st & 1) * 32 + (swz % 64) / 2; }
__device__ __forceinline__ int perm32(int rho) { const int n = rho >> 4, i = rho & 15; return 8 * (i >> 2) + 4 * n + (i & 3); }

struct Unit { int pm, pn, g, sm, fin; const char* A; const char* B; };
struct Sched {
    int nM, nN, nGrp, G, c, bd; const char* A;     const char* B; size_t a_g, b_g, a_pm, b_pn; long L0 = 0, Lend = (1L << 40);
    __device__ __forceinline__ bool next(int i, Unit& u) const {
        const long L = L0 + (long)i * G + c; const int nwg = nM * nN; if (L >= (long)nwg * nGrp || L >= Lend) return false;
        const int g = (int)(L / nwg); int wgid = (int)(L % nwg);
        { const int q = nwg / NXCD, r = nwg % NXCD, xcd = wgid % NXCD, off = wgid / NXCD; wgid = (xcd < r ? xcd * (q + 1) : r * (q + 1) + (xcd - r) * q) + off; }
        const int nig = WGM * nN, gid = wgid / nig, fm = gid * WGM, gsz = (nM - fm) < WGM ? (nM - fm) : WGM;
        u.pm = fm + ((wgid % nig) % gsz); u.pn = (wgid % nig) / gsz; u.g = g; u.sm = 0; u.fin = 1;
        u.A = A + (size_t)g * a_g + (size_t)u.pm * a_pm + (bd ? (size_t)(u.pn >> 1) * 512 : 0); u.B = B + (size_t)g * b_g + (size_t)u.pn * b_pn; return true;
    }
};

struct SchedM3 {
    int G, c; const char* YA; const char* YB; const char* YC; const char* WPA; const char* WPB; const char* WPC;
    __device__ __forceinline__ bool next(int i, Unit& u) const {
        const int rnd = i / 3, seg = i - rnd * 3; int wgid = c + rnd * G; if (wgid >= 256) return false;
        { const int q = 256 / NXCD, xcd = wgid % NXCD, off = wgid / NXCD; wgid = xcd * q + off; }
        const int nig = WGM * 4, gid = wgid / nig, fm = gid * WGM;
        u.pm = fm + ((wgid % nig) % WGM); u.pn = (wgid % nig) / WGM; u.g = seg; u.sm = seg ? 1 : 0; u.fin = (seg == 2);
        const size_t pa = (size_t)u.pm * 256 * 2, pb = (size_t)u.pn * 256 * 2;
        if (seg == 0) { u.A = YA + pa * 1024; u.B = WPA + pb * 1024; }
        else if (seg == 1) { u.A = YB + pa * 512; u.B = WPB + pb * 512; }
        else { u.A = YC + pa * 512; u.B = WPC + pb * 512; }
        return true;
    }
};

template <class F, class SC, bool MIX>
__device__ __forceinline__ void gemm_phase_t(LAS unsigned char* lds, const int lda, const int ldb, const int nt_, const SC& S, const F& E) {
    const int tid = otid(), wid = __builtin_amdgcn_readfirstlane(tid >> 6), lane = tid & 63, wr = wid >> 2, wc = wid & 3, fr = lane & 15, fq = lane >> 4;
    unsigned voffA[2], voffB[2];
#pragma unroll
    for (int i = 0; i < 2; ++i) { int R, C; stage_rc(tid * 16 + i * 8192, R, C); const int Rb = (R & ~31) + perm32(R & 31);
        voffA[i] = (unsigned)(R * (MIX ? 512 : lda) + C) * 2u; voffB[i] = (unsigned)(Rb * (MIX ? 512 : ldb) + C) * 2u; }
    const size_t kstep = (size_t)(BK * 2);
    const size_t hA0 = (size_t)HALF * lda * 2, hB0 = (size_t)HALF * ldb * 2;
    const unsigned ldsw = (unsigned)wid * 1024u;
    const int aoff = lds_byte(wr * 64 + fr, fq * 8), boff = lds_byte(wc * 32 + fr, fq * 8);
#define PG8_SA(b, h) (((b) * 2 + (h)) * HTB)
#define PG8_SB(b, h) ((4 + (b) * 2 + (h)) * HTB)
#define PG8_STAGE(bufoff, gbase, voff, m2) do { _Pragma("unroll") for (int _i = 0; _i < 2; ++_i) \
        __builtin_amdgcn_global_load_lds((const unsigned*)((const char*)(gbase) + ((voff)[_i] + ((voff)[_i] & (m2)))), (LAS unsigned*)(lds + (bufoff) + ldsw + _i * 8192), 16, 0, 0); } while (0)
#define PG8_LDA(dst, b, h) do { _Pragma("unroll") for (int m = 0; m < 4; ++m) _Pragma("unroll") for (int k = 0; k < 2; ++k) dst[m][k] = *(const LAS bf16x8*)(lds + PG8_SA(b, h) + aoff + m * 2048 + k * 1024); } while (0)
#define PG8_LDB(dst, b, h) do { _Pragma("unroll") for (int n = 0; n < 2; ++n) _Pragma("unroll") for (int k = 0; k < 2; ++k) dst[n][k] = *(const LAS bf16x8*)(lds + PG8_SB(b, h) + boff + n * 2048 + k * 1024); } while (0)
#define PG8_MMA(ai, bj, At, Bt) do { __builtin_amdgcn_s_setprio(1); _Pragma("unroll") for (int m = 0; m < 4; ++m) _Pragma("unroll") for (int n = 0; n < 2; ++n) _Pragma("unroll") for (int k = 0; k < 2; ++k) \
        acc[ai][bj][m][n] = __builtin_amdgcn_mfma_f32_16x16x32_bf16(Bt[n][k], At[m][k], acc[ai][bj][m][n], 0, 0, 0); __builtin_amdgcn_s_setprio(0); } while (0)
#define PG8_WAIT_V(n) asm volatile("s_waitcnt vmcnt(" #n ")" ::: "memory")
#define PG8_WAIT_L(n) asm volatile("s_waitcnt lgkmcnt(" #n ")" ::: "memory")
#define PG8_BAR __builtin_amdgcn_s_barrier()
#define PG8_SCHED __builtin_amdgcn_sched_barrier(0)
    Unit cur, nxt; int ui = 0;
    if (!S.next(0, cur)) return;
    f32x4 acc[2][2][4][2];
    if constexpr (F::ACC_INIT) E.init(acc, cur.pm, cur.pn, wr, wc, fr, fq); else {
#pragma unroll
    for (int a = 0; a < 2; ++a)
#pragma unroll
        for (int b = 0; b < 2; ++b)
#pragma unroll
            for (int m = 0; m < 4; ++m)
#pragma unroll
                for (int n = 0; n < 2; ++n) acc[a][b][m][n] = (f32x4){0.f, 0.f, 0.f, 0.f};
    }
    bf16x8 At[4][2], B0[2][2], B1[2][2];
    const char* cA = cur.A; const char* cB = cur.B;
    unsigned cm = (MIX && !cur.sm) ? ~1023u : 0u; size_t hA = MIX ? (cur.sm ? (size_t)131072 : (size_t)262144) : hA0, hB = MIX ? hA : hB0; int nt = MIX ? (cur.sm ? 8 : 16) : nt_;
    PG8_STAGE(PG8_SB(0, 0), cB, voffB, cm); PG8_STAGE(PG8_SA(0, 0), cA, voffA, cm); PG8_STAGE(PG8_SB(0, 1), cB + hB, voffB, cm); PG8_STAGE(PG8_SA(0, 1), cA + hA, voffA, cm);
    if (wr == 1) PG8_BAR;
    PG8_WAIT_V(4); PG8_BAR;
    PG8_STAGE(PG8_SB(1, 0), cB + kstep, voffB, cm); PG8_STAGE(PG8_SA(1, 0), cA + kstep, voffA, cm); PG8_STAGE(PG8_SB(1, 1), cB + hB + kstep, voffB, cm);
    PG8_WAIT_V(6); PG8_BAR;
    for (;;) {
        const bool has_next = S.next(ui + 1, nxt);
        const char* nA = has_next ? nxt.A : cA; const char* nB = has_next ? nxt.B : cB;
        const unsigned nm = (MIX && has_next) ? (nxt.sm ? 0u : ~1023u) : cm;
        const size_t nhA = (MIX && has_next) ? (nxt.sm ? (size_t)131072 : (size_t)262144) : hA, nhB = MIX ? nhA : hB;
#pragma unroll 1
        for (int t = 0; t < nt; t += 2) {
            const bool last = (t == nt - 2);
            const char* a1 = cA + (size_t)(t + 1) * kstep;
            const char* a2 = last ? nA : cA + (size_t)(t + 2) * kstep; const char* b2 = last ? nB : cB + (size_t)(t + 2) * kstep;
            const char* a3 = a2 + kstep; const char* b3 = b2 + kstep;
            const unsigned m2 = (MIX && last) ? nm : cm; const size_t h2A = (MIX && last) ? nhA : hA, h2B = (MIX && last) ? nhB : hB;
            PG8_LDB(B0, 0, 0); PG8_SCHED; PG8_LDA(At, 0, 0); PG8_STAGE(PG8_SA(1, 1), a1 + hA, voffA, cm);
            PG8_WAIT_L(8); PG8_BAR; PG8_WAIT_L(0); PG8_MMA(0, 0, At, B0); PG8_BAR; PG8_SCHED;
            PG8_LDB(B1, 0, 1); PG8_STAGE(PG8_SB(0, 0), b2, voffB, m2);
            PG8_BAR; PG8_WAIT_L(0); PG8_MMA(0, 1, At, B1); PG8_BAR;
            PG8_LDA(At, 0, 1); PG8_STAGE(PG8_SA(0, 0), a2, voffA, m2);
            PG8_BAR; PG8_WAIT_L(0); PG8_MMA(1, 0, At, B0); PG8_BAR; PG8_SCHED;
            PG8_STAGE(PG8_SB(0, 1), b2 + h2B, voffB, m2);
            PG8_WAIT_V(6); PG8_BAR; PG8_MMA(1, 1, At, B1); PG8_BAR;
            PG8_LDB(B0, 1, 0); PG8_SCHED; PG8_LDA(At, 1, 0); PG8_STAGE(PG8_SA(0, 1), a2 + h2A, voffA, m2);
            PG8_WAIT_L(8); PG8_BAR; PG8_WAIT_L(0); PG8_MMA(0, 0, At, B0); PG8_BAR; PG8_SCHED;
            PG8_LDB(B1, 1, 1); PG8_STAGE(PG8_SB(1, 0), b3, voffB, m2);
            PG8_BAR; PG8_WAIT_L(0); PG8_MMA(0, 1, At, B1); PG8_BAR;
            PG8_LDA(At, 1, 1); PG8_STAGE(PG8_SA(1, 0), a3, voffA, m2);
            PG8_BAR; PG8_WAIT_L(0); PG8_MMA(1, 0, At, B0); PG8_BAR; PG8_SCHED;
            PG8_STAGE(PG8_SB(1, 1), b3 + h2B, voffB, m2);
            PG8_WAIT_V(6); PG8_BAR; PG8_MMA(1, 1, At, B1); PG8_BAR;
        }
        {
            int row0 = cur.pm * BM + wr * 64 + fr; asm volatile("" : "+v"(row0));
            const typename F::UCtx uc = E.unit_ctx(cur.pn, wc, fq, cur.g);
            typename F::Pre pre = E.row_pre(row0, fq, cur.pn, wc, cur.g);
#pragma unroll
            for (int rg = 0; rg < 8; ++rg) { const int ai = rg >> 2, m = rg & 3;
                int row = cur.pm * BM + ai * HALF + wr * 64 + m * 16 + fr;
                asm volatile("" : "+v"(row));
                typename F::Pre pre_n = pre;
                if (rg < 7) { int rown = cur.pm * BM + ((rg + 1) >> 2) * HALF + wr * 64 + ((rg + 1) & 3) * 16 + fr; asm volatile("" : "+v"(rown)); pre_n = E.row_pre(rown, fq, cur.pn, wc, cur.g); }
                asm volatile("" ::: "memory");
                typename F::State st; E.row_begin(st, pre); PkSt ps;
#pragma unroll
                for (int n = 0; n < 2; ++n) { E.op(st, ps, uc, row, cur.pn, cur.g, wc * 32 + 8 * fq + 4 * n, n, acc[ai][0][m][n], acc[ai][1][m][n]); }
                E.row_end(st, row, cur.pn, wc);
                pre = pre_n;
            }
        }
        if (!has_next) break;
        if constexpr (F::ACC_INIT) E.init(acc, nxt.pm, nxt.pn, wr, wc, fr, fq); else if (!MIX || cur.fin) {
#pragma unroll
        for (int a = 0; a < 2; ++a)
#pragma unroll
            for (int b = 0; b < 2; ++b)
#pragma unroll
                for (int m = 0; m < 4; ++m)
#pragma unroll
                    for (int n = 0; n < 2; ++n) acc[a][b][m][n] = (f32x4){0.f, 0.f, 0.f, 0.f};
        }
        cur = nxt; cA = nA; cB = nB; ++ui;
        if (MIX) { cm = nm; hA = nhA; hB = nhB; nt = cur.sm ? 8 : 16; }
    }
    PG8_WAIT_V(0);
    if (wr == 0) PG8_BAR;
    PG8_BAR;
#undef PG8_SA
#undef PG8_SB
#undef PG8_STAGE
#undef PG8_LDA
#undef PG8_LDB
#undef PG8_MMA
#undef PG8_WAIT_V
#undef PG8_WAIT_L
#undef PG8_BAR
#undef PG8_SCHED
}

template <class F>
__device__ __forceinline__ void gemm_phase(LAS unsigned char* lds, const int lda, const int ldb, const int nt, const Sched& S, const F& E) { gemm_phase_t<F, Sched, false>(lds, lda, ldb, nt, S, E); }

template <class F>
__device__ __forceinline__ void thin_gemm(LAS unsigned char* lds, const bf16_t* A, const int lda, const bf16_t* Bt, const int ldb, const int K, const int nN, const int bd, const F& E, const int bi, const int nb) {
    const int tid = otid(), wid = tid >> 6, lane = tid & 63, fr = lane & 15, fq = lane >> 4;
    LAS f32x4* red = (LAS f32x4*)lds;
    const int nitems = 8 * nN * 4, kw = K >> 3;
    if (bi >= 0) for (int item = bi; item < nitems; item += nb) {
        const int rg = item & 7, wc = (item >> 3) & 3, pn = item >> 5;
        const bf16_t* ap = A + (size_t)(MP + 16 * rg + fr) * lda + (bd ? (pn >> 1) * 256 : 0) + wid * kw + 8 * fq;
        const bf16_t* bp[4];
#pragma unroll
        for (int n = 0; n < 4; ++n) bp[n] = Bt + (size_t)(256 * pn + 128 * (n >> 1) + 32 * wc + 8 * (fr >> 2) + 4 * (n & 1) + (fr & 3)) * ldb + wid * kw + 8 * fq;
        f32x4 acc[4];
#pragma unroll
        for (int n = 0; n < 4; ++n) acc[n] = (f32x4){0.f, 0.f, 0.f, 0.f};
        for (int kb = 0; kb < kw; kb += 128) {
            bf16x8 av[4], bv[4][4];
#pragma unroll
            for (int i = 0; i < 4; ++i) if (kb + 32 * i < kw) { av[i] = *(const bf16x8*)(ap + kb + 32 * i);
#pragma unroll
                for (int n = 0; n < 4; ++n) bv[i][n] = *(const bf16x8*)(bp[n] + kb + 32 * i); }
#pragma unroll
            for (int i = 0; i < 4; ++i) if (kb + 32 * i < kw) {
#pragma unroll
                for (int n = 0; n < 4; ++n) acc[n] = __builtin_amdgcn_mfma_f32_16x16x32_bf16(bv[i][n], av[i], acc[n], 0, 0, 0); }
        }
#pragma unroll
        for (int n = 0; n < 4; ++n) red[(wid * 4 + n) * 64 + lane] = acc[n];
        __syncthreads();
        if (wid == 0) {
            f32x4 sv[4];
#pragma unroll
            for (int n = 0; n < 4; ++n) { f32x4 s = red[n * 64 + lane];
#pragma unroll
                for (int w = 1; w < 8; ++w) s += red[(w * 4 + n) * 64 + lane];
                sv[n] = s; }
            const int row = MP + 16 * rg + fr; typename F::State st; E.row_begin(st, E.row_pre(row, fq, pn, wc, 0));
            const typename F::UCtx uc = E.unit_ctx(pn, wc, fq, 0);
            PkSt ps;
#pragma unroll
            for (int n = 0; n < 2; ++n) E.op(st, ps, uc, row, pn, 0, wc * 32 + 8 * fq + 4 * n, n, sv[n], sv[2 + n]);
            E.row_end(st, row, pn, wc);
        }
        __syncthreads();
    }
}

__device__ __forceinline__ void thin_merge(LAS unsigned char* lds, const bf16_t* YA, const bf16_t* YB, const bf16_t* YC, const bf16_t* WPA, const bf16_t* WPB, const bf16_t* WPC,
                                           const unsigned char* g8, bf16_t* mrg, const int bi, const int nb) {
    const int tid = otid(), wid = tid >> 6, lane = tid & 63, fr = lane & 15, fq = lane >> 4;
    LAS f32x4* red = (LAS f32x4*)lds;
    for (int item = bi; item < 8 * 4 * 4; item += nb) {
        const int rg = item & 7, wc = (item >> 3) & 3, pn = item >> 5, row = MP + 16 * rg + fr;
        int brow[4];
#pragma unroll
        for (int n = 0; n < 4; ++n) brow[n] = 256 * pn + 128 * (n >> 1) + 32 * wc + 8 * (fr >> 2) + 4 * (n & 1) + (fr & 3);
        f32x4 tot[4];
#pragma unroll
        for (int n = 0; n < 4; ++n) tot[n] = (f32x4){0.f, 0.f, 0.f, 0.f};
#pragma unroll
        for (int seg = 0; seg < 3; ++seg) {
            const bf16_t* A = seg == 0 ? YA : (seg == 1 ? YB : YC); const bf16_t* B = seg == 0 ? WPA : (seg == 1 ? WPB : WPC);
            const int K = seg == 0 ? 1024 : 512, kw = K >> 3, nst = kw >> 5;
            bf16x8 av[4], bv[4][4]; unsigned gw[4];
#pragma unroll
            for (int i = 0; i < 4; ++i) if (i < nst) { av[i] = *(const bf16x8*)(A + (size_t)row * K + wid * kw + 32 * i + 8 * fq);
#pragma unroll
                for (int n = 0; n < 4; ++n) bv[i][n] = *(const bf16x8*)(B + (size_t)brow[n] * K + wid * kw + 32 * i + 8 * fq); }
#pragma unroll
            for (int n = 0; n < 4; ++n) gw[n] = *(const unsigned*)(g8 + g8row(row) + seg * 1024 + 256 * pn + 128 * (n >> 1) + 32 * wc + 8 * fq + 4 * (n & 1));
            f32x4 acc[4];
#pragma unroll
            for (int n = 0; n < 4; ++n) acc[n] = (f32x4){0.f, 0.f, 0.f, 0.f};
#pragma unroll
            for (int i = 0; i < 4; ++i) if (i < nst) {
#pragma unroll
                for (int n = 0; n < 4; ++n) acc[n] = __builtin_amdgcn_mfma_f32_16x16x32_bf16(bv[i][n], av[i], acc[n], 0, 0, 0); }
#pragma unroll
            for (int n = 0; n < 4; ++n) tot[n] += acc[n] * ((f32x4){(float)(gw[n] & 255u), (float)((gw[n] >> 8) & 255u), (float)((gw[n] >> 16) & 255u), (float)(gw[n] >> 24)} * (1.0f / 255.0f));
        }
#pragma unroll
        for (int n = 0; n < 4; ++n) red[(wid * 4 + n) * 64 + lane] = tot[n];
        __syncthreads();
        if (wid == 0) {
#pragma unroll
            for (int n = 0; n < 4; ++n) { f32x4 sv = red[n * 64 + lane];
#pragma unroll
                for (int w = 1; w < 8; ++w) sv += red[(w * 4 + n) * 64 + lane];
                store4(mrg + (size_t)row * 1024 + 256 * pn + 128 * (n >> 1) + 32 * wc + 8 * fq + 4 * (n & 1), sv); }
        }
        __syncthreads();
    }
}

__device__ __forceinline__ f32x4 load4(const bf16_t* p) { const u32x2 w = *(const u32x2*)p; return (f32x4){__uint_as_float(w.x << 16), __uint_as_float(w.x & 0xffff0000u), __uint_as_float(w.y << 16), __uint_as_float(w.y & 0xffff0000u)}; }
__device__ __forceinline__ f32x4 sigm4(const f32x4 x) { return (f32x4){sigm(x[0]), sigm(x[1]), sigm(x[2]), sigm(x[3])}; }
__device__ __forceinline__ float row_rs4(const float* rsq, int row, int fq) {
    const f32x4 a = *(const f32x4*)(rsq + (size_t)row * 16 + fq * 4); float s = (a[0] + a[1]) + (a[2] + a[3]);
    s += __shfl_xor(s, 16); s += __shfl_xor(s, 32); return rsqrtf(s * (1.0f / 1024.0f) + EPS);
}
__device__ __forceinline__ float rs_from4(const f32x4 a) { float s = (a[0] + a[1]) + (a[2] + a[3]); s += __shfl_xor(s, 16); s += __shfl_xor(s, 32); return rsqrtf(s * (1.0f / 1024.0f) + EPS); }
__device__ __forceinline__ float row_rs(const float* rsq, int row) {
    const f32x4* p = (const f32x4*)(rsq + (size_t)row * 16); const f32x4 a = p[0], b = p[1], c = p[2], d = p[3];
    const float s = ((a[0] + a[1]) + (a[2] + a[3])) + ((b[0] + b[1]) + (b[2] + b[3])) + ((c[0] + c[1]) + (c[2] + c[3])) + ((d[0] + d[1]) + (d[2] + d[3]));
    return rsqrtf(s * (1.0f / 1024.0f) + EPS);
}
struct StNone { };
struct StF { float x; };
struct F1 {
    typedef StF State;
    static constexpr bool ACC_INIT = false;
    typedef StNone UCtx;
    __device__ __forceinline__ UCtx unit_ctx(int, int, int, int) const { return UCtx(); }
    const float* rsq; bf16_t* ua; bf16_t* glu; bf16_t* ucg; bf16_t* ucs;
    typedef f32x4 Pre;
    __device__ __forceinline__ Pre row_pre(int row, int fq, int, int, int) const { return *(const f32x4*)(rsq + (size_t)row * 16 + fq * 4); }
    __device__ __forceinline__ void row_begin(State& st, const Pre& p) const { st.x = rs_from4(p); }
    __device__ __forceinline__ void row_end(State&, int, int, int) const {}
    __device__ __forceinline__ void op(State& st, PkSt& ps, const UCtx& uc, int row, int pn, int, int lc, const int n, f32x4& a, f32x4& b) const {
        if (row >= MT) return;
        const f32x4 va = a * st.x, vb = b * st.x;
        if (pn < 4) { bf16_t* p = ua + (size_t)row * 1024 + pn * 256 + lc; wstore<0>(ps, n, p, va); wstore<1>(ps, n, p + 128, vb); }
        else if (pn < 8) wstore<0>(ps, n, glu + (size_t)row * 512 + (pn - 4) * 128 + lc, va * sigm4(vb));
        else {
#pragma unroll
            for (int h = 0; h < 2; ++h) { const int cc = (pn - 8) * 256 + lc + 128 * h; bf16_t* dst;
                if (row < MP) dst = ucg + ((size_t)(cc >> 4) * NCHK + (row >> 4)) * KS5 + (row & 15) * 16 + (cc & 15);
                else dst = ucs + (size_t)(row - MP) * 512 + cc;
                if (h) wstore<1>(ps, n, dst, vb); else wstore<0>(ps, n, dst, va); }
        }
    }
};
struct StU4 { u32x4 v; };
struct F2 {
    typedef StU4 State; typedef StU4 Pre;
    static constexpr bool ACC_INIT = false;
    struct UCtx { f32x4 brg[2], big[2], lm[2]; };
    __device__ __forceinline__ UCtx unit_ctx(int pn, int wc, int fq, int) const { UCtx u; const int ch = pn * 128 + wc * 32 + 8 * fq;
#pragma unroll
        for (int n = 0; n < 2; ++n) { u.brg[n] = *(const f32x4*)(b_rg + ch + 4 * n); u.big[n] = *(const f32x4*)(b_ig + ch + 4 * n); u.lm[n] = *(const f32x4*)(lam + ch + 4 * n); }
        return u; }
    const bf16_t* ca; const float* b_rg; const float* b_ig; const float* lam; const float* h0; bf16_t* la; bf16_t* bx; float* out_h;
    __device__ __forceinline__ Pre row_pre(int row, int fq, int pn, int wc, int) const { Pre p; p.v = *(const u32x4*)(ca + (size_t)row * 1024 + pn * 128 + wc * 32 + 8 * fq); return p; }
    __device__ __forceinline__ void row_begin(State& st, const Pre& p) const { st = p; }
    __device__ __forceinline__ void row_end(State&, int, int, int) const {}
    __device__ __forceinline__ void op(State& st, PkSt& ps, const UCtx& uc, int row, int pn, int, int lc, const int n, f32x4& a, f32x4& b) const {
        const int ch0 = pn * 128 + lc; const unsigned w0 = n ? st.v.z : st.v.x, w1 = n ? st.v.w : st.v.y;
        const f32x4 c4 = (f32x4){__uint_as_float(w0 << 16), __uint_as_float(w0 & 0xffff0000u), __uint_as_float(w1 << 16), __uint_as_float(w1 & 0xffff0000u)};
        const f32x4 r = sigm4(a + uc.brg[n]), ig = sigm4(b + uc.big[n]), l_a = r * uc.lm[n];
        f32x4 bxv;
#pragma unroll
        for (int j = 0; j < 4; ++j) bxv[j] = __builtin_amdgcn_sqrtf(fmaxf(1.0f - __expf(2.0f * l_a[j]), 0.f)) * ig[j] * c4[j];
        if (row < MP) { wstore<0>(ps, n, la + (size_t)row * 1024 + ch0, l_a); wstore<1>(ps, n, bx + (size_t)row * 1024 + ch0, bxv); }
        else { const size_t o = (size_t)(row - MP) * 1024 + ch0; const f32x4 hp = *(const f32x4*)(h0 + o); f32x4 h;
#pragma unroll
            for (int j = 0; j < 4; ++j) h[j] = __expf(l_a[j]) * hp[j] + bxv[j];
            *(f32x4*)(out_h + o) = h; wstore<0>(ps, n, la + (size_t)row * 1024 + ch0, h); }
    }
};
struct FEnd {
    typedef StNone State;
    static constexpr bool ACC_INIT = false;
    typedef StNone UCtx;
    __device__ __forceinline__ UCtx unit_ctx(int, int, int, int) const { return UCtx(); }
    float* ends;
    typedef StNone Pre;
    __device__ __forceinline__ Pre row_pre(int, int, int, int, int) const { return Pre(); }
    __device__ __forceinline__ void row_begin(State&, const Pre&) const {}
    __device__ __forceinline__ void row_end(State&, int, int, int) const {}
    __device__ __forceinline__ void op(State&, PkSt& ps, const UCtx& uc, int row, int, int g, int lc, const int n, f32x4& a, f32x4&) const { *(f32x4*)(ends + ((size_t)g * NCHK + row) * 128 + lc) = a; }
};
__device__ __forceinline__ float gelu_tanh(float x) { const float u = 0.7978845608028654f * (x + 0.044715f * x * x * x); return x * sigm(2.0f * u); }
struct StU8 { u32x2 v[4]; };
struct FS5 {
    typedef StU8 State; typedef StU8 Pre;
    static constexpr bool ACC_INIT = false;
    struct UCtx { f32x4 d[2]; };
    __device__ __forceinline__ UCtx unit_ctx(int, int, int fq, int g) const { UCtx u; u.d[0] = *(const f32x4*)(dsk + g * 16 + ((8 * fq) & 15)); u.d[1] = *(const f32x4*)(dsk + g * 16 + ((8 * fq + 4) & 15)); return u; }
    const bf16_t* ucg; const float* dsk; bf16_t* yc0;
    __device__ __forceinline__ Pre row_pre(int row, int fq, int, int wc, int g) const { Pre p; const bf16_t* base = ucg + ((size_t)g * NCHK + row) * KS5 + wc * 32 + 8 * fq;
#pragma unroll
        for (int h = 0; h < 2; ++h) { const u32x4 q = *(const u32x4*)(base + 128 * h); p.v[h] = (u32x2){q.x, q.y}; p.v[2 + h] = (u32x2){q.z, q.w}; }
        return p; }
    __device__ __forceinline__ void row_begin(State& st, const Pre& p) const { st = p; }
    __device__ __forceinline__ void row_end(State&, int, int, int) const {}
    __device__ __forceinline__ void op(State& st, PkSt& ps, const UCtx& uc, int row, int, int g, int lc, const int n, f32x4& a, f32x4& b) const {
#pragma unroll
        for (int h = 0; h < 2; ++h) { const int col = lc + 128 * h, i = col >> 4, c0 = col & 15; const u32x2 w = st.v[n * 2 + h];
            const f32x4 u4 = (f32x4){__uint_as_float(w.x << 16), __uint_as_float(w.x & 0xffff0000u), __uint_as_float(w.y << 16), __uint_as_float(w.y & 0xffff0000u)};
            const f32x4 y = (h ? b : a) + uc.d[n] * u4;
            const f32x4 gy = (f32x4){gelu_tanh(y[0]), gelu_tanh(y[1]), gelu_tanh(y[2]), gelu_tanh(y[3])}; bf16_t* dp = yc0 + (size_t)(row * 16 + i) * 512 + g * 16 + c0;
            if (h) wstore<1>(ps, n, dp, gy); else wstore<0>(ps, n, dp, gy); }
    }
};
struct F4 {
    typedef StU8 State; typedef StU8 Pre;
    static constexpr bool ACC_INIT = false;
    struct UCtx { f32x4 b[2][2]; };
    __device__ __forceinline__ UCtx unit_ctx(int pn, int wc, int fq, int) const { UCtx u; const float* p = bg + pn * 256 + wc * 32 + 8 * fq;
#pragma unroll
        for (int n = 0; n < 2; ++n)
#pragma unroll
            for (int h = 0; h < 2; ++h) u.b[n][h] = *(const f32x4*)(p + 128 * h + 4 * n);
        return u; }
    const bf16_t* yc0; const float* bg; bf16_t* yc;
    __device__ __forceinline__ Pre row_pre(int row, int fq, int pn, int wc, int) const { Pre p; const bf16_t* base = yc0 + (size_t)row * 512 + pn * 256 + wc * 32 + 8 * fq;
#pragma unroll
        for (int h = 0; h < 2; ++h) { const u32x4 q = *(const u32x4*)(base + 128 * h); p.v[h] = (u32x2){q.x, q.y}; p.v[2 + h] = (u32x2){q.z, q.w}; }
        return p; }
    __device__ __forceinline__ void row_begin(State& st, const Pre& p) const { st = p; }
    __device__ __forceinline__ void row_end(State&, int, int, int) const {}
    __device__ __forceinline__ void op(State& st, PkSt& ps, const UCtx& uc, int row, int pn, int, int lc, const int n, f32x4& a, f32x4& b) const {
#pragma unroll
        for (int h = 0; h < 2; ++h) { const int col = pn * 256 + lc + 128 * h; const u32x2 w = st.v[n * 2 + h];
            const f32x4 y4 = (f32x4){__uint_as_float(w.x << 16), __uint_as_float(w.x & 0xffff0000u), __uint_as_float(w.y << 16), __uint_as_float(w.y & 0xffff0000u)};
            const f32x4 yo = y4 * sigm4((h ? b : a) + uc.b[n][h]); if (h) wstore<1>(ps, n, yc + (size_t)row * 512 + col, yo); else wstore<0>(ps, n, yc + (size_t)row * 512 + col, yo); }
    }
};
struct FG8 {
    typedef StF State;
    static constexpr bool ACC_INIT = false;
    struct UCtx { f32x4 b[2][2]; };
    __device__ __forceinline__ UCtx unit_ctx(int pn, int wc, int fq, int) const { UCtx u; const float* p = bgate + pn * 256 + wc * 32 + 8 * fq;
#pragma unroll
        for (int n = 0; n < 2; ++n)
#pragma unroll
            for (int h = 0; h < 2; ++h) u.b[n][h] = *(const f32x4*)(p + 128 * h + 4 * n);
        return u; }
    const float* rsq; const float* bgate; unsigned char* g8;
    typedef f32x4 Pre;
    __device__ __forceinline__ Pre row_pre(int row, int fq, int, int, int) const { return *(const f32x4*)(rsq + (size_t)row * 16 + fq * 4); }
    __device__ __forceinline__ void row_begin(State& st, const Pre& p) const { st.x = rs_from4(p); }
    __device__ __forceinline__ void row_end(State&, int, int, int) const {}
    __device__ __forceinline__ void op(State& st, PkSt& ps, const UCtx& uc, int row, int pn, int, int lc, const int n, f32x4& a, f32x4& b) const {
#pragma unroll
        for (int h = 0; h < 2; ++h) { const int col = pn * 256 + lc + 128 * h; f32x4 g = sigm4((h ? b : a) * st.x + uc.b[(lc >> 2) & 1][h]) * 255.0f + 0.5f; g = __builtin_elementwise_max(g, (f32x4){1.f, 1.f, 1.f, 1.f});
            *(unsigned*)(g8 + g8row(row) + col) = (unsigned)g[0] | ((unsigned)g[1] << 8) | ((unsigned)g[2] << 16) | ((unsigned)g[3] << 24); }
    }
};
struct StG { unsigned w[8]; };
struct FMS {
    typedef StG State; typedef StG Pre;
    static constexpr bool ACC_INIT = false;
    typedef StNone UCtx;
    __device__ __forceinline__ UCtx unit_ctx(int, int, int, int) const { return UCtx(); }
    const unsigned char* g8; bf16_t* mrg;
    __device__ __forceinline__ Pre row_pre(int row, int fq, int pn, int wc, int seg) const { Pre p; const unsigned char* base = g8 + g8row(row) + seg * 1024 + pn * 256 + wc * 32 + 8 * fq;
#pragma unroll
        for (int h = 0; h < 2; ++h) { const u32x2 gnum = *(const u32x2*)(base + 128 * h); u32x2 gden = (u32x2){0x01010101u, 0x01010101u}; if (seg < 2) gden = *(const u32x2*)(base + 1024 + 128 * h);
            p.w[(0 * 2 + h) * 2] = gnum.x; p.w[(1 * 2 + h) * 2] = gnum.y; p.w[(0 * 2 + h) * 2 + 1] = gden.x; p.w[(1 * 2 + h) * 2 + 1] = gden.y; }
        return p; }
    __device__ __forceinline__ void row_begin(State& st, const Pre& p) const { st = p; }
    __device__ __forceinline__ void row_end(State&, int, int, int) const {}
    __device__ __forceinline__ void op(State& st, PkSt& ps, const UCtx& uc, int row, int pn, int seg, int lc, const int n, f32x4& a, f32x4& b) const {
#pragma unroll
        for (int h = 0; h < 2; ++h) { const unsigned gn = st.w[(n * 2 + h) * 2], gd = st.w[(n * 2 + h) * 2 + 1]; f32x4& v = h ? b : a;
            const f32x4 num = (f32x4){(float)(gn & 255u), (float)((gn >> 8) & 255u), (float)((gn >> 16) & 255u), (float)(gn >> 24)};
            if (seg < 2) { const f32x4 den = (f32x4){(float)(gd & 255u), (float)((gd >> 8) & 255u), (float)((gd >> 16) & 255u), (float)(gd >> 24)};
                v = v * num * (f32x4){__builtin_amdgcn_rcpf(den[0]), __builtin_amdgcn_rcpf(den[1]), __builtin_amdgcn_rcpf(den[2]), __builtin_amdgcn_rcpf(den[3])}; }
            else { const f32x4 mo = v * num * (1.0f / 255.0f); bf16_t* dp = mrg + (size_t)row * 1024 + pn * 256 + lc + 128 * h; if (h) wstore<1>(ps, n, dp, mo); else wstore<0>(ps, n, dp, mo); } }
    }
};
template <bool RES> struct F6T {
    typedef StF State;
    static constexpr bool ACC_INIT = !RES;
    typedef StNone UCtx;
    __device__ __forceinline__ UCtx unit_ctx(int, int, int, int) const { return UCtx(); }
    const float* xs_p; const float* xs_s; float* xd; bf16_t* xb; float* rsq;
    typedef StNone Pre;
    __device__ __forceinline__ Pre row_pre(int, int, int, int, int) const { return Pre(); }
    __device__ __forceinline__ void row_begin(State& st, const Pre&) const { st.x = 0.f; }
    __device__ __forceinline__ void row_end(State& st, int row, int pn, int wc) const {
        float ss = st.x; ss += __shfl_xor(ss, 16); ss += __shfl_xor(ss, 32);
        if ((__lane_id()) < 16) rsq[(size_t)row * 16 + pn * 4 + wc] = ss; }
    __device__ __forceinline__ void init(f32x4 (&acc)[2][2][4][2], int pm, int pn, int wr, int wc, int fr, int fq) const {
#pragma unroll
        for (int ai = 0; ai < 2; ++ai)
#pragma unroll
            for (int m = 0; m < 4; ++m) { const int row = pm * BM + ai * HALF + wr * 64 + m * 16 + fr;
                const float* src = ((row < MP) ? xs_p + (size_t)row * 1024 : xs_s + (size_t)(row - MP) * 1024) + pn * 256 + wc * 32 + 8 * fq;
#pragma unroll
                for (int bj = 0; bj < 2; ++bj)
#pragma unroll
                    for (int n = 0; n < 2; ++n) acc[ai][bj][m][n] = *(const f32x4*)(src + 128 * bj + 4 * n); }
    }
    __device__ __forceinline__ void op(State& st, PkSt& ps, const UCtx& uc, int row, int pn, int, int lc, const int n, f32x4& a, f32x4& b) const {
        const float* src = (row < MP) ? xs_p + (size_t)row * 1024 : xs_s + (size_t)(row - MP) * 1024;
#pragma unroll
        for (int h = 0; h < 2; ++h) { const int col = pn * 256 + lc + 128 * h; f32x4 v = (h ? b : a); if (RES) v += *(const f32x4*)(src + col);
            st.x += (v[0] * v[0] + v[1] * v[1]) + (v[2] * v[2] + v[3] * v[3]);
            *(f32x4*)(xd + (size_t)row * 1024 + col) = v; if (h) wstore<1>(ps, n, xb + (size_t)row * 1024 + col, v); else wstore<0>(ps, n, xb + (size_t)row * 1024 + col, v); }
    }
};
struct F7 {
    typedef StF State;
    static constexpr bool ACC_INIT = false;
    typedef StNone UCtx;
    __device__ __forceinline__ UCtx unit_ctx(int, int, int, int) const { return UCtx(); }
    const float* rsq; bf16_t* act;
    typedef f32x4 Pre;
    __device__ __forceinline__ Pre row_pre(int row, int fq, int, int, int) const { return *(const f32x4*)(rsq + (size_t)row * 16 + fq * 4); }
    __device__ __forceinline__ void row_begin(State& st, const Pre& p) const { st.x = rs_from4(p); }
    __device__ __forceinline__ void row_end(State&, int, int, int) const {}
    __device__ __forceinline__ void op(State& st, PkSt& ps, const UCtx& uc, int row, int pn, int, int lc, const int n, f32x4& a, f32x4& b) const {
        if (row >= MT) return;
        const f32x4 gte = a * st.x, up = b * st.x; wstore<0>(ps, n, act + (size_t)row * DFF + pn * 128 + lc, gte * sigm4(gte) * up);
    }
};

template <int MODE> __device__ __forceinline__ int srccol(int n) {
    if (MODE == 1) { if (n >= 1024 && n < 2048) { const int q = (n - 1024) >> 8, r = (n - 1024) & 255; return r < 128 ? 1024 + 128 * q + r : 1536 + 128 * q + (r - 128); } return n; }
    if (MODE == 2) { const int t = n >> 8, r = n & 255; return r < 128 ? 128 * t + r : DFF + 128 * t + (r - 128); }
    return n;
}
template <int MODE>
__device__ __forceinline__ int conv_T(LAS float* tile, const float* src, int ldsrc, const float* scale, bf16_t* dst, int ldd, int N, int K, int nb, int bi, int base) {
    const int tid = otid(), ntn = N >> 8, ntiles = ntn * (K >> 6);
    int t = bi - (base % nb); if (t < 0) t += nb;
    const int q = tid & 63, kr = tid >> 6; f32x4 v[8]; float sc8[8];
#define CT_LOAD(tt) do { const int n0_ = ((tt) % ntn) << 8, k0_ = ((tt) / ntn) << 6, sc_ = srccol<MODE>(n0_ + 4 * q); \
        _Pragma("unroll") for (int i = 0; i < 8; ++i) { v[i] = *(const f32x4*)(src + (size_t)(k0_ + i * 8 + kr) * ldsrc + sc_); sc8[i] = scale ? scale[k0_ + i * 8 + kr] : 1.0f; } } while (0)
    if (t < ntiles) CT_LOAD(t);
    for (; t < ntiles; t += nb) {
        const int n0 = (t % ntn) << 8, k0 = (t / ntn) << 6;
#pragma unroll
        for (int i = 0; i < 8; ++i) *(LAS f32x4*)(tile + (i * 8 + kr) * 260 + 4 * q) = v[i] * sc8[i];
        __syncthreads();
        if (t + nb < ntiles) CT_LOAD(t + nb);
        { const int n = tid >> 1, kh = tid & 1;
#pragma unroll
          for (int j4 = 0; j4 < 4; ++j4) { float w[8];
#pragma unroll
              for (int j = 0; j < 8; ++j) w[j] = tile[(kh * 32 + j4 * 8 + j) * 260 + n];
              store8(dst + (size_t)(n0 + n) * ldd + k0 + kh * 32 + j4 * 8, w); } }
        __syncthreads();
    }
#undef CT_LOAD
    return base + ntiles;
}

__device__ __forceinline__ void s5_build(KArgsP a, int l, int g, LAS unsigned char* lds, const int part, const int nparts) {
    const int tid = otid();
    LAS float* apr = (LAS float*)lds; LAS float* api = apr + 17 * 64; LAS float* bbr = api + 17 * 64; LAS float* bbi = bbr + 1024;
    LAS float* ccr = bbi + 1024; LAS float* cci = ccr + 1024; LAS float* kk = cci + 1024;
    const float* lam_re = a->in[20] + (size_t)(l * 32 + g) * 64; const float* lam_im = a->in[21] + (size_t)(l * 32 + g) * 64;
    const float dt = expf(a->in[22][l * 32 + g]);
    bf16_t* TF = (bf16_t*)(a->ws + OFF_TF); bf16_t* ET = (bf16_t*)(a->ws + OFF_ET); float* TAB = (float*)(a->ws + OFF_TAB);
    for (int idx = tid; idx < 17 * 64; idx += 512) { const int d = idx >> 6, p = idx & 63; const float lr = lam_re[p], li = lam_im[p];
        const float mag = expf((float)d * lr * dt);
        double x = (double)d * (double)li * (double)dt; x -= 6.283185307179586 * rint(x * 0.15915494309189535); const float xr = (float)x;
        apr[idx] = mag * cosf(xr); api[idx] = mag * sinf(xr); }
    __syncthreads();
    for (int idx = tid; idx < 1024; idx += 512) { const int p = idx >> 4; const float lr = lam_re[p], li = lam_im[p], ar = apr[64 + p], ai = api[64 + p], den = lr * lr + li * li;
        const float qr = ((ar - 1.0f) * lr + ai * li) / den, qi = (ai * lr - (ar - 1.0f) * li) / den;
        const float br = a->in[23][(size_t)(l * 32 + g) * 1024 + idx], bi = a->in[24][(size_t)(l * 32 + g) * 1024 + idx];
        bbr[idx] = qr * br - qi * bi; bbi[idx] = qr * bi + qi * br;
        ccr[idx] = a->in[25][(size_t)(l * 32 + g) * 1024 + idx]; cci[idx] = a->in[26][(size_t)(l * 32 + g) * 1024 + idx]; }
    __syncthreads();
    if (part == 0 && tid < 64) { TAB[(g * 64 + tid) * 2] = apr[64 + tid]; TAB[(g * 64 + tid) * 2 + 1] = api[64 + tid]; TAB[4096 + (g * 64 + tid) * 2] = apr[16 * 64 + tid]; TAB[4096 + (g * 64 + tid) * 2 + 1] = api[16 * 64 + tid]; }
    if (part == 0) for (int idx = tid; idx < 1024; idx += 512) { TAB[8192 + ((size_t)g * 1024 + idx) * 2] = bbr[idx]; TAB[8192 + ((size_t)g * 1024 + idx) * 2 + 1] = bbi[idx]; }
    for (int idx = tid; idx < 4096; idx += 512) { const int d = idx >> 8, c = (idx >> 4) & 15, c2 = idx & 15; float s = 0.f;
        for (int p = 0; p < 64; ++p) { const float Pr = apr[d * 64 + p], Pi = api[d * 64 + p], Br = bbr[p * 16 + c2], Bi = bbi[p * 16 + c2];
            const float Wr = Pr * Br - Pi * Bi, Wi = Pr * Bi + Pi * Br; s += ccr[c * 64 + p] * Wr - cci[c * 64 + p] * Wi; }
        kk[idx] = s; }
    __syncthreads();
    const int tfn = 256 / nparts, etn = 128 / nparts;
    for (int idx = part * tfn * KS5 + tid; idx < (part + 1) * tfn * KS5; idx += 512) { const int n = idx / KS5, k = idx % KS5, i = n >> 4, c = n & 15; float v;
        if (k < 256) { const int j = k >> 4, c2 = k & 15; v = (i >= j) ? kk[(i - j) * 256 + c * 16 + c2] : 0.f; }
        else if (k < 320) { const int p = k - 256; v = ccr[c * 64 + p] * apr[(i + 1) * 64 + p] - cci[c * 64 + p] * api[(i + 1) * 64 + p]; }
        else { const int p = k - 320; v = -(ccr[c * 64 + p] * api[(i + 1) * 64 + p] + cci[c * 64 + p] * apr[(i + 1) * 64 + p]); }
        TF[((size_t)g * 256 + n) * KS5 + k] = f2bf(v); }
    for (int idx = part * etn * 256 + tid; idx < (part + 1) * etn * 256; idx += 512) { const int n = idx >> 8, k = idx & 255, p = n & 63, j = k >> 4, c2 = k & 15, d = 15 - j;
        const float Pr = apr[d * 64 + p], Pi = api[d * 64 + p], Br = bbr[p * 16 + c2], Bi = bbi[p * 16 + c2];
        ET[((size_t)g * 128 + n) * 256 + k] = f2bf(n < 64 ? (Pr * Br - Pi * Bi) : (Pr * Bi + Pi * Br)); }
    if (g == 31 && part == 0) for (int idx = tid; idx < 128 * 256; idx += 512) ET[(size_t)32 * 128 * 256 + idx] = 0;
    __syncthreads();
}

__device__ __forceinline__ void phase0(KArgsP a, int l, LAS unsigned char* lds) {
    const int tid = otid(), blk = blockIdx.x, nblk = gridDim.x;
    LAS float* tile = (LAS float*)lds; unsigned char* ws = a->ws;
    const int nsb = (nblk >= 256) ? 128 : 0, nb = nblk - nsb;
    if (blk < nb) { int base = 0;
        base = conv_T<1>(tile, a->in[8] + (size_t)l * 1024 * INW, INW, a->in[7] + l * 1024, (bf16_t*)(ws + OFF_WIN), 1024, INW, 1024, nb, blk, base);
        base = conv_T<2>(tile, a->in[36] + (size_t)l * 1024 * INW, INW, a->in[35] + l * 1024, (bf16_t*)(ws + OFF_WF1), 1024, INW, 1024, nb, blk, base);
        base = conv_T<0>(tile, a->in[37] + (size_t)l * DFF * 1024, 1024, nullptr, (bf16_t*)(ws + OFF_WF2), DFF, 1024, DFF, nb, blk, base);
        base = conv_T<0>(tile, a->in[31] + (size_t)l * 1024 * 1024, 1024, nullptr, (bf16_t*)(ws + OFF_WPA), 1024, 1024, 1024, nb, blk, base);
        base = conv_T<0>(tile, a->in[34] + (size_t)l * 1024 * 1024, 1024, nullptr, (bf16_t*)(ws + OFF_WOUT), 1024, 1024, 1024, nb, blk, base);
        base = conv_T<0>(tile, a->in[32] + (size_t)l * 512 * 1024, 1024, nullptr, (bf16_t*)(ws + OFF_WPB), 512, 1024, 512, nb, blk, base);
        base = conv_T<0>(tile, a->in[33] + (size_t)l * 512 * 1024, 1024, nullptr, (bf16_t*)(ws + OFF_WPC), 512, 1024, 512, nb, blk, base);
        base = conv_T<0>(tile, a->in[28] + (size_t)l * 512 * 512, 512, nullptr, (bf16_t*)(ws + OFF_WGLU), 512, 512, 512, nb, blk, base);
    }
    { bf16_t* wgt = (bf16_t*)(ws + OFF_WGT); const float* wrg = a->in[11] + (size_t)l * 8 * 128 * 128; const float* wig = a->in[13] + (size_t)l * 8 * 128 * 128;
      for (int idx = blk * 512 + tid; idx < 2048 * 256; idx += nblk * 512) { const int n = idx >> 8, k = idx & 255, h = n >> 8, s = (n >> 7) & 1, j = n & 127; float v = 0.f;
          if ((k >> 7) == (h & 1)) v = (s ? wig : wrg)[((size_t)h * 128 + (k & 127)) * 128 + j];
          wgt[idx] = f2bf(v); } }
    { float* TAB = (float*)(ws + OFF_TAB); for (int idx = blk * 512 + tid; idx < 1024; idx += nblk * 512) TAB[TAB_LAM + idx] = -8.0f * log1pf(expf(-a->in[15][l * 1024 + idx])); }
    if (nsb) { if (blk >= nb) s5_build(a, l, (blk - nb) >> 2, lds, (blk - nb) & 3, 4); } else { for (int g = blk; g < 32; g += nblk) s5_build(a, l, g, lds, 0, 1); }
    if (l == 0) {
        bf16_t* xb = (bf16_t*)(ws + OFF_XB); float* rsq = (float*)(ws + OFF_RSQ); const int wv = tid >> 6, lane = tid & 63;
        f32x4 vn[4]; const int rstep = nblk * 8; int row = blk * 8 + wv;
        if (row < MT) { const float* src = (row < MP) ? a->in[0] + (size_t)row * 1024 : a->in[1] + (size_t)(row - MP) * 1024;
#pragma unroll
            for (int i = 0; i < 4; ++i) vn[i] = *(const f32x4*)(src + i * 256 + lane * 4); }
        for (; row < MT; row += rstep) { f32x4 vc[4]; float ss = 0.f;
#pragma unroll
            for (int i = 0; i < 4; ++i) vc[i] = vn[i];
            if (row + rstep < MT) { const int rn = row + rstep; const float* src = (rn < MP) ? a->in[0] + (size_t)rn * 1024 : a->in[1] + (size_t)(rn - MP) * 1024;
#pragma unroll
                for (int i = 0; i < 4; ++i) vn[i] = *(const f32x4*)(src + i * 256 + lane * 4); }
#pragma unroll
            for (int i = 0; i < 4; ++i) { const f32x4 v = vc[i]; ss += v[0] * v[0] + v[1] * v[1] + v[2] * v[2] + v[3] * v[3];
                u32x2 w; w.x = cvt_pk_bf16(v[0], v[1]); w.y = cvt_pk_bf16(v[2], v[3]); *(u32x2*)(xb + (size_t)row * 1024 + i * 256 + lane * 4) = w; }
            ss = wave_sum(ss); if (lane < 16) rsq[(size_t)row * 16 + lane] = (lane == 0) ? ss : 0.f; }
    }
}

__device__ __forceinline__ void conv_a_phase(KArgsP a, int l) {
    const bf16_t* ua = (const bf16_t*)(a->ws + OFF_SA); bf16_t* ca = (bf16_t*)(a->ws + OFF_SB);
    const float* w = a->in[9] + (size_t)l * 4 * 1024; const float* bias = a->in[10] + (size_t)l * 1024;
    const int tid = otid();
    const int c8 = (tid & 127) * 8;
    float wv[4][8], bv[8];
#pragma unroll
    for (int k = 0; k < 4; ++k) { const f32x4 p = *(const f32x4*)(w + k * 1024 + c8), q = *(const f32x4*)(w + k * 1024 + c8 + 4);
#pragma unroll
        for (int j = 0; j < 4; ++j) { wv[k][j] = p[j]; wv[k][4 + j] = q[j]; } }
    { const f32x4 p = *(const f32x4*)(bias + c8), q = *(const f32x4*)(bias + c8 + 4);
#pragma unroll
      for (int j = 0; j < 4; ++j) { bv[j] = p[j]; bv[4 + j] = q[j]; } }
    const int step = gridDim.x * 512; int idx = blockIdx.x * 512 + tid;
    u32x4 xv[4];
    if (idx < MT * 128) { const int row = idx >> 7;
#pragma unroll
        for (int k = 0; k < 4; ++k) { const int rr = row - 3 + k; xv[k] = *(const u32x4*)(ua + (size_t)(rr < 0 ? 0 : rr) * 1024 + c8); } }
    for (; idx < MT * 128; idx += step) {
        const int row = idx >> 7; float acc[8], x[8]; u32x4 xc[4];
#pragma unroll
        for (int k = 0; k < 4; ++k) xc[k] = xv[k];
        if (idx + step < MT * 128) { const int rown = (idx + step) >> 7;
#pragma unroll
            for (int k = 0; k < 4; ++k) { const int rr = rown - 3 + k; xv[k] = *(const u32x4*)(ua + (size_t)(rr < 0 ? 0 : rr) * 1024 + c8); } }
#pragma unroll
        for (int j = 0; j < 8; ++j) acc[j] = bv[j];
        unpack8(xc[3], x);
        if (row < MP) { const int t = row & (SEQ - 1), b = row >> 11;
#pragma unroll
            for (int k = 0; k < 4; ++k) { if (t - 3 + k >= 0) { float xk[8]; unpack8(xc[k], xk);
#pragma unroll
                for (int j = 0; j < 8; ++j) acc[j] += wv[k][j] * xk[j]; } }
            if (t >= SEQ - 3) { float* o = a->out + O_PLC + (((size_t)l * NBATCH + b) * 3 + (t - (SEQ - 3))) * 1024 + c8;
#pragma unroll
                for (int j = 0; j < 8; ++j) o[j] = x[j]; }
        } else { const int s = row - MP; const float* st = a->in[2] + ((size_t)l * MS + s) * 3 * 1024 + c8; float* o = a->out + O_SLC + ((size_t)l * MS + s) * 3 * 1024 + c8;
#pragma unroll
            for (int j = 0; j < 8; ++j) { const float s0 = st[j], s1 = st[1024 + j], s2 = st[2048 + j];
                acc[j] += wv[0][j] * s0 + wv[1][j] * s1 + wv[2][j] * s2 + wv[3][j] * x[j]; o[j] = s1; o[1024 + j] = s2; o[2048 + j] = x[j]; }
        }
        store8(ca + (size_t)row * 1024 + c8, acc);
    }
}

__device__ __forceinline__ void cfm_phase(KArgsP a, int l, LAS unsigned char* lds) {
    const int tid = otid(), half = tid >> 8, cp = tid & 255, wv = tid >> 6, lane = tid & 63;
    const bf16_t* glu = (const bf16_t*)(a->ws + OFF_SE); bf16_t* yb = (bf16_t*)(a->ws + OFF_YB);
    LAS unsigned* in = (LAS unsigned*)lds;
    LAS float* part = (LAS float*)(lds + 62 * 1024);
    const float* wdw = a->in[16] + (size_t)l * 31 * 512 + 2 * cp;
    typedef float f32x2 __attribute__((ext_vector_type(2)));
    LAS f32x2* wl = (LAS f32x2*)(lds + 65536);
    for (int idx = tid; idx < 31 * 256; idx += 512) { const f32x2 wk = *(const f32x2*)(a->in[16] + (size_t)l * 31 * 512 + 2 * idx);
        u32x2 pk; pk.x = cvt_pk_bf16(wk.x, 0.f); pk.y = cvt_pk_bf16(0.f, wk.y); ((LAS u32x2*)wl)[idx] = pk; }
    const float bs0 = a->in[17][l * 512 + 2 * cp], bs1 = a->in[17][l * 512 + 2 * cp + 1];
    const float lg0 = a->in[18][l * 512 + 2 * cp], lg1 = a->in[18][l * 512 + 2 * cp + 1], lb0 = a->in[19][l * 512 + 2 * cp], lb1 = a->in[19][l * 512 + 2 * cp + 1];
    u32x4 pv[8];
#define CFM_LOAD(tl) do { const int b_ = (tl) >> 6, t0_ = ((tl) & 63) * 32; \
        _Pragma("unroll") for (int i = 0; i < 8; ++i) { const int idx = tid + 512 * i, r = idx >> 6, c16 = idx & 63, t = t0_ - 30 + r; pv[i] = (u32x4){0u, 0u, 0u, 0u}; \
            if (idx < 62 * 64 && t >= 0) pv[i] = *(const u32x4*)(glu + ((size_t)b_ * SEQ + t) * 512 + c16 * 8); } } while (0)
    if ((int)blockIdx.x < 512) CFM_LOAD((int)blockIdx.x);
    const int ntl = (gridDim.x == 256) ? 768 : 512 + 64;
    for (int tile0 = blockIdx.x; tile0 < ntl; tile0 += gridDim.x) {
        int tile = tile0;
        if (gridDim.x == 256 && tile0 >= 512) { tile = 512 + (((int)blockIdx.x + 64) & 255); if (tile >= 512 + 64) continue; }
        if (tile < 512) {
            const int b = tile >> 6, t0 = (tile & 63) * 32;
#pragma unroll
            for (int i = 0; i < 8; ++i) { const int idx = tid + 512 * i; if (idx < 62 * 64) *(LAS u32x4*)(in + (idx >> 6) * 256 + (idx & 63) * 4) = pv[i]; }
            if (tile + (int)gridDim.x < 512) CFM_LOAD(tile + (int)gridDim.x);
            __syncthreads();
            float val0[16], val1[16];
#pragma unroll
            for (int j = 0; j < 16; ++j) { val0[j] = bs0; val1[j] = bs1; }
#pragma unroll 1
            for (int k = 0; k < 31; ++k) { const u32x2 wk = ((const LAS u32x2*)wl)[k * 256 + cp]; const LAS unsigned* ip = in + (half * 16 + k) * 256 + cp;
#pragma unroll
                for (int j = 0; j < 16; ++j) { const unsigned xw = ip[j * 256];
                    asm("v_dot2c_f32_bf16 %0, %1, %2" : "+v"(val0[j]) : "v"(xw), "v"(wk.x));
                    asm("v_dot2c_f32_bf16 %0, %1, %2" : "+v"(val1[j]) : "v"(xw), "v"(wk.y)); } }
#pragma unroll
            for (int ti = 0; ti < 16; ++ti) { float s = val0[ti] + val1[ti], q = val0[ti] * val0[ti] + val1[ti] * val1[ti]; s = wave_sum(s); q = wave_sum(q);
                if (lane == 0) { part[((half * 16 + ti) * 4 + (wv & 3)) * 2] = s; part[((half * 16 + ti) * 4 + (wv & 3)) * 2 + 1] = q; } }
            if (t0 + 32 == SEQ) {
                float* o = a->out + O_PCC + ((size_t)l * NBATCH + b) * 30 * 512;
                for (int idx = tid; idx < 30 * 256; idx += 512) { const int r = idx >> 8, c = idx & 255; const unsigned xw = in[(32 + r) * 256 + c]; o[r * 512 + 2 * c] = __uint_as_float(xw << 16); o[r * 512 + 2 * c + 1] = __uint_as_float(xw & 0xffff0000u); } }
            __syncthreads();
#pragma unroll
            for (int ti = 0; ti < 16; ++ti) { const LAS float* pp = part + (half * 16 + ti) * 8; const float S = (pp[0] + pp[2]) + (pp[4] + pp[6]), Q = (pp[1] + pp[3]) + (pp[5] + pp[7]);
                const float mean = S * (1.0f / 512.0f), var = fmaxf(Q * (1.0f / 512.0f) - mean * mean, 0.f), rstd = rsqrtf(var + EPS);
                float y0 = (val0[ti] - mean) * rstd * lg0 + lb0, y1 = (val1[ti] - mean) * rstd * lg1 + lb1; y0 *= sigm(y0); y1 *= sigm(y1);
                *(unsigned*)(yb + ((size_t)b * SEQ + t0 + half * 16 + ti) * 512 + 2 * cp) = cvt_pk_bf16(y0, y1); }
            __syncthreads();
        } else {
            const int s = (tile - 512) * 2 + half; const float* st = a->in[4] + ((size_t)l * MS + s) * 30 * 512 + 2 * cp; float* o = a->out + O_SCC + ((size_t)l * MS + s) * 30 * 512 + 2 * cp;
            float a0 = bs0, a1 = bs1;
#pragma unroll 2
            for (int k = 0; k < 30; ++k) { const float x0 = st[k * 512], x1 = st[k * 512 + 1]; a0 += wdw[k * 512] * x0; a1 += wdw[k * 512 + 1] * x1; if (k >= 1) { o[(k - 1) * 512] = x0; o[(k - 1) * 512 + 1] = x1; } }
            { const unsigned xw = *(const unsigned*)(glu + (size_t)(MP + s) * 512 + 2 * cp); const float x0 = __uint_as_float(xw << 16), x1 = __uint_as_float(xw & 0xffff0000u);
              a0 += wdw[30 * 512] * x0; a1 += wdw[30 * 512 + 1] * x1; o[29 * 512] = x0; o[29 * 512 + 1] = x1; }
            float sm = wave_sum(a0 + a1), q = wave_sum(a0 * a0 + a1 * a1);
            if (lane == 0) { part[(half * 4 + (wv & 3)) * 2] = sm; part[(half * 4 + (wv & 3)) * 2 + 1] = q; }
            __syncthreads();
            { const LAS float* pp = part + half * 8; const float S = (pp[0] + pp[2]) + (pp[4] + pp[6]), Q = (pp[1] + pp[3]) + (pp[5] + pp[7]);
              const float mean = S * (1.0f / 512.0f), var = fmaxf(Q * (1.0f / 512.0f) - mean * mean, 0.f), rstd = rsqrtf(var + EPS);
              float y0 = (a0 - mean) * rstd * lg0 + lb0, y1 = (a1 - mean) * rstd * lg1 + lb1; y0 *= sigm(y0); y1 *= sigm(y1);
              *(unsigned*)(yb + (size_t)(MP + s) * 512 + 2 * cp) = cvt_pk_bf16(y0, y1); }
            __syncthreads();
        }
    }
}

#undef CFM_LOAD
__device__ __forceinline__ void s5_sample(KArgsP a, int l) {
    const int tid = otid(); const int wv = tid >> 6, p = tid & 63; const float* TAB = (const float*)(a->ws + OFF_TAB);
    const bf16_t* ucs = (const bf16_t*)(a->ws + OFF_UCS); bf16_t* yc0 = (bf16_t*)(a->ws + OFF_SE);
    for (int w = blockIdx.x * 8 + wv; w < MS * 32; w += gridDim.x * 8) { const int s = w >> 5, g = w & 31;
        float u[16]; load8(ucs + (size_t)s * 512 + g * 16, u); load8(ucs + (size_t)s * 512 + g * 16 + 8, u + 8);
        const float ar = TAB[(g * 64 + p) * 2], ai = TAB[(g * 64 + p) * 2 + 1]; const float* bb = TAB + 8192 + ((size_t)g * 1024 + p * 16) * 2;
        const size_t si = (((size_t)l * MS + s) * 32 + g) * 64 + p; const float s0r = a->in[5][si], s0i = a->in[6][si];
        float xr = ar * s0r - ai * s0i, xi = ar * s0i + ai * s0r;
#pragma unroll
        for (int c = 0; c < 16; ++c) { xr += bb[2 * c] * u[c]; xi += bb[2 * c + 1] * u[c]; }
        a->out[O_SSR + si] = xr; a->out[O_SSI + si] = xi;
        const float* cr = a->in[25] + (size_t)(l * 32 + g) * 1024; const float* ci = a->in[26] + (size_t)(l * 32 + g) * 1024; float mine = 0.f;
#pragma unroll
        for (int c = 0; c < 16; ++c) { const float t = wave_sum(cr[c * 64 + p] * xr - ci[c * 64 + p] * xi); if (p == c) mine = t; }
        float up = 0.f;
#pragma unroll
        for (int c = 0; c < 16; ++c) up = (p == c) ? u[c] : up;
        if (p < 16) yc0[(size_t)(MP + s) * 512 + g * 16 + p] = f2bf(gelu_tanh(mine + a->in[27][l * 512 + g * 16 + p] * up));
    }
}

__device__ __forceinline__ void s5_carry_bg(KArgsP a, int l, LAS unsigned char* lds, const int b, const int g) {
    const int tid = otid(), seg = tid >> 6, p = tid & 63; const float* TAB = (const float*)(a->ws + OFF_TAB);
    const float* ends = (const float*)(a->ws + OFF_SF); bf16_t* ucg = (bf16_t*)(a->ws + OFF_UCG); LAS float* sT = (LAS float*)lds;
    {
        const float ar = TAB[4096 + (g * 64 + p) * 2], ai = TAB[4096 + (g * 64 + p) * 2 + 1];
        const size_t c0 = (size_t)g * NCHK + b * 128 + seg * 16; float er[16], ei[16];
#pragma unroll
        for (int k = 0; k < 16; ++k) { er[k] = ends[(c0 + k) * 128 + p]; ei[k] = ends[(c0 + k) * 128 + 64 + p]; }
        float Lr[17], Li[17]; Lr[0] = 0.f; Li[0] = 0.f;
#pragma unroll
        for (int k = 0; k < 16; ++k) { Lr[k + 1] = ar * Lr[k] - ai * Li[k] + er[k]; Li[k + 1] = ar * Li[k] + ai * Lr[k] + ei[k]; }
        sT[(seg * 64 + p) * 2] = Lr[16]; sT[(seg * 64 + p) * 2 + 1] = Li[16];
        __syncthreads();
        float br = ar, bi = ai;
#pragma unroll
        for (int i = 0; i < 4; ++i) { const float t = br * br - bi * bi; bi = 2.f * br * bi; br = t; }
        float Sr = 0.f, Si = 0.f;
        for (int s2 = 0; s2 < seg; ++s2) { const float tr = sT[(s2 * 64 + p) * 2], ti = sT[(s2 * 64 + p) * 2 + 1]; const float nr = br * Sr - bi * Si + tr; Si = br * Si + bi * Sr + ti; Sr = nr; }
        float pr = 1.f, pi = 0.f;
#pragma unroll
        for (int k = 0; k < 16; ++k) { const float vr = Lr[k] + pr * Sr - pi * Si, vi = Li[k] + pr * Si + pi * Sr;
            ucg[(c0 + k) * KS5 + 256 + p] = f2bf(vr); ucg[(c0 + k) * KS5 + 320 + p] = f2bf(vi);
            const float t = pr * ar - pi * ai; pi = pr * ai + pi * ar; pr = t; }
        if (seg == 7) { const size_t o = (((size_t)l * NBATCH + b) * 32 + g) * 64 + p; a->out[O_PSR + o] = Lr[16] + br * Sr - bi * Si; a->out[O_PSI + o] = Li[16] + br * Si + bi * Sr; }
        __syncthreads();
    }
}
__device__ __forceinline__ void s5_carry(KArgsP a, int l, LAS unsigned char* lds) { for (int w = blockIdx.x; w < NBATCH * 32; w += gridDim.x) s5_carry_bg(a, l, lds, w >> 5, w & 31); }

__device__ __forceinline__ void lru_scan(KArgsP a, int l, LAS unsigned char* lds, bf16_t* dst_alt) {
    const int tid = otid(), cq = tid & 7, chunk = tid >> 3;
    bf16_t* la = (bf16_t*)(a->ws + OFF_SA); const bf16_t* bx = (const bf16_t*)(a->ws + OFF_SC);
    LAS f32x4* sP = (LAS f32x4*)lds; LAS f32x4* sH = sP + 64 * 8;
    for (int w = blockIdx.x; w < NBATCH * 32; w += gridDim.x) { const int b = w >> 5, cg_ = w & 31;
        const size_t base = ((size_t)b * SEQ + chunk * 32) * 1024 + cg_ * 32 + cq * 4;
        f32x4 P = (f32x4){1.f, 1.f, 1.f, 1.f}, h = (f32x4){0.f, 0.f, 0.f, 0.f};
        u32x2 lw[32], bw[32];
#pragma unroll
        for (int j = 0; j < 32; ++j) { lw[j] = *(const u32x2*)(la + base + (size_t)j * 1024); bw[j] = *(const u32x2*)(bx + base + (size_t)j * 1024); }
#pragma unroll
        for (int j = 0; j < 32; ++j) { const f32x4 av = (f32x4){__expf(bf2f(lw[j].x & 0xffffu)), __expf(bf2f(lw[j].x >> 16)), __expf(bf2f(lw[j].y & 0xffffu)), __expf(bf2f(lw[j].y >> 16))};
            const f32x4 bv = (f32x4){bf2f(bw[j].x & 0xffffu), bf2f(bw[j].x >> 16), bf2f(bw[j].y & 0xffffu), bf2f(bw[j].y >> 16)};
            h = av * h + bv; P = P * av; }
        sP[chunk * 8 + cq] = P; sH[chunk * 8 + cq] = h;
        __syncthreads();
        f32x4 cin = (f32x4){0.f, 0.f, 0.f, 0.f};
        for (int c2 = 0; c2 < chunk; ++c2) cin = sP[c2 * 8 + cq] * cin + sH[c2 * 8 + cq];
        h = cin;
#pragma unroll
        for (int j = 0; j < 32; ++j) { asm volatile("" : "+v"(lw[j].x), "+v"(lw[j].y), "+v"(bw[j].x), "+v"(bw[j].y));
            const f32x4 av = (f32x4){__expf(bf2f(lw[j].x & 0xffffu)), __expf(bf2f(lw[j].x >> 16)), __expf(bf2f(lw[j].y & 0xffffu)), __expf(bf2f(lw[j].y >> 16))};
            const f32x4 bv = (f32x4){bf2f(bw[j].x & 0xffffu), bf2f(bw[j].x >> 16), bf2f(bw[j].y & 0xffffu), bf2f(bw[j].y >> 16)};
            h = av * h + bv; u32x2 o; o.x = cvt_pk_bf16(h[0], h[1]); o.y = cvt_pk_bf16(h[2], h[3]); *(u32x2*)(dst_alt + base + (size_t)j * 1024) = o; }
        if (chunk == 63) *(f32x4*)(a->out + O_PLH + ((size_t)l * NBATCH + b) * 1024 + cg_ * 32 + cq * 4) = h;
        __syncthreads();
    }
}


#define XB_TMO      128
#define XB_XCNT(j)  (256  + 64 * (j))
#define XB_XSUB(j)  (1280 + 64 * (j))
#define XB_XGEN(j)  (2304 + 64 * (j))
#define XB_TOP      3328
#define XB_TOPGEN   3392
#define XCD_BAR_WORDS 3456
#define XB_SPIN_CAP (1u << 18)
__device__ __forceinline__ unsigned xb_ld(unsigned* p)              { return __hip_atomic_load(p, __ATOMIC_RELAXED, __HIP_MEMORY_SCOPE_AGENT); }
__device__ __forceinline__ unsigned xb_add(unsigned* p, unsigned v) { return __hip_atomic_fetch_add(p, v, __ATOMIC_RELAXED, __HIP_MEMORY_SCOPE_AGENT); }
__device__ __forceinline__ unsigned xb_xcc_id() { return (unsigned)__builtin_amdgcn_s_getreg((3 << 11) | 20) & 0xFu; }
#define XB_SPIN(cond, bar) do { unsigned _sp = 0; while (cond) { __builtin_amdgcn_s_sleep(1); \
    if ((++_sp & 255u) == 0u) { if (xb_ld(&(bar)[XB_TMO])) break; if (_sp > XB_SPIN_CAP) { atomicAdd(&(bar)[XB_TMO], 1u); break; } } } } while (0)
__device__ __forceinline__ void xcd_barrier_complete(unsigned* bar, unsigned x, unsigned& nloc, unsigned& nx) {
    const unsigned G = gridDim.x * gridDim.y * gridDim.z;
    unsigned sum, cnt, mine, sp = 0u;
    for (;;) {
        sum = 0u; cnt = 0u; mine = 0u;
#pragma unroll
        for (unsigned j = 0; j < 16; ++j) { const unsigned c = xb_ld(&bar[XB_XCNT(j)]); sum += c; cnt += (c > 0u) ? 1u : 0u; mine = (j == x) ? c : mine; }
        if (sum == G) break;
        __builtin_amdgcn_s_sleep(1);
        if ((++sp & 255u) == 0u) { if (xb_ld(&bar[XB_TMO])) break; if (sp > XB_SPIN_CAP) { atomicAdd(&bar[XB_TMO], 1u); break; } }
    }
    nloc = mine > 0u ? mine : 1u; nx = cnt > 0u ? cnt : 1u;
}
__device__ __forceinline__ void xcd_barrier(unsigned* bar, volatile LAS unsigned* st) {
    asm volatile("s_waitcnt vmcnt(0)" ::: "memory");
    __syncthreads();
    if (threadIdx.x == 0) {
        const unsigned x = xb_xcc_id();
        __builtin_amdgcn_s_waitcnt(0);
        unsigned nloc = st[0], nx = st[1];
        if (nloc == 0u) { xcd_barrier_complete(bar, x, nloc, nx); st[0] = nloc; st[1] = nx; }
        const unsigned old = xb_add(&bar[XB_XSUB(x)], 1u);
        const unsigned gen = old / nloc;
        if (old + 1u == (gen + 1u) * nloc) {
            __builtin_amdgcn_fence(__ATOMIC_RELEASE, "agent");
            asm volatile("s_waitcnt vmcnt(0)" ::: "memory");
            const unsigned og = xb_add(&bar[XB_TOP], 1u);
            const unsigned tg = og / nx;
            if (og + 1u == (tg + 1u) * nx) xb_add(&bar[XB_TOPGEN], 1u);
            else XB_SPIN(xb_ld(&bar[XB_TOPGEN]) == tg, bar);
            __builtin_amdgcn_fence(__ATOMIC_ACQUIRE, "agent");
            xb_add(&bar[XB_XGEN(x)], 1u);
            asm volatile("s_waitcnt vmcnt(0)" ::: "memory");
        } else {
            XB_SPIN(xb_ld(&bar[XB_XGEN(x)]) == gen, bar);
            __builtin_amdgcn_fence(__ATOMIC_ACQUIRE, "agent");
            asm volatile("s_waitcnt vmcnt(0)" ::: "memory");
        }
    }
    __syncthreads();
}

#ifndef PROBE_DUP
#define PROBE_DUP -1
#endif
#define REP(k) for (int rep_ = 0; rep_ < ((PROBE_DUP) == (k) ? 2 : 1); ++rep_)
#define XBAR() xcd_barrier((unsigned*)(kargs()->ws + OFF_BAR), (volatile LAS unsigned*)(lds + 131072 + 512))
#define GSYNC() do { XBAR(); if ((PROBE_DUP) == 100) XBAR(); } while (0)
#ifndef PH_ONLY
#define PH_ON(n) true
#else
#define PH_ON(n) ((n) == PH_ONLY)
#endif
__global__ void __launch_bounds__(512) fwd_megakernel(KArgs a_by_value) {
    extern __shared__ __attribute__((aligned(16))) unsigned char lds_raw[];
    LAS unsigned char* lds = (LAS unsigned char*)lds_raw;
    cg::grid_group grid = cg::this_grid();
    { volatile LAS unsigned* st = (volatile LAS unsigned*)(lds + 131072 + 512); if (threadIdx.x == 0) { st[0] = 0u; st[1] = 0u; }
      __syncthreads();
      if (threadIdx.x == 0) (void)xb_add((unsigned*)(kargs()->ws + OFF_BAR) + XB_XCNT(xb_xcc_id()), 1u); }
    grid.sync();
#define WSB(off) ((bf16_t*)(ws + (off)))
#define PH_HEAD KArgsP a = kargs(); unsigned char* ws = a->ws; const int G = gridDim.x, c = oblk(); (void)G; (void)c; (void)ws;

    for (int l = 0; l < NLAYER; ++l) {
        REP(0) if (PH_ON(0)) { PH_HEAD phase0(a, l, lds); }
        GSYNC();
        REP(1) if (PH_ON(1)) { PH_HEAD
          Sched S{65, 10, 1, G, c, 0, (const char*)WSB(OFF_XB), (const char*)WSB(OFF_WIN), 0, 0, (size_t)256 * 1024 * 2, (size_t)256 * 1024 * 2};
          F1 f{(const float*)(ws + OFF_RSQ), WSB(OFF_SA), WSB(OFF_SE), WSB(OFF_UCG), WSB(OFF_UCS)};
          gemm_phase(lds, 1024, 1024, 16, S, f); }
        GSYNC();
        REP(20) if (PH_ON(20)) { PH_HEAD conv_a_phase(a, l); }
        REP(21) if (PH_ON(21)) { PH_HEAD cfm_phase(a, l, lds); }
        REP(22) if (PH_ON(22)) { PH_HEAD
          Sched S{4, 1, 32, G, c, 0, (const char*)WSB(OFF_UCG), (const char*)(ws + OFF_ET), (size_t)NCHK * KS5 * 2, (size_t)128 * 256 * 2, (size_t)256 * KS5 * 2, 0};
          FEnd f{(float*)(ws + OFF_SF)};
          gemm_phase(lds, KS5, 256, 4, S, f);
          if (G == 256) { Unit u; if (S.next(0, u)) { s5_carry_bg(a, l, lds, 2 * u.pm, u.g); s5_carry_bg(a, l, lds, 2 * u.pm + 1, u.g); } } }
        GSYNC();
        if (gridDim.x == 256) {
            REP(3) if (PH_ON(3)) { PH_HEAD
              const bool lo = c < 128;
              Sched S{64, 8, 1, 128, lo ? c : c - 128, 1, (const char*)WSB(OFF_SB), (const char*)(ws + OFF_WGT), 0, 0, (size_t)256 * 1024 * 2, (size_t)256 * 256 * 2, lo ? 0L : 384L, lo ? 384L : 512L};
              F2 f{WSB(OFF_SB), a->in[12] + l * 1024, a->in[14] + l * 1024, (const float*)(ws + OFF_TAB) + TAB_LAM, a->in[3] + (size_t)l * MS * 1024, WSB(OFF_SA), WSB(OFF_SC), a->out + O_SLH + (size_t)l * MS * 1024};
              gemm_phase(lds, 1024, 256, 4, S, f);
              thin_gemm(lds, WSB(OFF_SB), 1024, WSB(OFF_WGT), 256, 256, 8, 1, f, c, G); }
            REP(41) if (PH_ON(41)) { PH_HEAD
              if (c >= 128) { Sched S{4, 1, 32, G, c - 128, 0, (const char*)WSB(OFF_UCG), (const char*)(ws + OFF_TF), (size_t)NCHK * KS5 * 2, (size_t)256 * KS5 * 2, (size_t)256 * KS5 * 2, 0};
                FS5 f{WSB(OFF_UCG), a->in[27] + l * 512, WSB(OFF_SE)};
                gemm_phase(lds, KS5, KS5, 6, S, f); } }
            REP(23) if (PH_ON(23)) { PH_HEAD s5_sample(a, l); }
            GSYNC();
            REP(4) if (PH_ON(4)) { PH_HEAD lru_scan(a, l, lds, WSB(OFF_SA)); }
        } else {
        REP(3) if (PH_ON(3)) { PH_HEAD
          Sched S{64, 8, 1, G, c, 1, (const char*)WSB(OFF_SB), (const char*)(ws + OFF_WGT), 0, 0, (size_t)256 * 1024 * 2, (size_t)256 * 256 * 2};
          F2 f{WSB(OFF_SB), a->in[12] + l * 1024, a->in[14] + l * 1024, (const float*)(ws + OFF_TAB) + TAB_LAM, a->in[3] + (size_t)l * MS * 1024, WSB(OFF_SA), WSB(OFF_SC), a->out + O_SLH + (size_t)l * MS * 1024};
          gemm_phase(lds, 1024, 256, 4, S, f);
          thin_gemm(lds, WSB(OFF_SB), 1024, WSB(OFF_WGT), 256, 256, 8, 1, f, c, G); }
        REP(31) if (PH_ON(31)) { PH_HEAD s5_carry(a, l, lds); }
        GSYNC();
        REP(4) if (PH_ON(4)) { PH_HEAD lru_scan(a, l, lds, ((PROBE_DUP) == 4 && rep_ == 0) ? WSB(OFF_SB) : WSB(OFF_SA)); }
        REP(23) if (PH_ON(23)) { PH_HEAD s5_sample(a, l); }
        REP(41) if (PH_ON(41)) { PH_HEAD
          Sched S{4, 1, 32, G, c, 0, (const char*)WSB(OFF_UCG), (const char*)(ws + OFF_TF), (size_t)NCHK * KS5 * 2, (size_t)256 * KS5 * 2, (size_t)256 * KS5 * 2, 0};
          FS5 f{WSB(OFF_UCG), a->in[27] + l * 512, WSB(OFF_SE)};
          gemm_phase(lds, KS5, KS5, 6, S, f); }
        GSYNC();
        }
        REP(5) if (PH_ON(5)) {
            { PH_HEAD
              Sched S{64, 2, 1, G, c, 0, (const char*)WSB(OFF_SE), (const char*)(ws + OFF_WGLU), 0, 0, (size_t)256 * 512 * 2, (size_t)256 * 512 * 2};
              F4 f{WSB(OFF_SE), a->in[29] + l * 512, WSB(OFF_SF)};
              gemm_phase(lds, 512, 512, 8, S, f);
              const int hb = G >> 1;
              thin_gemm(lds, WSB(OFF_SE), 512, WSB(OFF_WGLU), 512, 512, 2, 0, f, c >= hb ? c - hb : -1, G - hb); }
            { PH_HEAD
              const int hb = G >> 1, cr = c >= hb ? c - hb : c + (G - hb);
              const bf16_t* Wg = WSB(OFF_WIN) + (size_t)2560 * 1024;
              Sched S{64, 12, 1, G, cr, 0, (const char*)WSB(OFF_XB), (const char*)Wg, 0, 0, (size_t)256 * 1024 * 2, (size_t)256 * 1024 * 2};
              FG8 f{(const float*)(ws + OFF_RSQ), a->in[30] + l * 3072, ws + OFF_GT8};
              gemm_phase(lds, 1024, 1024, 16, S, f);
              thin_gemm(lds, WSB(OFF_XB), 1024, Wg, 1024, 1024, 12, 0, f, c >= hb ? c - hb : -1, G - hb); }
        }
        GSYNC();
        REP(6) if (PH_ON(6)) {
            { PH_HEAD
              SchedM3 S{G, c, (const char*)WSB(OFF_SA), (const char*)WSB(OFF_YB), (const char*)WSB(OFF_SF), (const char*)WSB(OFF_WPA), (const char*)WSB(OFF_WPB), (const char*)WSB(OFF_WPC)};
              FMS f{ws + OFF_GT8, WSB(OFF_MRG)};
              gemm_phase_t<FMS, SchedM3, true>(lds, 1024, 1024, 16, S, f); }
            { PH_HEAD
              thin_merge(lds, WSB(OFF_SA), WSB(OFF_YB), WSB(OFF_SF), WSB(OFF_WPA), WSB(OFF_WPB), WSB(OFF_WPC), ws + OFF_GT8, WSB(OFF_MRG), c, G); }
        }
        GSYNC();
        if (PH_ON(7)) { PH_HEAD
          Sched S{64, 4, 1, G, c, 0, (const char*)WSB(OFF_MRG), (const char*)(ws + OFF_WOUT), 0, 0, (size_t)256 * 1024 * 2, (size_t)256 * 1024 * 2};
          F6T<false> f{l == 0 ? a->in[0] : a->out, l == 0 ? a->in[1] : a->out + (size_t)MP * 1024, a->out, WSB(OFF_XB), (float*)(ws + OFF_RSQ2)};
          gemm_phase(lds, 1024, 1024, 16, S, f);
          F6T<true> ft{f.xs_p, f.xs_s, f.xd, f.xb, f.rsq};
          thin_gemm(lds, WSB(OFF_MRG), 1024, WSB(OFF_WOUT), 1024, 1024, 4, 0, ft, c, G); }
        GSYNC();
        REP(8) if (PH_ON(8)) { PH_HEAD
          Sched S{65, 22, 1, G, c, 0, (const char*)WSB(OFF_XB), (const char*)(ws + OFF_WF1), 0, 0, (size_t)256 * 1024 * 2, (size_t)256 * 1024 * 2};
          F7 f{(const float*)(ws + OFF_RSQ2), WSB(OFF_SA)};
          gemm_phase(lds, 1024, 1024, 16, S, f); }
        GSYNC();
        if (PH_ON(9)) { PH_HEAD
          Sched S{64, 4, 1, G, c, 0, (const char*)WSB(OFF_SA), (const char*)(ws + OFF_WF2), 0, 0, (size_t)256 * DFF * 2, (size_t)256 * DFF * 2};
          F6T<false> f{a->out, a->out + (size_t)MP * 1024, a->out, WSB(OFF_XB), (float*)(ws + OFF_RSQ)};
          gemm_phase(lds, DFF, DFF, DFF / 64, S, f);
          F6T<true> ft{f.xs_p, f.xs_s, f.xd, f.xb, f.rsq};
          thin_gemm(lds, WSB(OFF_SA), DFF, WSB(OFF_WF2), DFF, DFF, 4, 0, ft, c, G); }
        GSYNC();
    }
    { PH_HEAD const int tid = otid(); const int wv = tid >> 6, lane = tid & 63; const float* gf = a->in[38]; const float* RSQ = (const float*)(ws + OFF_RSQ);
      f32x4 vn[4], pn4; const int rstep = gridDim.x * 8; int row = blockIdx.x * 8 + wv; f32x4 gv[4];
#pragma unroll
      for (int i = 0; i < 4; ++i) gv[i] = *(const f32x4*)(gf + i * 256 + lane * 4);
      if (row < MT) { pn4 = *(const f32x4*)(RSQ + (size_t)row * 16 + (lane & 3) * 4);
#pragma unroll
          for (int i = 0; i < 4; ++i) vn[i] = *(const f32x4*)(a->out + (size_t)row * 1024 + i * 256 + lane * 4); }
      for (; row < MT; row += rstep) { f32x4 vc[4]; const f32x4 pc = pn4;
#pragma unroll
          for (int i = 0; i < 4; ++i) vc[i] = vn[i];
          if (row + rstep < MT) { const int rn = row + rstep; pn4 = *(const f32x4*)(RSQ + (size_t)rn * 16 + (lane & 3) * 4);
#pragma unroll
              for (int i = 0; i < 4; ++i) vn[i] = *(const f32x4*)(a->out + (size_t)rn * 1024 + i * 256 + lane * 4); }
          float sq = (pc[0] + pc[1]) + (pc[2] + pc[3]); sq += __shfl_xor(sq, 1); sq += __shfl_xor(sq, 2);
          const float rs = rsqrtf(sq * (1.0f / 1024.0f) + EPS); float* x = a->out + (size_t)row * 1024;
#pragma unroll
          for (int i = 0; i < 4; ++i) *(f32x4*)(x + i * 256 + lane * 4) = vc[i] * rs * gv[i]; } }
}

extern "C" void kernel_launch(void* const* d_in, const int* in_sizes, int n_in, void* d_out, int out_size, void* d_ws, size_t ws_size, hipStream_t stream) {
    static int grid_blocks = 0;
    if (!grid_blocks) {
        int dev = 0, cus = 0, per_cu = 0;
        hipGetDevice(&dev);
        hipDeviceGetAttribute(&cus, hipDeviceAttributeMultiprocessorCount, dev);
        hipFuncSetAttribute((const void*)fwd_megakernel, hipFuncAttributeMaxDynamicSharedMemorySize, LDS_BYTES);
        hipOccupancyMaxActiveBlocksPerMultiprocessor(&per_cu, (const void*)fwd_megakernel, 512, LDS_BYTES);
        if (per_cu < 1) { fprintf(stderr, "occupancy query says %d blocks/CU\n", per_cu); per_cu = 1; }
        if (per_cu > 1) per_cu = 1;
        grid_blocks = cus * per_cu;
        if (n_in != 39 || ws_size < WS_END) fprintf(stderr, "kernel_launch: unexpected n_in %d / ws_size %zu (need %zu)\n", n_in, ws_size, (size_t)WS_END);
    }
    (void)hipMemsetAsync((unsigned char*)d_ws + OFF_BAR, 0, 16384, stream);
    KArgs a{};
    for (int i = 0; i < 39; ++i) a.in[i] = (const float*)d_in[i];
    a.out = (float*)d_out; a.ws = (unsigned char*)d_ws;
    void* args[] = {&a};
    hipError_t e = hipLaunchCooperativeKernel((const void*)fwd_megakernel, dim3(grid_blocks), dim3(512), args, LDS_BYTES, stream);
    if (e != hipSuccess) fprintf(stderr, "cooperative launch failed: %s (grid %d)\n", hipGetErrorString(e), grid_blocks);
}
```

```cpp
#include <hip/hip_runtime.h>
#include <hip/hip_cooperative_groups.h>
#include <cstdio>
namespace cg = cooperative_groups;

#define LAS __attribute__((address_space(3)))
typedef unsigned short bf16_t;
typedef short bf16x8 __attribute__((ext_vector_type(8)));
typedef float f32x4 __attribute__((ext_vector_type(4)));
typedef unsigned u32x4 __attribute__((ext_vector_type(4)));
typedef unsigned u32x2 __attribute__((ext_vector_type(2)));

constexpr int D = 1024, SEQ = 2048, NBATCH = 8, MP = 16384, MS = 128, MT = MP + MS;
constexpr int INW = 5632, DFF = 2816, WB = 512, NG = 32, NPC = 64, NLAYER = 2;
constexpr int NCHK = 1024;
constexpr int KS5 = 384;
constexpr float EPS = 1e-6f;

constexpr size_t O_PLC = 16908288, O_PLH = 16957440, O_PCC = 16973824, O_PSR = 17219584, O_PSI = 17252352,
                 O_SLC = 17285120, O_SLH = 18071552, O_SCC = 18333696, O_SSR = 22265856, O_SSI = 22790144;

constexpr size_t SZ34 = (size_t)MT * 1024 * 2, SZ17 = (size_t)MT * 512 * 2;
constexpr size_t OFF_WIN = 0;
constexpr size_t OFF_WGT = OFF_WIN + (size_t)5632 * 1024 * 2;
constexpr size_t OFF_WGLU = OFF_WGT + (size_t)2048 * 256 * 2;
constexpr size_t OFF_WPA = OFF_WGLU + (size_t)512 * 512 * 2;
constexpr size_t OFF_WPB = OFF_WPA + (size_t)1024 * 1024 * 2;
constexpr size_t OFF_WPC = OFF_WPB + (size_t)1024 * 512 * 2;
constexpr size_t OFF_WOUT = OFF_WPC + (size_t)1024 * 512 * 2;
constexpr size_t OFF_WF1 = OFF_WOUT + (size_t)1024 * 1024 * 2;
constexpr size_t OFF_WF2 = OFF_WF1 + (size_t)5632 * 1024 * 2;
constexpr size_t OFF_TF = OFF_WF2 + (size_t)1024 * 2816 * 2;
constexpr size_t OFF_ET = OFF_TF + (size_t)32 * 256 * KS5 * 2;
constexpr size_t OFF_TAB = OFF_ET + (size_t)(32 * 128 + 128) * 256 * 2;
constexpr int TAB_LAM = 4096 + 4096 + 65536;
constexpr size_t OFF_RSQ = OFF_TAB + (size_t)(TAB_LAM + 1024) * 4;
constexpr size_t OFF_RSQ2 = OFF_RSQ + (size_t)MT * 16 * 4;
constexpr size_t OFF_XB = OFF_RSQ2 + (size_t)MT * 16 * 4;
constexpr size_t OFF_SA = OFF_XB + SZ34;
constexpr size_t OFF_SB = OFF_SA + SZ34;
constexpr size_t OFF_SC = OFF_SB + SZ34;
constexpr size_t OFF_UCG = OFF_SC + SZ34;
constexpr size_t OFF_UCS = OFF_UCG + (size_t)32 * 1024 * KS5 * 2;
constexpr size_t OFF_SE = OFF_UCS + (size_t)128 * 512 * 2;
constexpr size_t OFF_YB = OFF_SE + SZ17;
constexpr size_t OFF_SF = OFF_YB + SZ17;
constexpr size_t SZG8 = (((size_t)MT * 3072) + 255) & ~(size_t)255;
constexpr size_t OFF_GT8 = OFF_SB;
constexpr int G8_SPLIT = 11008;
static_assert((size_t)G8_SPLIT * 3072 == SZ34 && (size_t)(MT - G8_SPLIT) * 3072 <= (size_t)32 * 1024 * KS5 * 2, "gate array placement");
constexpr size_t OFF_MRG = OFF_SC;
constexpr size_t OFF_BAR = OFF_SF + SZ17;
constexpr size_t WS_END = OFF_BAR + 16384;
static_assert((size_t)32 * 1024 * 128 * 4 <= SZ17, "ends fits");
static_assert((size_t)MT * 2816 * 2 <= 3 * SZ34, "act fits");
static_assert(WS_END <= (size_t)256 * 1024 * 1024, "workspace");

constexpr int LDS_BYTES = 128 * 1024 + 1024;

struct KArgs { const float* in[39]; float* out; unsigned char* ws; };
typedef const __attribute__((address_space(4))) KArgs* KArgsP;
__device__ __forceinline__ KArgsP kargs() { auto p = __builtin_amdgcn_kernarg_segment_ptr(); asm volatile("" : "+s"(p)); return (KArgsP)p; }

__device__ __forceinline__ unsigned cvt_pk_bf16(float lo, float hi) { unsigned r; asm volatile("v_cvt_pk_bf16_f32 %0, %1, %2" : "=v"(r) : "v"(lo), "v"(hi)); return r; }
__device__ __forceinline__ bf16_t f2bf(float f) { return (bf16_t)(cvt_pk_bf16(f, 0.f) & 0xffffu); }
__device__ __forceinline__ float bf2f(unsigned b) { return __uint_as_float(b << 16); }
__device__ __forceinline__ void store8(bf16_t* p, const float* v) { u32x4 w; w.x = cvt_pk_bf16(v[0], v[1]); w.y = cvt_pk_bf16(v[2], v[3]); w.z = cvt_pk_bf16(v[4], v[5]); w.w = cvt_pk_bf16(v[6], v[7]); *(u32x4*)p = w; }
__device__ __forceinline__ void store4(bf16_t* p, const f32x4 v) { u32x2 w; w.x = cvt_pk_bf16(v[0], v[1]); w.y = cvt_pk_bf16(v[2], v[3]); *(u32x2*)p = w; }
struct PkSt { u32x2 pk[2]; };
template <int SLOT> __device__ __forceinline__ void wstore(PkSt& ps, const int n, bf16_t* p, const f32x4 v) {
    u32x2 w; w.x = cvt_pk_bf16(v[0], v[1]); w.y = cvt_pk_bf16(v[2], v[3]);
    if (n == 0) ps.pk[SLOT] = w; else { u32x4 q; q.x = ps.pk[SLOT].x; q.y = ps.pk[SLOT].y; q.z = w.x; q.w = w.y; *(u32x4*)(p - 4) = q; }
}
__device__ __forceinline__ void unpack8(const u32x4 w, float* v) {
    v[0] = __uint_as_float(w.x << 16); v[1] = __uint_as_float(w.x & 0xffff0000u); v[2] = __uint_as_float(w.y << 16); v[3] = __uint_as_float(w.y & 0xffff0000u);
    v[4] = __uint_as_float(w.z << 16); v[5] = __uint_as_float(w.z & 0xffff0000u); v[6] = __uint_as_float(w.w << 16); v[7] = __uint_as_float(w.w & 0xffff0000u); }
__device__ __forceinline__ void load8(const bf16_t* p, float* v) { unpack8(*(const u32x4*)p, v); }
__device__ __forceinline__ size_t g8row(int row) { return (size_t)row * 3072 + (row >= G8_SPLIT ? SZ34 : (size_t)0); }
__device__ __forceinline__ float sigm(float x) { return __builtin_amdgcn_rcpf(1.0f + __expf(-x)); }
__device__ __forceinline__ float wave_sum(float v) { for (int o = 32; o >= 1; o >>= 1) v += __shfl_xor(v, o); return v; }

__device__ __forceinline__ int otid() { int t = threadIdx.x; asm volatile("" : "+v"(t)); return t; }
__device__ __forceinline__ int oblk() { int t = blockIdx.x; asm volatile("" : "+s"(t)); return t; }
constexpr int BM = 256, BK = 64, HALF = 128, HTB = HALF * BK * 2, NXCD = 8, WGM = 8;
__device__ __forceinline__ int lds_byte(int r, int c) { const int st = (r >> 4) * 2 + (c >> 5), rr = r & 15, cc = c & 31, ob = rr * 64 + cc * 2; return st * 1024 + (ob ^ (((ob >> 9) & 1) << 5)); }
__device__ __forceinline__ void stage_rc(int b, int& R, int& C) { const int st = b / 1024, sb = b % 1024, swz = sb ^ (((sb >> 9) & 1) << 5); R = (st >> 1) * 16 + swz / 64; C = (st & 1) * 32 + (swz % 64) / 2; }
__device__ __forceinline__ int perm32(int rho) { const int n = rho >> 4, i = rho & 15; return 8 * (i >> 2) + 4 * n + (i & 3); }

struct Unit { int pm, pn, g, sm, fin; const char* A; const char* B; };
struct Sched {
    int nM, nN, nGrp, G, c, bd; const char* A;     const char* B; size_t a_g, b_g, a_pm, b_pn; long L0 = 0, Lend = (1L << 40);
    __device__ __forceinline__ bool next(int i, Unit& u) const {
        const long L = L0 + (long)i * G + c; const int nwg = nM * nN; if (L >= (long)nwg * nGrp || L >= Lend) return false;
        const int g = (int)(L / nwg); int wgid = (int)(L % nwg);
        { const int q = nwg / NXCD, r = nwg % NXCD, xcd = wgid % NXCD, off = wgid / NXCD; wgid = (xcd < r ? xcd * (q + 1) : r * (q + 1) + (xcd - r) * q) + off; }
        const int nig = WGM * nN, gid = wgid / nig, fm = gid * WGM, gsz = (nM - fm) < WGM ? (nM - fm) : WGM;
        u.pm = fm + ((wgid % nig) % gsz); u.pn = (wgid % nig) / gsz; u.g = g; u.sm = 0; u.fin = 1;
        u.A = A + (size_t)g * a_g + (size_t)u.pm * a_pm + (bd ? (size_t)(u.pn >> 1) * 512 : 0); u.B = B + (size_t)g * b_g + (size_t)u.pn * b_pn; return true;
    }
};

struct SchedM3 {
    int G, c; const char* YA; const char* YB; const char* YC; const char* WPA; const char* WPB; const char* WPC;
    __device__ __forceinline__ bool next(int i, Unit& u) const {
        const int rnd = i / 3, seg = i - rnd * 3; int wgid = c + rnd * G; if (wgid >= 256) return false;
        { const int q = 256 / NXCD, xcd = wgid % NXCD, off = wgid / NXCD; wgid = xcd * q + off; }
        const int nig = WGM * 4, gid = wgid / nig, fm = gid * WGM;
        u.pm = fm + ((wgid % nig) % WGM); u.pn = (wgid % nig) / WGM; u.g = seg; u.sm = seg ? 1 : 0; u.fin = (seg == 2);
        const size_t pa = (size_t)u.pm * 256 * 2, pb = (size_t)u.pn * 256 * 2;
        if (seg == 0) { u.A = YA + pa * 1024; u.B = WPA + pb * 1024; }
        else if (seg == 1) { u.A = YB + pa * 512; u.B = WPB + pb * 512; }
        else { u.A = YC + pa * 512; u.B = WPC + pb * 512; }
        return true;
    }
};

template <class F, class SC, bool MIX>
__device__ __forceinline__ void gemm_phase_t(LAS unsigned char* lds, const int lda, const int ldb, const int nt_, const SC& S, const F& E) {
    const int tid = otid(), wid = __builtin_amdgcn_readfirstlane(tid >> 6), lane = tid & 63, wr = wid >> 2, wc = wid & 3, fr = lane & 15, fq = lane >> 4;
    unsigned voffA[2], voffB[2];
#pragma unroll
    for (int i = 0; i < 2; ++i) { int R, C; stage_rc(tid * 16 + i * 8192, R, C); const int Rb = (R & ~31) + perm32(R & 31);
        voffA[i] = (unsigned)(R * (MIX ? 512 : lda) + C) * 2u; voffB[i] = (unsigned)(Rb * (MIX ? 512 : ldb) + C) * 2u; }
    const size_t kstep = (size_t)(BK * 2);
    const size_t hA0 = (size_t)HALF * lda * 2, hB0 = (size_t)HALF * ldb * 2;
    const unsigned ldsw = (unsigned)wid * 1024u;
    const int aoff = lds_byte(wr * 64 + fr, fq * 8), boff = lds_byte(wc * 32 + fr, fq * 8);
#define PG8_SA(b, h) (((b) * 2 + (h)) * HTB)
#define PG8_SB(b, h) ((4 + (b) * 2 + (h)) * HTB)
#define PG8_STAGE(bufoff, gbase, voff, m2) do { _Pragma("unroll") for (int _i = 0; _i < 2; ++_i) \
        __builtin_amdgcn_global_load_lds((const unsigned*)((const char*)(gbase) + ((voff)[_i] + ((voff)[_i] & (m2)))), (LAS unsigned*)(lds + (bufoff) + ldsw + _i * 8192), 16, 0, 0); } while (0)
#define PG8_LDA(dst, b, h) do { _Pragma("unroll") for (int m = 0; m < 4; ++m) _Pragma("unroll") for (int k = 0; k < 2; ++k) dst[m][k] = *(const LAS bf16x8*)(lds + PG8_SA(b, h) + aoff + m * 2048 + k * 1024); } while (0)
#define PG8_LDB(dst, b, h) do { _Pragma("unroll") for (int n = 0; n < 2; ++n) _Pragma("unroll") for (int k = 0; k < 2; ++k) dst[n][k] = *(const LAS bf16x8*)(lds + PG8_SB(b, h) + boff + n * 2048 + k * 1024); } while (0)
#define PG8_MMA(ai, bj, At, Bt) do { __builtin_amdgcn_s_setprio(1); _Pragma("unroll") for (int m = 0; m < 4; ++m) _Pragma("unroll") for (int n = 0; n < 2; ++n) _Pragma("unroll") for (int k = 0; k < 2; ++k) \
        acc[ai][bj][m][n] = __builtin_amdgcn_mfma_f32_16x16x32_bf16(Bt[n][k], At[m][k], acc[ai][bj][m][n], 0, 0, 0); __builtin_amdgcn_s_setprio(0); } while (0)
#define PG8_WAIT_V(n) asm volatile("s_waitcnt vmcnt(" #n ")" ::: "memory")
#define PG8_WAIT_L(n) asm volatile("s_waitcnt lgkmcnt(" #n ")" ::: "memory")
#define PG8_BAR __builtin_amdgcn_s_barrier()
#define PG8_SCHED __builtin_amdgcn_sched_barrier(0)
    Unit cur, nxt; int ui = 0;
    if (!S.next(0, cur)) return;
    f32x4 acc[2][2][4][2];
    if constexpr (F::ACC_INIT) E.init(acc, cur.pm, cur.pn, wr, wc, fr, fq); else {
#pragma unroll
    for (int a = 0; a < 2; ++a)
#pragma unroll
        for (int b = 0; b < 2; ++b)
#pragma unroll
            for (int m = 0; m < 4; ++m)
#pragma unroll
                for (int n = 0; n < 2; ++n) acc[a][b][m][n] = (f32x4){0.f, 0.f, 0.f, 0.f};
    }
    bf16x8 At[4][2], B0[2][2], B1[2][2];
    const char* cA = cur.A; const char* cB = cur.B;
    unsigned cm = (MIX && !cur.sm) ? ~1023u : 0u; size_t hA = MIX ? (cur.sm ? (size_t)131072 : (size_t)262144) : hA0, hB = MIX ? hA : hB0; int nt = MIX ? (cur.sm ? 8 : 16) : nt_;
    PG8_STAGE(PG8_SB(0, 0), cB, voffB, cm); PG8_STAGE(PG8_SA(0, 0), cA, voffA, cm); PG8_STAGE(PG8_SB(0, 1), cB + hB, voffB, cm); PG8_STAGE(PG8_SA(0, 1), cA + hA, voffA, cm);
    if (wr == 1) PG8_BAR;
    PG8_WAIT_V(4); PG8_BAR;
    PG8_STAGE(PG8_SB(1, 0), cB + kstep, voffB, cm); PG8_STAGE(PG8_SA(1, 0), cA + kstep, voffA, cm); PG8_STAGE(PG8_SB(1, 1), cB + hB + kstep, voffB, cm);
    PG8_WAIT_V(6); PG8_BAR;
    for (;;) {
        const bool has_next = S.next(ui + 1, nxt);
        const char* nA = has_next ? nxt.A : cA; const char* nB = has_next ? nxt.B : cB;
        const unsigned nm = (MIX && has_next) ? (nxt.sm ? 0u : ~1023u) : cm;
        const size_t nhA = (MIX && has_next) ? (nxt.sm ? (size_t)131072 : (size_t)262144) : hA, nhB = MIX ? nhA : hB;
#pragma unroll 1
        for (int t = 0; t < nt; t += 2) {
            const bool last = (t == nt - 2);
            const char* a1 = cA + (size_t)(t + 1) * kstep;
            const char* a2 = last ? nA : cA + (size_t)(t + 2) * kstep; const char* b2 = last ? nB : cB + (size_t)(t + 2) * kstep;
            const char* a3 = a2 + kstep; const char* b3 = b2 + kstep;
            const unsigned m2 = (MIX && last) ? nm : cm; const size_t h2A = (MIX && last) ? nhA : hA, h2B = (MIX && last) ? nhB : hB;
            PG8_LDB(B0, 0, 0); PG8_SCHED; PG8_LDA(At, 0, 0); PG8_STAGE(PG8_SA(1, 1), a1 + hA, voffA, cm);
            PG8_WAIT_L(8); PG8_BAR; PG8_WAIT_L(0); PG8_MMA(0, 0, At, B0); PG8_BAR; PG8_SCHED;
            PG8_LDB(B1, 0, 1); PG8_STAGE(PG8_SB(0, 0), b2, voffB, m2);
            PG8_BAR; PG8_WAIT_L(0); PG8_MMA(0, 1, At, B1); PG8_BAR;
            PG8_LDA(At, 0, 1); PG8_STAGE(PG8_SA(0, 0), a2, voffA, m2);
            PG8_BAR; PG8_WAIT_L(0); PG8_MMA(1, 0, At, B0); PG8_BAR; PG8_SCHED;
            PG8_STAGE(PG8_SB(0, 1), b2 + h2B, voffB, m2);
            PG8_WAIT_V(6); PG8_BAR; PG8_MMA(1, 1, At, B1); PG8_BAR;
            PG8_LDB(B0, 1, 0); PG8_SCHED; PG8_LDA(At, 1, 0); PG8_STAGE(PG8_SA(0, 1), a2 + h2A, voffA, m2);
            PG8_WAIT_L(8); PG8_BAR; PG8_WAIT_L(0); PG8_MMA(0, 0, At, B0); PG8_BAR; PG8_SCHED;
            PG8_LDB(B1, 1, 1); PG8_STAGE(PG8_SB(1, 0), b3, voffB, m2);
            PG8_BAR; PG8_WAIT_L(0); PG8_MMA(0, 1, At, B1); PG8_BAR;
            PG8_LDA(At, 1, 1); PG8_STAGE(PG8_SA(1, 0), a3, voffA, m2);
            PG8_BAR; PG8_WAIT_L(0); PG8_MMA(1, 0, At, B0); PG8_BAR; PG8_SCHED;
            PG8_STAGE(PG8_SB(1, 1), b3 + h2B, voffB, m2);
            PG8_WAIT_V(6); PG8_BAR; PG8_MMA(1, 1, At, B1); PG8_BAR;
        }
        {
            int row0 = cur.pm * BM + wr * 64 + fr; asm volatile("" : "+v"(row0));
            const typename F::UCtx uc = E.unit_ctx(cur.pn, wc, fq, cur.g);
            typename F::Pre pre = E.row_pre(row0, fq, cur.pn, wc, cur.g);
#pragma unroll
            for (int rg = 0; rg < 8; ++rg) { const int ai = rg >> 2, m = rg & 3;
                int row = cur.pm * BM + ai * HALF + wr * 64 + m * 16 + fr;
                asm volatile("" : "+v"(row));
                typename F::Pre pre_n = pre;
                if (rg < 7) { int rown = cur.pm * BM + ((rg + 1) >> 2) * HALF + wr * 64 + ((rg + 1) & 3) * 16 + fr; asm volatile("" : "+v"(rown)); pre_n = E.row_pre(rown, fq, cur.pn, wc, cur.g); }
                asm volatile("" ::: "memory");
                typename F::State st; E.row_begin(st, pre); PkSt ps;
#pragma unroll
                for (int n = 0; n < 2; ++n) { E.op(st, ps, uc, row, cur.pn, cur.g, wc * 32 + 8 * fq + 4 * n, n, acc[ai][0][m][n], acc[ai][1][m][n]); }
                E.row_end(st, row, cur.pn, wc);
                pre = pre_n;
            }
        }
        if (!has_next) break;
        if constexpr (F::ACC_INIT) E.init(acc, nxt.pm, nxt.pn, wr, wc, fr, fq); else if (!MIX || cur.fin) {
#pragma unroll
        for (int a = 0; a < 2; ++a)
#pragma unroll
            for (int b = 0; b < 2; ++b)
#pragma unroll
                for (int m = 0; m < 4; ++m)
#pragma unroll
                    for (int n = 0; n < 2; ++n) acc[a][b][m][n] = (f32x4){0.f, 0.f, 0.f, 0.f};
        }
        cur = nxt; cA = nA; cB = nB; ++ui;
        if (MIX) { cm = nm; hA = nhA; hB = nhB; nt = cur.sm ? 8 : 16; }
    }
    PG8_WAIT_V(0);
    if (wr == 0) PG8_BAR;
    PG8_BAR;
#undef PG8_SA
#undef PG8_SB
#undef PG8_STAGE
#undef PG8_LDA
#undef PG8_LDB
#undef PG8_MMA
#undef PG8_WAIT_V
#undef PG8_WAIT_L
#undef PG8_BAR
#undef PG8_SCHED
}

template <class F>
__device__ __forceinline__ void gemm_phase(LAS unsigned char* lds, const int lda, const int ldb, const int nt, const Sched& S, const F& E) { gemm_phase_t<F, Sched, false>(lds, lda, ldb, nt, S, E); }

template <class F>
__device__ __forceinline__ void thin_gemm(LAS unsigned char* lds, const bf16_t* A, const int lda, const bf16_t* Bt, const int ldb, const int K, const int nN, const int bd, const F& E, const int bi, const int nb) {
    const int tid = otid(), wid = tid >> 6, lane = tid & 63, fr = lane & 15, fq = lane >> 4;
    LAS f32x4* red = (LAS f32x4*)lds;
    const int nitems = 8 * nN * 4, kw = K >> 3;
    if (bi >= 0) for (int item = bi; item < nitems; item += nb) {
        const int rg = item & 7, wc = (item >> 3) & 3, pn = item >> 5;
        const bf16_t* ap = A + (size_t)(MP + 16 * rg + fr) * lda + (bd ? (pn >> 1) * 256 : 0) + wid * kw + 8 * fq;
        const bf16_t* bp[4];
#pragma unroll
        for (int n = 0; n < 4; ++n) bp[n] = Bt + (size_t)(256 * pn + 128 * (n >> 1) + 32 * wc + 8 * (fr >> 2) + 4 * (n & 1) + (fr & 3)) * ldb + wid * kw + 8 * fq;
        f32x4 acc[4];
#pragma unroll
        for (int n = 0; n < 4; ++n) acc[n] = (f32x4){0.f, 0.f, 0.f, 0.f};
        for (int kb = 0; kb < kw; kb += 128) {
            bf16x8 av[4], bv[4][4];
#pragma unroll
            for (int i = 0; i < 4; ++i) if (kb + 32 * i < kw) { av[i] = *(const bf16x8*)(ap + kb + 32 * i);
#pragma unroll
                for (int n = 0; n < 4; ++n) bv[i][n] = *(const bf16x8*)(bp[n] + kb + 32 * i); }
#pragma unroll
            for (int i = 0; i < 4; ++i) if (kb + 32 * i < kw) {
#pragma unroll
                for (int n = 0; n < 4; ++n) acc[n] = __builtin_amdgcn_mfma_f32_16x16x32_bf16(bv[i][n], av[i], acc[n], 0, 0, 0); }
        }
#pragma unroll
        for (int n = 0; n < 4; ++n) red[(wid * 4 + n) * 64 + lane] = acc[n];
        __syncthreads();
        if (wid == 0) {
            f32x4 sv[4];
#pragma unroll
            for (int n = 0; n < 4; ++n) { f32x4 s = red[n * 64 + lane];
#pragma unroll
                for (int w = 1; w < 8; ++w) s += red[(w * 4 + n) * 64 + lane];
                sv[n] = s; }
            const int row = MP + 16 * rg + fr; typename F::State st; E.row_begin(st, E.row_pre(row, fq, pn, wc, 0));
            const typename F::UCtx uc = E.unit_ctx(pn, wc, fq, 0);
            PkSt ps;
#pragma unroll
            for (int n = 0; n < 2; ++n) E.op(st, ps, uc, row, pn, 0, wc * 32 + 8 * fq + 4 * n, n, sv[n], sv[2 + n]);
            E.row_end(st, row, pn, wc);
        }
        __syncthreads();
    }
}

__device__ __forceinline__ void thin_merge(LAS unsigned char* lds, const bf16_t* YA, const bf16_t* YB, const bf16_t* YC, const bf16_t* WPA, const bf16_t* WPB, const bf16_t* WPC,
                                           const unsigned char* g8, bf16_t* mrg, const int bi, const int nb) {
    const int tid = otid(), wid = tid >> 6, lane = tid & 63, fr = lane & 15, fq = lane >> 4;
    LAS f32x4* red = (LAS f32x4*)lds;
    for (int item = bi; item < 8 * 4 * 4; item += nb) {
        const int rg = item & 7, wc = (item >> 3) & 3, pn = item >> 5, row = MP + 16 * rg + fr;
        int brow[4];
#pragma unroll
        for (int n = 0; n < 4; ++n) brow[n] = 256 * pn + 128 * (n >> 1) + 32 * wc + 8 * (fr >> 2) + 4 * (n & 1) + (fr & 3);
        f32x4 tot[4];
#pragma unroll
        for (int n = 0; n < 4; ++n) tot[n] = (f32x4){0.f, 0.f, 0.f, 0.f};
#pragma unroll
        for (int seg = 0; seg < 3; ++seg) {
            const bf16_t* A = seg == 0 ? YA : (seg == 1 ? YB : YC); const bf16_t* B = seg == 0 ? WPA : (seg == 1 ? WPB : WPC);
            const int K = seg == 0 ? 1024 : 512, kw = K >> 3, nst = kw >> 5;
            bf16x8 av[4], bv[4][4]; unsigned gw[4];
#pragma unroll
            for (int i = 0; i < 4; ++i) if (i < nst) { av[i] = *(const bf16x8*)(A + (size_t)row * K + wid * kw + 32 * i + 8 * fq);
#pragma unroll
                for (int n = 0; n < 4; ++n) bv[i][n] = *(const bf16x8*)(B + (size_t)brow[n] * K + wid * kw + 32 * i + 8 * fq); }
#pragma unroll
            for (int n = 0; n < 4; ++n) gw[n] = *(const unsigned*)(g8 + g8row(row) + seg * 1024 + 256 * pn + 128 * (n >> 1) + 32 * wc + 8 * fq + 4 * (n & 1));
            f32x4 acc[4];
#pragma unroll
            for (int n = 0; n < 4; ++n) acc[n] = (f32x4){0.f, 0.f, 0.f, 0.f};
#pragma unroll
            for (int i = 0; i < 4; ++i) if (i < nst) {
#pragma unroll
                for (int n = 0; n < 4; ++n) acc[n] = __builtin_amdgcn_mfma_f32_16x16x32_bf16(bv[i][n], av[i], acc[n], 0, 0, 0); }
#pragma unroll
            for (int n = 0; n < 4; ++n) tot[n] += acc[n] * ((f32x4){(float)(gw[n] & 255u), (float)((gw[n] >> 8) & 255u), (float)((gw[n] >> 16) & 255u), (float)(gw[n] >> 24)} * (1.0f / 255.0f));
        }
#pragma unroll
        for (int n = 0; n < 4; ++n) red[(wid * 4 + n) * 64 + lane] = tot[n];
        __syncthreads();
        if (wid == 0) {
#pragma unroll
            for (int n = 0; n < 4; ++n) { f32x4 sv = red[n * 64 + lane];
#pragma unroll
                for (int w = 1; w < 8; ++w) sv += red[(w * 4 + n) * 64 + lane];
                store4(mrg + (size_t)row * 1024 + 256 * pn + 128 * (n >> 1) + 32 * wc + 8 * fq + 4 * (n & 1), sv); }
        }
        __syncthreads();
    }
}

__device__ __forceinline__ f32x4 load4(const bf16_t* p) { const u32x2 w = *(const u32x2*)p; return (f32x4){__uint_as_float(w.x << 16), __uint_as_float(w.x & 0xffff0000u), __uint_as_float(w.y << 16), __uint_as_float(w.y & 0xffff0000u)}; }
__device__ __forceinline__ f32x4 sigm4(const f32x4 x) { return (f32x4){sigm(x[0]), sigm(x[1]), sigm(x[2]), sigm(x[3])}; }
__device__ __forceinline__ float row_rs4(const float* rsq, int row, int fq) {
    const f32x4 a = *(const f32x4*)(rsq + (size_t)row * 16 + fq * 4); float s = (a[0] + a[1]) + (a[2] + a[3]);
    s += __shfl_xor(s, 16); s += __shfl_xor(s, 32); return rsqrtf(s * (1.0f / 1024.0f) + EPS);
}
__device__ __forceinline__ float sum_fq4(float s) {
    { auto r = __builtin_amdgcn_permlane16_swap(__float_as_uint(s), __float_as_uint(s), false, false); s = __uint_as_float(r[0]) + __uint_as_float(r[1]); }
    { auto r = __builtin_amdgcn_permlane32_swap(__float_as_uint(s), __float_as_uint(s), false, false); s = __uint_as_float(r[0]) + __uint_as_float(r[1]); }
    return s;
}
__device__ __forceinline__ float rs_from4(const f32x4 a) { const float s = sum_fq4((a[0] + a[1]) + (a[2] + a[3])); return rsqrtf(s * (1.0f / 1024.0f) + EPS); }
__device__ __forceinline__ float row_rs(const float* rsq, int row) {
    const f32x4* p = (const f32x4*)(rsq + (size_t)row * 16); const f32x4 a = p[0], b = p[1], c = p[2], d = p[3];
    const float s = ((a[0] + a[1]) + (a[2] + a[3])) + ((b[0] + b[1]) + (b[2] + b[3])) + ((c[0] + c[1]) + (c[2] + c[3])) + ((d[0] + d[1]) + (d[2] + d[3]));
    return rsqrtf(s * (1.0f / 1024.0f) + EPS);
}
struct StNone { };
struct StF { float x; };
struct F1 {
    typedef StF State;
    static constexpr bool ACC_INIT = false;
    typedef StNone UCtx;
    __device__ __forceinline__ UCtx unit_ctx(int, int, int, int) const { return UCtx(); }
    const float* rsq; bf16_t* ua; bf16_t* glu; bf16_t* ucg; bf16_t* ucs;
    typedef f32x4 Pre;
    __device__ __forceinline__ Pre row_pre(int row, int fq, int, int, int) const { return *(const f32x4*)(rsq + (size_t)row * 16 + fq * 4); }
    __device__ __forceinline__ void row_begin(State& st, const Pre& p) const { st.x = rs_from4(p); }
    __device__ __forceinline__ void row_end(State&, int, int, int) const {}
    __device__ __forceinline__ void op(State& st, PkSt& ps, const UCtx& uc, int row, int pn, int, int lc, const int n, f32x4& a, f32x4& b) const {
        if (row >= MT) return;
        const f32x4 va = a * st.x, vb = b * st.x;
        if (pn < 4) { bf16_t* p = ua + (size_t)row * 1024 + pn * 256 + lc; wstore<0>(ps, n, p, va); wstore<1>(ps, n, p + 128, vb); }
        else if (pn < 8) wstore<0>(ps, n, glu + (size_t)row * 512 + (pn - 4) * 128 + lc, va * sigm4(vb));
        else {
#pragma unroll
            for (int h = 0; h < 2; ++h) { const int cc = (pn - 8) * 256 + lc + 128 * h; bf16_t* dst;
                if (row < MP) dst = ucg + ((size_t)(cc >> 4) * NCHK + (row >> 4)) * KS5 + (row & 15) * 16 + (cc & 15);
                else dst = ucs + (size_t)(row - MP) * 512 + cc;
                if (h) wstore<1>(ps, n, dst, vb); else wstore<0>(ps, n, dst, va); }
        }
    }
};
struct StU4 { u32x4 v; };
struct F2 {
    typedef StU4 State; typedef StU4 Pre;
    static constexpr bool ACC_INIT = false;
    struct UCtx { f32x4 brg[2], big[2], lm[2]; };
    __device__ __forceinline__ UCtx unit_ctx(int pn, int wc, int fq, int) const { UCtx u; const int ch = pn * 128 + wc * 32 + 8 * fq;
#pragma unroll
        for (int n = 0; n < 2; ++n) { u.brg[n] = *(const f32x4*)(b_rg + ch + 4 * n); u.big[n] = *(const f32x4*)(b_ig + ch + 4 * n); u.lm[n] = *(const f32x4*)(lam + ch + 4 * n); }
        return u; }
    const bf16_t* ca; const float* b_rg; const float* b_ig; const float* lam; const float* h0; bf16_t* la; bf16_t* bx; float* out_h;
    __device__ __forceinline__ Pre row_pre(int row, int fq, int pn, int wc, int) const { Pre p; p.v = *(const u32x4*)(ca + (size_t)row * 1024 + pn * 128 + wc * 32 + 8 * fq); return p; }
    __device__ __forceinline__ void row_begin(State& st, const Pre& p) const { st = p; }
    __device__ __forceinline__ void row_end(State&, int, int, int) const {}
    __device__ __forceinline__ void op(State& st, PkSt& ps, const UCtx& uc, int row, int pn, int, int lc, const int n, f32x4& a, f32x4& b) const {
        const int ch0 = pn * 128 + lc; const unsigned w0 = n ? st.v.z : st.v.x, w1 = n ? st.v.w : st.v.y;
        const f32x4 c4 = (f32x4){__uint_as_float(w0 << 16), __uint_as_float(w0 & 0xffff0000u), __uint_as_float(w1 << 16), __uint_as_float(w1 & 0xffff0000u)};
        const f32x4 r = sigm4(a + uc.brg[n]), ig = sigm4(b + uc.big[n]), l_a = r * uc.lm[n];
        f32x4 bxv;
#pragma unroll
        for (int j = 0; j < 4; ++j) bxv[j] = __builtin_amdgcn_sqrtf(fmaxf(1.0f - __expf(2.0f * l_a[j]), 0.f)) * ig[j] * c4[j];
        if (row < MP) { wstore<0>(ps, n, la + (size_t)row * 1024 + ch0, l_a); wstore<1>(ps, n, bx + (size_t)row * 1024 + ch0, bxv); }
        else { const size_t o = (size_t)(row - MP) * 1024 + ch0; const f32x4 hp = *(const f32x4*)(h0 + o); f32x4 h;
#pragma unroll
            for (int j = 0; j < 4; ++j) h[j] = __expf(l_a[j]) * hp[j] + bxv[j];
            *(f32x4*)(out_h + o) = h; wstore<0>(ps, n, la + (size_t)row * 1024 + ch0, h); }
    }
};
struct FEnd {
    typedef StNone State;
    static constexpr bool ACC_INIT = false;
    typedef StNone UCtx;
    __device__ __forceinline__ UCtx unit_ctx(int, int, int, int) const { return UCtx(); }
    float* ends;
    typedef StNone Pre;
    __device__ __forceinline__ Pre row_pre(int, int, int, int, int) const { return Pre(); }
    __device__ __forceinline__ void row_begin(State&, const Pre&) const {}
    __device__ __forceinline__ void row_end(State&, int, int, int) const {}
    __device__ __forceinline__ void op(State&, PkSt& ps, const UCtx& uc, int row, int, int g, int lc, const int n, f32x4& a, f32x4&) const { *(f32x4*)(ends + ((size_t)g * NCHK + row) * 128 + lc) = a; }
};
__device__ __forceinline__ float gelu_tanh(float x) { const float u = 0.7978845608028654f * (x + 0.044715f * x * x * x); return x * sigm(2.0f * u); }
struct StU8 { u32x2 v[4]; };
struct FS5 {
    typedef StU8 State; typedef StU8 Pre;
    static constexpr bool ACC_INIT = false;
    struct UCtx { f32x4 d[2]; };
    __device__ __forceinline__ UCtx unit_ctx(int, int, int fq, int g) const { UCtx u; u.d[0] = *(const f32x4*)(dsk + g * 16 + ((8 * fq) & 15)); u.d[1] = *(const f32x4*)(dsk + g * 16 + ((8 * fq + 4) & 15)); return u; }
    const bf16_t* ucg; const float* dsk; bf16_t* yc0;
    __device__ __forceinline__ Pre row_pre(int row, int fq, int, int wc, int g) const { Pre p; const bf16_t* base = ucg + ((size_t)g * NCHK + row) * KS5 + wc * 32 + 8 * fq;
#pragma unroll
        for (int h = 0; h < 2; ++h) { const u32x4 q = *(const u32x4*)(base + 128 * h); p.v[h] = (u32x2){q.x, q.y}; p.v[2 + h] = (u32x2){q.z, q.w}; }
        return p; }
    __device__ __forceinline__ void row_begin(State& st, const Pre& p) const { st = p; }
    __device__ __forceinline__ void row_end(State&, int, int, int) const {}
    __device__ __forceinline__ void op(State& st, PkSt& ps, const UCtx& uc, int row, int, int g, int lc, const int n, f32x4& a, f32x4& b) const {
#pragma unroll
        for (int h = 0; h < 2; ++h) { const int col = lc + 128 * h, i = col >> 4, c0 = col & 15; const u32x2 w = st.v[n * 2 + h];
            const f32x4 u4 = (f32x4){__uint_as_float(w.x << 16), __uint_as_float(w.x & 0xffff0000u), __uint_as_float(w.y << 16), __uint_as_float(w.y & 0xffff0000u)};
            const f32x4 y = (h ? b : a) + uc.d[n] * u4;
            const f32x4 gy = (f32x4){gelu_tanh(y[0]), gelu_tanh(y[1]), gelu_tanh(y[2]), gelu_tanh(y[3])}; bf16_t* dp = yc0 + (size_t)(row * 16 + i) * 512 + g * 16 + c0;
            if (h) wstore<1>(ps, n, dp, gy); else wstore<0>(ps, n, dp, gy); }
    }
};
struct F4 {
    typedef StU8 State; typedef StU8 Pre;
    static constexpr bool ACC_INIT = false;
    struct UCtx { f32x4 b[2][2]; };
    __device__ __forceinline__ UCtx unit_ctx(int pn, int wc, int fq, int) const { UCtx u; const float* p = bg + pn * 256 + wc * 32 + 8 * fq;
#pragma unroll
        for (int n = 0; n < 2; ++n)
#pragma unroll
            for (int h = 0; h < 2; ++h) u.b[n][h] = *(const f32x4*)(p + 128 * h + 4 * n);
        return u; }
    const bf16_t* yc0; const float* bg; bf16_t* yc;
    __device__ __forceinline__ Pre row_pre(int row, int fq, int pn, int wc, int) const { Pre p; const bf16_t* base = yc0 + (size_t)row * 512 + pn * 256 + wc * 32 + 8 * fq;
#pragma unroll
        for (int h = 0; h < 2; ++h) { const u32x4 q = *(const u32x4*)(base + 128 * h); p.v[h] = (u32x2){q.x, q.y}; p.v[2 + h] = (u32x2){q.z, q.w}; }
        return p; }
    __device__ __forceinline__ void row_begin(State& st, const Pre& p) const { st = p; }
    __device__ __forceinline__ void row_end(State&, int, int, int) const {}
    __device__ __forceinline__ void op(State& st, PkSt& ps, const UCtx& uc, int row, int pn, int, int lc, const int n, f32x4& a, f32x4& b) const {
#pragma unroll
        for (int h = 0; h < 2; ++h) { const int col = pn * 256 + lc + 128 * h; const u32x2 w = st.v[n * 2 + h];
            const f32x4 y4 = (f32x4){__uint_as_float(w.x << 16), __uint_as_float(w.x & 0xffff0000u), __uint_as_float(w.y << 16), __uint_as_float(w.y & 0xffff0000u)};
            const f32x4 yo = y4 * sigm4((h ? b : a) + uc.b[n][h]); if (h) wstore<1>(ps, n, yc + (size_t)row * 512 + col, yo); else wstore<0>(ps, n, yc + (size_t)row * 512 + col, yo); }
    }
};
struct FG8 {
    typedef StF State;
    static constexpr bool ACC_INIT = false;
    struct UCtx { f32x4 b[2][2]; };
    __device__ __forceinline__ UCtx unit_ctx(int pn, int wc, int fq, int) const { UCtx u; const float* p = bgate + pn * 256 + wc * 32 + 8 * fq;
#pragma unroll
        for (int n = 0; n < 2; ++n)
#pragma unroll
            for (int h = 0; h < 2; ++h) u.b[n][h] = *(const f32x4*)(p + 128 * h + 4 * n);
        return u; }
    const float* rsq; const float* bgate; unsigned char* g8;
    typedef f32x4 Pre;
    __device__ __forceinline__ Pre row_pre(int row, int fq, int, int, int) const { return *(const f32x4*)(rsq + (size_t)row * 16 + fq * 4); }
    __device__ __forceinline__ void row_begin(State& st, const Pre& p) const { st.x = rs_from4(p); }
    __device__ __forceinline__ void row_end(State&, int, int, int) const {}
    __device__ __forceinline__ void op(State& st, PkSt& ps, const UCtx& uc, int row, int pn, int, int lc, const int n, f32x4& a, f32x4& b) const {
#pragma unroll
        for (int h = 0; h < 2; ++h) { const int col = pn * 256 + lc + 128 * h; f32x4 g = sigm4((h ? b : a) * st.x + uc.b[(lc >> 2) & 1][h]) * 255.0f + 0.5f; g = __builtin_elementwise_max(g, (f32x4){1.f, 1.f, 1.f, 1.f});
            const unsigned gw = (unsigned)g[0] | ((unsigned)g[1] << 8) | ((unsigned)g[2] << 16) | ((unsigned)g[3] << 24);
            if (n == 0) ps.pk[h].x = gw; else *(u32x2*)(g8 + g8row(row) + col - 4) = (u32x2){ps.pk[h].x, gw}; }
    }
};
struct StG { unsigned w[8]; };
struct FMS {
    typedef StG State; typedef StG Pre;
    static constexpr bool ACC_INIT = false;
    typedef StNone UCtx;
    __device__ __forceinline__ UCtx unit_ctx(int, int, int, int) const { return UCtx(); }
    const unsigned char* g8; bf16_t* mrg;
    __device__ __forceinline__ Pre row_pre(int row, int fq, int pn, int wc, int seg) const { Pre p; const unsigned char* base = g8 + g8row(row) + seg * 1024 + pn * 256 + wc * 32 + 8 * fq;
#pragma unroll
        for (int h = 0; h < 2; ++h) { const u32x2 gnum = *(const u32x2*)(base + 128 * h); u32x2 gden = (u32x2){0x01010101u, 0x01010101u}; if (seg < 2) gden = *(const u32x2*)(base + 1024 + 128 * h);
            p.w[(0 * 2 + h) * 2] = gnum.x; p.w[(1 * 2 + h) * 2] = gnum.y; p.w[(0 * 2 + h) * 2 + 1] = gden.x; p.w[(1 * 2 + h) * 2 + 1] = gden.y; }
        return p; }
    __device__ __forceinline__ void row_begin(State& st, const Pre& p) const { st = p; }
    __device__ __forceinline__ void row_end(State&, int, int, int) const {}
    __device__ __forceinline__ void op(State& st, PkSt& ps, const UCtx& uc, int row, int pn, int seg, int lc, const int n, f32x4& a, f32x4& b) const {
#pragma unroll
        for (int h = 0; h < 2; ++h) { const unsigned gn = st.w[(n * 2 + h) * 2], gd = st.w[(n * 2 + h) * 2 + 1]; f32x4& v = h ? b : a;
            const f32x4 num = (f32x4){(float)(gn & 255u), (float)((gn >> 8) & 255u), (float)((gn >> 16) & 255u), (float)(gn >> 24)};
            if (seg < 2) { const f32x4 den = (f32x4){(float)(gd & 255u), (float)((gd >> 8) & 255u), (float)((gd >> 16) & 255u), (float)(gd >> 24)};
                v = v * num * (f32x4){__builtin_amdgcn_rcpf(den[0]), __builtin_amdgcn_rcpf(den[1]), __builtin_amdgcn_rcpf(den[2]), __builtin_amdgcn_rcpf(den[3])}; }
            else { const f32x4 mo = v * num * (1.0f / 255.0f); bf16_t* dp = mrg + (size_t)row * 1024 + pn * 256 + lc + 128 * h; if (h) wstore<1>(ps, n, dp, mo); else wstore<0>(ps, n, dp, mo); } }
    }
};
template <bool RES> struct F6T {
    typedef StF State;
    static constexpr bool ACC_INIT = !RES;
    typedef StNone UCtx;
    __device__ __forceinline__ UCtx unit_ctx(int, int, int, int) const { return UCtx(); }
    const float* xs_p; const float* xs_s; float* xd; bf16_t* xb; float* rsq;
    typedef StNone Pre;
    __device__ __forceinline__ Pre row_pre(int, int, int, int, int) const { return Pre(); }
    __device__ __forceinline__ void row_begin(State& st, const Pre&) const { st.x = 0.f; }
    __device__ __forceinline__ void row_end(State& st, int row, int pn, int wc) const {
        const float ss = sum_fq4(st.x);
        if ((__lane_id()) < 16) rsq[(size_t)row * 16 + pn * 4 + wc] = ss; }
    __device__ __forceinline__ void init(f32x4 (&acc)[2][2][4][2], int pm, int pn, int wr, int wc, int fr, int fq) const {
#pragma unroll
        for (int ai = 0; ai < 2; ++ai)
#pragma unroll
            for (int m = 0; m < 4; ++m) { const int row = pm * BM + ai * HALF + wr * 64 + m * 16 + fr;
                const float* src = ((row < MP) ? xs_p + (size_t)row * 1024 : xs_s + (size_t)(row - MP) * 1024) + pn * 256 + wc * 32 + 8 * fq;
#pragma unroll
                for (int bj = 0; bj < 2; ++bj)
#pragma unroll
                    for (int n = 0; n < 2; ++n) acc[ai][bj][m][n] = *(const f32x4*)(src + 128 * bj + 4 * n); }
    }
    __device__ __forceinline__ void op(State& st, PkSt& ps, const UCtx& uc, int row, int pn, int, int lc, const int n, f32x4& a, f32x4& b) const {
        const float* src = (row < MP) ? xs_p + (size_t)row * 1024 : xs_s + (size_t)(row - MP) * 1024;
#pragma unroll
        for (int h = 0; h < 2; ++h) { const int col = pn * 256 + lc + 128 * h; f32x4 v = (h ? b : a); if (RES) v += *(const f32x4*)(src + col);
            st.x += (v[0] * v[0] + v[1] * v[1]) + (v[2] * v[2] + v[3] * v[3]);
            *(f32x4*)(xd + (size_t)row * 1024 + col) = v; if (h) wstore<1>(ps, n, xb + (size_t)row * 1024 + col, v); else wstore<0>(ps, n, xb + (size_t)row * 1024 + col, v); }
    }
};
struct F7 {
    typedef StF State;
    static constexpr bool ACC_INIT = false;
    typedef StNone UCtx;
    __device__ __forceinline__ UCtx unit_ctx(int, int, int, int) const { return UCtx(); }
    const float* rsq; bf16_t* act;
    typedef f32x4 Pre;
    __device__ __forceinline__ Pre row_pre(int row, int fq, int, int, int) const { return *(const f32x4*)(rsq + (size_t)row * 16 + fq * 4); }
    __device__ __forceinline__ void row_begin(State& st, const Pre& p) const { st.x = rs_from4(p); }
    __device__ __forceinline__ void row_end(State&, int, int, int) const {}
    __device__ __forceinline__ void op(State& st, PkSt& ps, const UCtx& uc, int row, int pn, int, int lc, const int n, f32x4& a, f32x4& b) const {
        if (row >= MT) return;
        const f32x4 gte = a * st.x, up = b * st.x; wstore<0>(ps, n, act + (size_t)row * DFF + pn * 128 + lc, gte * sigm4(gte) * up);
    }
};

template <int MODE> __device__ __forceinline__ int srccol(int n) {
    if (MODE == 1) { if (n >= 1024 && n < 2048) { const int q = (n - 1024) >> 8, r = (n - 1024) & 255; return r < 128 ? 1024 + 128 * q + r : 1536 + 128 * q + (r - 128); } return n; }
    if (MODE == 2) { const int t = n >> 8, r = n & 255; return r < 128 ? 128 * t + r : DFF + 128 * t + (r - 128); }
    return n;
}
template <int MODE>
__device__ __forceinline__ int conv_T(LAS float* tile, const float* src, int ldsrc, const float* scale, bf16_t* dst, int ldd, int N, int K, int nb, int bi, int base) {
    const int tid = otid(), ntn = N >> 8, ntiles = ntn * (K >> 6);
    int t = bi - (base % nb); if (t < 0) t += nb;
    const int q = tid & 63, kr = tid >> 6; f32x4 v[8]; float sc8[8];
#define CT_LOAD(tt) do { const int n0_ = ((tt) % ntn) << 8, k0_ = ((tt) / ntn) << 6, sc_ = srccol<MODE>(n0_ + 4 * q); \
        _Pragma("unroll") for (int i = 0; i < 8; ++i) { v[i] = *(const f32x4*)(src + (size_t)(k0_ + i * 8 + kr) * ldsrc + sc_); sc8[i] = scale ? scale[k0_ + i * 8 + kr] : 1.0f; } } while (0)
    if (t < ntiles) CT_LOAD(t);
    for (; t < ntiles; t += nb) {
        const int n0 = (t % ntn) << 8, k0 = (t / ntn) << 6;
#pragma unroll
        for (int i = 0; i < 8; ++i) *(LAS f32x4*)(tile + (i * 8 + kr) * 260 + 4 * q) = v[i] * sc8[i];
        __syncthreads();
        if (t + nb < ntiles) CT_LOAD(t + nb);
        { const int n = tid >> 1, kh = tid & 1;
#pragma unroll
          for (int j4 = 0; j4 < 4; ++j4) { float w[8];
#pragma unroll
              for (int j = 0; j < 8; ++j) w[j] = tile[(kh * 32 + j4 * 8 + j) * 260 + n];
              store8(dst + (size_t)(n0 + n) * ldd + k0 + kh * 32 + j4 * 8, w); } }
        __syncthreads();
    }
#undef CT_LOAD
    return base + ntiles;
}

__device__ __forceinline__ void s5_build(KArgsP a, int l, int g, LAS unsigned char* lds, const int part, const int nparts) {
    const int tid = otid();
    LAS float* apr = (LAS float*)lds; LAS float* api = apr + 17 * 64; LAS float* bbr = api + 17 * 64; LAS float* bbi = bbr + 1024;
    LAS float* ccr = bbi + 1024; LAS float* cci = ccr + 1024; LAS float* kk = cci + 1024;
    const float* lam_re = a->in[20] + (size_t)(l * 32 + g) * 64; const float* lam_im = a->in[21] + (size_t)(l * 32 + g) * 64;
    const float dt = expf(a->in[22][l * 32 + g]);
    bf16_t* TF = (bf16_t*)(a->ws + OFF_TF); bf16_t* ET = (bf16_t*)(a->ws + OFF_ET); float* TAB = (float*)(a->ws + OFF_TAB);
    for (int idx = tid; idx < 17 * 64; idx += 512) { const int d = idx >> 6, p = idx & 63; const float lr = lam_re[p], li = lam_im[p];
        const float mag = expf((float)d * lr * dt);
        double x = (double)d * (double)li * (double)dt; x -= 6.283185307179586 * rint(x * 0.15915494309189535); const float xr = (float)x;
        apr[idx] = mag * cosf(xr); api[idx] = mag * sinf(xr); }
    __syncthreads();
    for (int idx = tid; idx < 1024; idx += 512) { const int p = idx >> 4; const float lr = lam_re[p], li = lam_im[p], ar = apr[64 + p], ai = api[64 + p], den = lr * lr + li * li;
        const float qr = ((ar - 1.0f) * lr + ai * li) / den, qi = (ai * lr - (ar - 1.0f) * li) / den;
        const float br = a->in[23][(size_t)(l * 32 + g) * 1024 + idx], bi = a->in[24][(size_t)(l * 32 + g) * 1024 + idx];
        bbr[idx] = qr * br - qi * bi; bbi[idx] = qr * bi + qi * br;
        ccr[idx] = a->in[25][(size_t)(l * 32 + g) * 1024 + idx]; cci[idx] = a->in[26][(size_t)(l * 32 + g) * 1024 + idx]; }
    __syncthreads();
    if (part == 0 && tid < 64) { TAB[(g * 64 + tid) * 2] = apr[64 + tid]; TAB[(g * 64 + tid) * 2 + 1] = api[64 + tid]; TAB[4096 + (g * 64 + tid) * 2] = apr[16 * 64 + tid]; TAB[4096 + (g * 64 + tid) * 2 + 1] = api[16 * 64 + tid]; }
    if (part == 0) for (int idx = tid; idx < 1024; idx += 512) { TAB[8192 + ((size_t)g * 1024 + idx) * 2] = bbr[idx]; TAB[8192 + ((size_t)g * 1024 + idx) * 2 + 1] = bbi[idx]; }
    for (int idx = tid; idx < 4096; idx += 512) { const int d = idx >> 8, c = (idx >> 4) & 15, c2 = idx & 15; float s = 0.f;
        for (int p = 0; p < 64; ++p) { const float Pr = apr[d * 64 + p], Pi = api[d * 64 + p], Br = bbr[p * 16 + c2], Bi = bbi[p * 16 + c2];
            const float Wr = Pr * Br - Pi * Bi, Wi = Pr * Bi + Pi * Br; s += ccr[c * 64 + p] * Wr - cci[c * 64 + p] * Wi; }
        kk[idx] = s; }
    __syncthreads();
    const int tfn = 256 / nparts, etn = 128 / nparts;
    for (int idx = part * tfn * KS5 + tid; idx < (part + 1) * tfn * KS5; idx += 512) { const int n = idx / KS5, k = idx % KS5, i = n >> 4, c = n & 15; float v;
        if (k < 256) { const int j = k >> 4, c2 = k & 15; v = (i >= j) ? kk[(i - j) * 256 + c * 16 + c2] : 0.f; }
        else if (k < 320) { const int p = k - 256; v = ccr[c * 64 + p] * apr[(i + 1) * 64 + p] - cci[c * 64 + p] * api[(i + 1) * 64 + p]; }
        else { const int p = k - 320; v = -(ccr[c * 64 + p] * api[(i + 1) * 64 + p] + cci[c * 64 + p] * apr[(i + 1) * 64 + p]); }
        TF[((size_t)g * 256 + n) * KS5 + k] = f2bf(v); }
    for (int idx = part * etn * 256 + tid; idx < (part + 1) * etn * 256; idx += 512) { const int n = idx >> 8, k = idx & 255, p = n & 63, j = k >> 4, c2 = k & 15, d = 15 - j;
        const float Pr = apr[d * 64 + p], Pi = api[d * 64 + p], Br = bbr[p * 16 + c2], Bi = bbi[p * 16 + c2];
        ET[((size_t)g * 128 + n) * 256 + k] = f2bf(n < 64 ? (Pr * Br - Pi * Bi) : (Pr * Bi + Pi * Br)); }
    if (g == 31 && part == 0) for (int idx = tid; idx < 128 * 256; idx += 512) ET[(size_t)32 * 128 * 256 + idx] = 0;
    __syncthreads();
}

__device__ __forceinline__ void phase0(KArgsP a, int l, LAS unsigned char* lds) {
    const int tid = otid(), blk = blockIdx.x, nblk = gridDim.x;
    LAS float* tile = (LAS float*)lds; unsigned char* ws = a->ws;
    const int nsb = (nblk >= 256) ? 128 : 0, nb = nblk - nsb;
    if (blk < nb) { int base = 0;
        base = conv_T<1>(tile, a->in[8] + (size_t)l * 1024 * INW, INW, a->in[7] + l * 1024, (bf16_t*)(ws + OFF_WIN), 1024, INW, 1024, nb, blk, base);
        base = conv_T<2>(tile, a->in[36] + (size_t)l * 1024 * INW, INW, a->in[35] + l * 1024, (bf16_t*)(ws + OFF_WF1), 1024, INW, 1024, nb, blk, base);
        base = conv_T<0>(tile, a->in[37] + (size_t)l * DFF * 1024, 1024, nullptr, (bf16_t*)(ws + OFF_WF2), DFF, 1024, DFF, nb, blk, base);
        base = conv_T<0>(tile, a->in[31] + (size_t)l * 1024 * 1024, 1024, nullptr, (bf16_t*)(ws + OFF_WPA), 1024, 1024, 1024, nb, blk, base);
        base = conv_T<0>(tile, a->in[34] + (size_t)l * 1024 * 1024, 1024, nullptr, (bf16_t*)(ws + OFF_WOUT), 1024, 1024, 1024, nb, blk, base);
        base = conv_T<0>(tile, a->in[32] + (size_t)l * 512 * 1024, 1024, nullptr, (bf16_t*)(ws + OFF_WPB), 512, 1024, 512, nb, blk, base);
        base = conv_T<0>(tile, a->in[33] + (size_t)l * 512 * 1024, 1024, nullptr, (bf16_t*)(ws + OFF_WPC), 512, 1024, 512, nb, blk, base);
        base = conv_T<0>(tile, a->in[28] + (size_t)l * 512 * 512, 512, nullptr, (bf16_t*)(ws + OFF_WGLU), 512, 512, 512, nb, blk, base);
    }
    { bf16_t* wgt = (bf16_t*)(ws + OFF_WGT); const float* wrg = a->in[11] + (size_t)l * 8 * 128 * 128; const float* wig = a->in[13] + (size_t)l * 8 * 128 * 128;
      for (int idx = blk * 512 + tid; idx < 2048 * 256; idx += nblk * 512) { const int n = idx >> 8, k = idx & 255, h = n >> 8, s = (n >> 7) & 1, j = n & 127; float v = 0.f;
          if ((k >> 7) == (h & 1)) v = (s ? wig : wrg)[((size_t)h * 128 + (k & 127)) * 128 + j];
          wgt[idx] = f2bf(v); } }
    { float* TAB = (float*)(ws + OFF_TAB); for (int idx = blk * 512 + tid; idx < 1024; idx += nblk * 512) TAB[TAB_LAM + idx] = -8.0f * log1pf(expf(-a->in[15][l * 1024 + idx])); }
    if (nsb) { if (blk >= nb) s5_build(a, l, (blk - nb) >> 2, lds, (blk - nb) & 3, 4); } else { for (int g = blk; g < 32; g += nblk) s5_build(a, l, g, lds, 0, 1); }
    if (l == 0) {
        bf16_t* xb = (bf16_t*)(ws + OFF_XB); float* rsq = (float*)(ws + OFF_RSQ); const int wv = tid >> 6, lane = tid & 63;
        f32x4 vn[4]; const int rstep = nblk * 8; int row = blk * 8 + wv;
        if (row < MT) { const float* src = (row < MP) ? a->in[0] + (size_t)row * 1024 : a->in[1] + (size_t)(row - MP) * 1024;
#pragma unroll
            for (int i = 0; i < 4; ++i) vn[i] = *(const f32x4*)(src + i * 256 + lane * 4); }
        for (; row < MT; row += rstep) { f32x4 vc[4]; float ss = 0.f;
#pragma unroll
            for (int i = 0; i < 4; ++i) vc[i] = vn[i];
            if (row + rstep < MT) { const int rn = row + rstep; const float* src = (rn < MP) ? a->in[0] + (size_t)rn * 1024 : a->in[1] + (size_t)(rn - MP) * 1024;
#pragma unroll
                for (int i = 0; i < 4; ++i) vn[i] = *(const f32x4*)(src + i * 256 + lane * 4); }
#pragma unroll
            for (int i = 0; i < 4; ++i) { const f32x4 v = vc[i]; ss += v[0] * v[0] + v[1] * v[1] + v[2] * v[2] + v[3] * v[3];
                u32x2 w; w.x = cvt_pk_bf16(v[0], v[1]); w.y = cvt_pk_bf16(v[2], v[3]); *(u32x2*)(xb + (size_t)row * 1024 + i * 256 + lane * 4) = w; }
            ss = wave_sum(ss); if (lane < 16) rsq[(size_t)row * 16 + lane] = (lane == 0) ? ss : 0.f; }
    }
}

__device__ __forceinline__ void conv_a_phase(KArgsP a, int l) {
    const bf16_t* ua = (const bf16_t*)(a->ws + OFF_SA); bf16_t* ca = (bf16_t*)(a->ws + OFF_SB);
    const float* w = a->in[9] + (size_t)l * 4 * 1024; const float* bias = a->in[10] + (size_t)l * 1024;
    const int tid = otid();
    const int c8 = (tid & 127) * 8;
    float wv[4][8], bv[8];
#pragma unroll
    for (int k = 0; k < 4; ++k) { const f32x4 p = *(const f32x4*)(w + k * 1024 + c8), q = *(const f32x4*)(w + k * 1024 + c8 + 4);
#pragma unroll
        for (int j = 0; j < 4; ++j) { wv[k][j] = p[j]; wv[k][4 + j] = q[j]; } }
    { const f32x4 p = *(const f32x4*)(bias + c8), q = *(const f32x4*)(bias + c8 + 4);
#pragma unroll
      for (int j = 0; j < 4; ++j) { bv[j] = p[j]; bv[4 + j] = q[j]; } }
    const int step = gridDim.x * 512; int idx = blockIdx.x * 512 + tid;
    u32x4 xv[4];
    if (idx < MT * 128) { const int row = idx >> 7;
#pragma unroll
        for (int k = 0; k < 4; ++k) { const int rr = row - 3 + k; xv[k] = *(const u32x4*)(ua + (size_t)(rr < 0 ? 0 : rr) * 1024 + c8); } }
    for (; idx < MT * 128; idx += step) {
        const int row = idx >> 7; float acc[8], x[8]; u32x4 xc[4];
#pragma unroll
        for (int k = 0; k < 4; ++k) xc[k] = xv[k];
        if (idx + step < MT * 128) { const int rown = (idx + step) >> 7;
#pragma unroll
            for (int k = 0; k < 4; ++k) { const int rr = rown - 3 + k; xv[k] = *(const u32x4*)(ua + (size_t)(rr < 0 ? 0 : rr) * 1024 + c8); } }
#pragma unroll
        for (int j = 0; j < 8; ++j) acc[j] = bv[j];
        unpack8(xc[3], x);
        if (row < MP) { const int t = row & (SEQ - 1), b = row >> 11;
#pragma unroll
            for (int k = 0; k < 4; ++k) { if (t - 3 + k >= 0) { float xk[8]; unpack8(xc[k], xk);
#pragma unroll
                for (int j = 0; j < 8; ++j) acc[j] += wv[k][j] * xk[j]; } }
            if (t >= SEQ - 3) { float* o = a->out + O_PLC + (((size_t)l * NBATCH + b) * 3 + (t - (SEQ - 3))) * 1024 + c8;
#pragma unroll
                for (int j = 0; j < 8; ++j) o[j] = x[j]; }
        } else { const int s = row - MP; const float* st = a->in[2] + ((size_t)l * MS + s) * 3 * 1024 + c8; float* o = a->out + O_SLC + ((size_t)l * MS + s) * 3 * 1024 + c8;
#pragma unroll
            for (int j = 0; j < 8; ++j) { const float s0 = st[j], s1 = st[1024 + j], s2 = st[2048 + j];
                acc[j] += wv[0][j] * s0 + wv[1][j] * s1 + wv[2][j] * s2 + wv[3][j] * x[j]; o[j] = s1; o[1024 + j] = s2; o[2048 + j] = x[j]; }
        }
        store8(ca + (size_t)row * 1024 + c8, acc);
    }
}

__device__ __forceinline__ void cfm_phase(KArgsP a, int l, LAS unsigned char* lds) {
    const int tid = otid(), half = tid >> 8, cp = tid & 255, wv = tid >> 6, lane = tid & 63;
    const bf16_t* glu = (const bf16_t*)(a->ws + OFF_SE); bf16_t* yb = (bf16_t*)(a->ws + OFF_YB);
    LAS unsigned* in = (LAS unsigned*)lds;
    LAS float* part = (LAS float*)(lds + 62 * 1024);
    const float* wdw = a->in[16] + (size_t)l * 31 * 512 + 2 * cp;
    typedef float f32x2 __attribute__((ext_vector_type(2)));
    LAS f32x2* wl = (LAS f32x2*)(lds + 65536);
    for (int idx = tid; idx < 31 * 256; idx += 512) { const f32x2 wk = *(const f32x2*)(a->in[16] + (size_t)l * 31 * 512 + 2 * idx);
        u32x2 pk; pk.x = cvt_pk_bf16(wk.x, 0.f); pk.y = cvt_pk_bf16(0.f, wk.y); ((LAS u32x2*)wl)[idx] = pk; }
    const float bs0 = a->in[17][l * 512 + 2 * cp], bs1 = a->in[17][l * 512 + 2 * cp + 1];
    const float lg0 = a->in[18][l * 512 + 2 * cp], lg1 = a->in[18][l * 512 + 2 * cp + 1], lb0 = a->in[19][l * 512 + 2 * cp], lb1 = a->in[19][l * 512 + 2 * cp + 1];
    u32x4 pv[8];
#define CFM_LOAD(tl) do { const int b_ = (tl) >> 6, t0_ = ((tl) & 63) * 32; \
        _Pragma("unroll") for (int i = 0; i < 8; ++i) { const int idx = tid + 512 * i, r = idx >> 6, c16 = idx & 63, t = t0_ - 30 + r; pv[i] = (u32x4){0u, 0u, 0u, 0u}; \
            if (idx < 62 * 64 && t >= 0) pv[i] = *(const u32x4*)(glu + ((size_t)b_ * SEQ + t) * 512 + c16 * 8); } } while (0)
    if ((int)blockIdx.x < 512) CFM_LOAD((int)blockIdx.x);
    const int ntl = (gridDim.x == 256) ? 768 : 512 + 64;
    for (int tile0 = blockIdx.x; tile0 < ntl; tile0 += gridDim.x) {
        int tile = tile0;
        if (gridDim.x == 256 && tile0 >= 512) { tile = 512 + (((int)blockIdx.x + 64) & 255); if (tile >= 512 + 64) continue; }
        if (tile < 512) {
            const int b = tile >> 6, t0 = (tile & 63) * 32;
#pragma unroll
            for (int i = 0; i < 8; ++i) { const int idx = tid + 512 * i; if (idx < 62 * 64) *(LAS u32x4*)(in + (idx >> 6) * 256 + (idx & 63) * 4) = pv[i]; }
            if (tile + (int)gridDim.x < 512) CFM_LOAD(tile + (int)gridDim.x);
            __syncthreads();
            float val0[16], val1[16];
#pragma unroll
            for (int j = 0; j < 16; ++j) { val0[j] = bs0; val1[j] = bs1; }
#pragma unroll 1
            for (int k = 0; k < 31; ++k) { const u32x2 wk = ((const LAS u32x2*)wl)[k * 256 + cp]; const LAS unsigned* ip = in + (half * 16 + k) * 256 + cp;
#pragma unroll
                for (int j = 0; j < 16; ++j) { const unsigned xw = ip[j * 256];
                    asm("v_dot2c_f32_bf16 %0, %1, %2" : "+v"(val0[j]) : "v"(xw), "v"(wk.x));
                    asm("v_dot2c_f32_bf16 %0, %1, %2" : "+v"(val1[j]) : "v"(xw), "v"(wk.y)); } }
#pragma unroll
            for (int ti = 0; ti < 16; ++ti) { float s = val0[ti] + val1[ti], q = val0[ti] * val0[ti] + val1[ti] * val1[ti]; s = wave_sum(s); q = wave_sum(q);
                if (lane == 0) { part[((half * 16 + ti) * 4 + (wv & 3)) * 2] = s; part[((half * 16 + ti) * 4 + (wv & 3)) * 2 + 1] = q; } }
            if (t0 + 32 == SEQ) {
                float* o = a->out + O_PCC + ((size_t)l * NBATCH + b) * 30 * 512;
                for (int idx = tid; idx < 30 * 256; idx += 512) { const int r = idx >> 8, c = idx & 255; const unsigned xw = in[(32 + r) * 256 + c]; o[r * 512 + 2 * c] = __uint_as_float(xw << 16); o[r * 512 + 2 * c + 1] = __uint_as_float(xw & 0xffff0000u); } }
            __syncthreads();
#pragma unroll
            for (int ti = 0; ti < 16; ++ti) { const LAS float* pp = part + (half * 16 + ti) * 8; const float S = (pp[0] + pp[2]) + (pp[4] + pp[6]), Q = (pp[1] + pp[3]) + (pp[5] + pp[7]);
                const float mean = S * (1.0f / 512.0f), var = fmaxf(Q * (1.0f / 512.0f) - mean * mean, 0.f), rstd = rsqrtf(var + EPS);
                float y0 = (val0[ti] - mean) * rstd * lg0 + lb0, y1 = (val1[ti] - mean) * rstd * lg1 + lb1; y0 *= sigm(y0); y1 *= sigm(y1);
                *(unsigned*)(yb + ((size_t)b * SEQ + t0 + half * 16 + ti) * 512 + 2 * cp) = cvt_pk_bf16(y0, y1); }
            __syncthreads();
        } else {
            const int s = (tile - 512) * 2 + half; const float* st = a->in[4] + ((size_t)l * MS + s) * 30 * 512 + 2 * cp; float* o = a->out + O_SCC + ((size_t)l * MS + s) * 30 * 512 + 2 * cp;
            float a0 = bs0, a1 = bs1;
#pragma unroll 2
            for (int k = 0; k < 30; ++k) { const float x0 = st[k * 512], x1 = st[k * 512 + 1]; a0 += wdw[k * 512] * x0; a1 += wdw[k * 512 + 1] * x1; if (k >= 1) { o[(k - 1) * 512] = x0; o[(k - 1) * 512 + 1] = x1; } }
            { const unsigned xw = *(const unsigned*)(glu + (size_t)(MP + s) * 512 + 2 * cp); const float x0 = __uint_as_float(xw << 16), x1 = __uint_as_float(xw & 0xffff0000u);
              a0 += wdw[30 * 512] * x0; a1 += wdw[30 * 512 + 1] * x1; o[29 * 512] = x0; o[29 * 512 + 1] = x1; }
            float sm = wave_sum(a0 + a1), q = wave_sum(a0 * a0 + a1 * a1);
            if (lane == 0) { part[(half * 4 + (wv & 3)) * 2] = sm; part[(half * 4 + (wv & 3)) * 2 + 1] = q; }
            __syncthreads();
            { const LAS float* pp = part + half * 8; const float S = (pp[0] + pp[2]) + (pp[4] + pp[6]), Q = (pp[1] + pp[3]) + (pp[5] + pp[7]);
              const float mean = S * (1.0f / 512.0f), var = fmaxf(Q * (1.0f / 512.0f) - mean * mean, 0.f), rstd = rsqrtf(var + EPS);
              float y0 = (a0 - mean) * rstd * lg0 + lb0, y1 = (a1 - mean) * rstd * lg1 + lb1; y0 *= sigm(y0); y1 *= sigm(y1);
              *(unsigned*)(yb + (size_t)(MP + s) * 512 + 2 * cp) = cvt_pk_bf16(y0, y1); }
            __syncthreads();
        }
    }
}

#undef CFM_LOAD
__device__ __forceinline__ void s5_sample(KArgsP a, int l) {
    const int tid = otid(); const int wv = tid >> 6, p = tid & 63; const float* TAB = (const float*)(a->ws + OFF_TAB);
    const bf16_t* ucs = (const bf16_t*)(a->ws + OFF_UCS); bf16_t* yc0 = (bf16_t*)(a->ws + OFF_SE);
    for (int w = blockIdx.x * 8 + wv; w < MS * 32; w += gridDim.x * 8) { const int s = w >> 5, g = w & 31;
        float u[16]; load8(ucs + (size_t)s * 512 + g * 16, u); load8(ucs + (size_t)s * 512 + g * 16 + 8, u + 8);
        const float ar = TAB[(g * 64 + p) * 2], ai = TAB[(g * 64 + p) * 2 + 1]; const float* bb = TAB + 8192 + ((size_t)g * 1024 + p * 16) * 2;
        const size_t si = (((size_t)l * MS + s) * 32 + g) * 64 + p; const float s0r = a->in[5][si], s0i = a->in[6][si];
        float xr = ar * s0r - ai * s0i, xi = ar * s0i + ai * s0r;
#pragma unroll
        for (int c = 0; c < 16; ++c) { xr += bb[2 * c] * u[c]; xi += bb[2 * c + 1] * u[c]; }
        a->out[O_SSR + si] = xr; a->out[O_SSI + si] = xi;
        const float* cr = a->in[25] + (size_t)(l * 32 + g) * 1024; const float* ci = a->in[26] + (size_t)(l * 32 + g) * 1024; float mine = 0.f;
#pragma unroll
        for (int c = 0; c < 16; ++c) { const float t = wave_sum(cr[c * 64 + p] * xr - ci[c * 64 + p] * xi); if (p == c) mine = t; }
        float up = 0.f;
#pragma unroll
        for (int c = 0; c < 16; ++c) up = (p == c) ? u[c] : up;
        if (p < 16) yc0[(size_t)(MP + s) * 512 + g * 16 + p] = f2bf(gelu_tanh(mine + a->in[27][l * 512 + g * 16 + p] * up));
    }
}

__device__ __forceinline__ void s5_carry_bg(KArgsP a, int l, LAS unsigned char* lds, const int b, const int g) {
    const int tid = otid(), seg = tid >> 6, p = tid & 63; const float* TAB = (const float*)(a->ws + OFF_TAB);
    const float* ends = (const float*)(a->ws + OFF_SF); bf16_t* ucg = (bf16_t*)(a->ws + OFF_UCG); LAS float* sT = (LAS float*)lds;
    {
        const float ar = TAB[4096 + (g * 64 + p) * 2], ai = TAB[4096 + (g * 64 + p) * 2 + 1];
        const size_t c0 = (size_t)g * NCHK + b * 128 + seg * 16; float er[16], ei[16];
#pragma unroll
        for (int k = 0; k < 16; ++k) { er[k] = ends[(c0 + k) * 128 + p]; ei[k] = ends[(c0 + k) * 128 + 64 + p]; }
        float Lr[17], Li[17]; Lr[0] = 0.f; Li[0] = 0.f;
#pragma unroll
        for (int k = 0; k < 16; ++k) { Lr[k + 1] = ar * Lr[k] - ai * Li[k] + er[k]; Li[k + 1] = ar * Li[k] + ai * Lr[k] + ei[k]; }
        sT[(seg * 64 + p) * 2] = Lr[16]; sT[(seg * 64 + p) * 2 + 1] = Li[16];
        __syncthreads();
        float br = ar, bi = ai;
#pragma unroll
        for (int i = 0; i < 4; ++i) { const float t = br * br - bi * bi; bi = 2.f * br * bi; br = t; }
        float Sr = 0.f, Si = 0.f;
        for (int s2 = 0; s2 < seg; ++s2) { const float tr = sT[(s2 * 64 + p) * 2], ti = sT[(s2 * 64 + p) * 2 + 1]; const float nr = br * Sr - bi * Si + tr; Si = br * Si + bi * Sr + ti; Sr = nr; }
        float pr = 1.f, pi = 0.f;
#pragma unroll
        for (int k = 0; k < 16; ++k) { const float vr = Lr[k] + pr * Sr - pi * Si, vi = Li[k] + pr * Si + pi * Sr;
            ucg[(c0 + k) * KS5 + 256 + p] = f2bf(vr); ucg[(c0 + k) * KS5 + 320 + p] = f2bf(vi);
            const float t = pr * ar - pi * ai; pi = pr * ai + pi * ar; pr = t; }
        if (seg == 7) { const size_t o = (((size_t)l * NBATCH + b) * 32 + g) * 64 + p; a->out[O_PSR + o] = Lr[16] + br * Sr - bi * Si; a->out[O_PSI + o] = Li[16] + br * Si + bi * Sr; }
        __syncthreads();
    }
}
__device__ __forceinline__ void s5_carry(KArgsP a, int l, LAS unsigned char* lds) { for (int w = blockIdx.x; w < NBATCH * 32; w += gridDim.x) s5_carry_bg(a, l, lds, w >> 5, w & 31); }

__device__ __forceinline__ void lru_scan(KArgsP a, int l, LAS unsigned char* lds, bf16_t* dst_alt) {
    const int tid = otid(), cq = tid & 7, chunk = tid >> 3;
    bf16_t* la = (bf16_t*)(a->ws + OFF_SA); const bf16_t* bx = (const bf16_t*)(a->ws + OFF_SC);
    LAS f32x4* sP = (LAS f32x4*)lds; LAS f32x4* sH = sP + 64 * 8;
    for (int w = blockIdx.x; w < NBATCH * 32; w += gridDim.x) { const int b = w >> 5, cg_ = w & 31;
        const size_t base = ((size_t)b * SEQ + chunk * 32) * 1024 + cg_ * 32 + cq * 4;
        f32x4 P = (f32x4){1.f, 1.f, 1.f, 1.f}, h = (f32x4){0.f, 0.f, 0.f, 0.f};
        u32x2 lw[32], bw[32];
#pragma unroll
        for (int j = 0; j < 32; ++j) { lw[j] = *(const u32x2*)(la + base + (size_t)j * 1024); bw[j] = *(const u32x2*)(bx + base + (size_t)j * 1024); }
#pragma unroll
        for (int j = 0; j < 32; ++j) { const f32x4 av = (f32x4){__expf(bf2f(lw[j].x & 0xffffu)), __expf(bf2f(lw[j].x >> 16)), __expf(bf2f(lw[j].y & 0xffffu)), __expf(bf2f(lw[j].y >> 16))};
            const f32x4 bv = (f32x4){bf2f(bw[j].x & 0xffffu), bf2f(bw[j].x >> 16), bf2f(bw[j].y & 0xffffu), bf2f(bw[j].y >> 16)};
            h = av * h + bv; P = P * av; }
        sP[chunk * 8 + cq] = P; sH[chunk * 8 + cq] = h;
        __syncthreads();
        f32x4 cin = (f32x4){0.f, 0.f, 0.f, 0.f};
        for (int c2 = 0; c2 < chunk; ++c2) cin = sP[c2 * 8 + cq] * cin + sH[c2 * 8 + cq];
        h = cin;
#pragma unroll
        for (int j = 0; j < 32; ++j) { asm volatile("" : "+v"(lw[j].x), "+v"(lw[j].y), "+v"(bw[j].x), "+v"(bw[j].y));
            const f32x4 av = (f32x4){__expf(bf2f(lw[j].x & 0xffffu)), __expf(bf2f(lw[j].x >> 16)), __expf(bf2f(lw[j].y & 0xffffu)), __expf(bf2f(lw[j].y >> 16))};
            const f32x4 bv = (f32x4){bf2f(bw[j].x & 0xffffu), bf2f(bw[j].x >> 16), bf2f(bw[j].y & 0xffffu), bf2f(bw[j].y >> 16)};
            h = av * h + bv; u32x2 o; o.x = cvt_pk_bf16(h[0], h[1]); o.y = cvt_pk_bf16(h[2], h[3]); *(u32x2*)(dst_alt + base + (size_t)j * 1024) = o; }
        if (chunk == 63) *(f32x4*)(a->out + O_PLH + ((size_t)l * NBATCH + b) * 1024 + cg_ * 32 + cq * 4) = h;
        __syncthreads();
    }
}


#define XB_TMO      128
#define XB_XCNT(j)  (256  + 64 * (j))
#define XB_XSUB(j)  (1280 + 64 * (j))
#define XB_XGEN(j)  (2304 + 64 * (j))
#define XB_TOP      3328
#define XB_TOPGEN   3392
#define XCD_BAR_WORDS 3456
#define XB_SPIN_CAP (1u << 18)
__device__ __forceinline__ unsigned xb_ld(unsigned* p)              { return __hip_atomic_load(p, __ATOMIC_RELAXED, __HIP_MEMORY_SCOPE_AGENT); }
__device__ __forceinline__ unsigned xb_add(unsigned* p, unsigned v) { return __hip_atomic_fetch_add(p, v, __ATOMIC_RELAXED, __HIP_MEMORY_SCOPE_AGENT); }
__device__ __forceinline__ unsigned xb_xcc_id() { return (unsigned)__builtin_amdgcn_s_getreg((3 << 11) | 20) & 0xFu; }
#define XB_SPIN(cond, bar) do { unsigned _sp = 0; while (cond) { __builtin_amdgcn_s_sleep(1); \
    if ((++_sp & 255u) == 0u) { if (xb_ld(&(bar)[XB_TMO])) break; if (_sp > XB_SPIN_CAP) { atomicAdd(&(bar)[XB_TMO], 1u); break; } } } } while (0)
__device__ __forceinline__ void xcd_barrier_complete(unsigned* bar, unsigned x, unsigned& nloc, unsigned& nx) {
    const unsigned G = gridDim.x * gridDim.y * gridDim.z;
    unsigned sum, cnt, mine, sp = 0u;
    for (;;) {
        sum = 0u; cnt = 0u; mine = 0u;
#pragma unroll
        for (unsigned j = 0; j < 16; ++j) { const unsigned c = xb_ld(&bar[XB_XCNT(j)]); sum += c; cnt += (c > 0u) ? 1u : 0u; mine = (j == x) ? c : mine; }
        if (sum == G) break;
        __builtin_amdgcn_s_sleep(1);
        if ((++sp & 255u) == 0u) { if (xb_ld(&bar[XB_TMO])) break; if (sp > XB_SPIN_CAP) { atomicAdd(&bar[XB_TMO], 1u); break; } }
    }
    nloc = mine > 0u ? mine : 1u; nx = cnt > 0u ? cnt : 1u;
}
__device__ __forceinline__ void xcd_barrier(unsigned* bar, volatile LAS unsigned* st) {
    asm volatile("s_waitcnt vmcnt(0)" ::: "memory");
    __syncthreads();
    if (threadIdx.x == 0) {
        const unsigned x = xb_xcc_id();
        __builtin_amdgcn_s_waitcnt(0);
        unsigned nloc = st[0], nx = st[1];
        if (nloc == 0u) { xcd_barrier_complete(bar, x, nloc, nx); st[0] = nloc; st[1] = nx; }
        const unsigned old = xb_add(&bar[XB_XSUB(x)], 1u);
        const unsigned gen = old / nloc;
        if (old + 1u == (gen + 1u) * nloc) {
            __builtin_amdgcn_fence(__ATOMIC_RELEASE, "agent");
            asm volatile("s_waitcnt vmcnt(0)" ::: "memory");
            const unsigned og = xb_add(&bar[XB_TOP], 1u);
            const unsigned tg = og / nx;
            if (og + 1u == (tg + 1u) * nx) xb_add(&bar[XB_TOPGEN], 1u);
            else XB_SPIN(xb_ld(&bar[XB_TOPGEN]) == tg, bar);
            __builtin_amdgcn_fence(__ATOMIC_ACQUIRE, "agent");
            xb_add(&bar[XB_XGEN(x)], 1u);
            asm volatile("s_waitcnt vmcnt(0)" ::: "memory");
        } else {
            XB_SPIN(xb_ld(&bar[XB_XGEN(x)]) == gen, bar);
            __builtin_amdgcn_fence(__ATOMIC_ACQUIRE, "agent");
            asm volatile("s_waitcnt vmcnt(0)" ::: "memory");
        }
    }
    __syncthreads();
}

#ifndef PROBE_DUP
#define PROBE_DUP -1
#endif
#define REP(k) for (int rep_ = 0; rep_ < ((PROBE_DUP) == (k) ? 2 : 1); ++rep_)
#define XBAR() xcd_barrier((unsigned*)(kargs()->ws + OFF_BAR), (volatile LAS unsigned*)(lds + 131072 + 512))
#define GSYNC() do { XBAR(); if ((PROBE_DUP) == 100) XBAR(); } while (0)
#ifndef PH_ONLY
#define PH_ON(n) true
#else
#define PH_ON(n) ((n) == PH_ONLY)
#endif
__global__ void __launch_bounds__(512) fwd_megakernel(KArgs a_by_value) {
    extern __shared__ __attribute__((aligned(16))) unsigned char lds_raw[];
    LAS unsigned char* lds = (LAS unsigned char*)lds_raw;
    cg::grid_group grid = cg::this_grid();
    { volatile LAS unsigned* st = (volatile LAS unsigned*)(lds + 131072 + 512); if (threadIdx.x == 0) { st[0] = 0u; st[1] = 0u; }
      __syncthreads();
      if (threadIdx.x == 0) (void)xb_add((unsigned*)(kargs()->ws + OFF_BAR) + XB_XCNT(xb_xcc_id()), 1u); }
    grid.sync();
#define WSB(off) ((bf16_t*)(ws + (off)))
#define PH_HEAD KArgsP a = kargs(); unsigned char* ws = a->ws; const int G = gridDim.x, c = oblk(); (void)G; (void)c; (void)ws;

    for (int l = 0; l < NLAYER; ++l) {
        REP(0) if (PH_ON(0)) { PH_HEAD phase0(a, l, lds); }
        GSYNC();
        REP(1) if (PH_ON(1)) { PH_HEAD
          Sched S{65, 10, 1, G, c, 0, (const char*)WSB(OFF_XB), (const char*)WSB(OFF_WIN), 0, 0, (size_t)256 * 1024 * 2, (size_t)256 * 1024 * 2};
          F1 f{(const float*)(ws + OFF_RSQ), WSB(OFF_SA), WSB(OFF_SE), WSB(OFF_UCG), WSB(OFF_UCS)};
          gemm_phase(lds, 1024, 1024, 16, S, f); }
        GSYNC();
        REP(20) if (PH_ON(20)) { PH_HEAD conv_a_phase(a, l); }
        REP(21) if (PH_ON(21)) { PH_HEAD cfm_phase(a, l, lds); }
        REP(22) if (PH_ON(22)) { PH_HEAD
          Sched S{4, 1, 32, G, c, 0, (const char*)WSB(OFF_UCG), (const char*)(ws + OFF_ET), (size_t)NCHK * KS5 * 2, (size_t)128 * 256 * 2, (size_t)256 * KS5 * 2, 0};
          FEnd f{(float*)(ws + OFF_SF)};
          gemm_phase(lds, KS5, 256, 4, S, f);
          if (G == 256) { Unit u; if (S.next(0, u)) { s5_carry_bg(a, l, lds, 2 * u.pm, u.g); s5_carry_bg(a, l, lds, 2 * u.pm + 1, u.g); } } }
        GSYNC();
        if (gridDim.x == 256) {
            REP(3) if (PH_ON(3)) { PH_HEAD
              const bool lo = c < 128;
              Sched S{64, 8, 1, 128, lo ? c : c - 128, 1, (const char*)WSB(OFF_SB), (const char*)(ws + OFF_WGT), 0, 0, (size_t)256 * 1024 * 2, (size_t)256 * 256 * 2, lo ? 0L : 384L, lo ? 384L : 512L};
              F2 f{WSB(OFF_SB), a->in[12] + l * 1024, a->in[14] + l * 1024, (const float*)(ws + OFF_TAB) + TAB_LAM, a->in[3] + (size_t)l * MS * 1024, WSB(OFF_SA), WSB(OFF_SC), a->out + O_SLH + (size_t)l * MS * 1024};
              gemm_phase(lds, 1024, 256, 4, S, f);
              thin_gemm(lds, WSB(OFF_SB), 1024, WSB(OFF_WGT), 256, 256, 8, 1, f, c, G); }
            REP(41) if (PH_ON(41)) { PH_HEAD
              if (c >= 128) { Sched S{4, 1, 32, G, c - 128, 0, (const char*)WSB(OFF_UCG), (const char*)(ws + OFF_TF), (size_t)NCHK * KS5 * 2, (size_t)256 * KS5 * 2, (size_t)256 * KS5 * 2, 0};
                FS5 f{WSB(OFF_UCG), a->in[27] + l * 512, WSB(OFF_SE)};
                gemm_phase(lds, KS5, KS5, 6, S, f); } }
            REP(23) if (PH_ON(23)) { PH_HEAD s5_sample(a, l); }
            GSYNC();
            REP(4) if (PH_ON(4)) { PH_HEAD lru_scan(a, l, lds, WSB(OFF_SA)); }
        } else {
        REP(3) if (PH_ON(3)) { PH_HEAD
          Sched S{64, 8, 1, G, c, 1, (const char*)WSB(OFF_SB), (const char*)(ws + OFF_WGT), 0, 0, (size_t)256 * 1024 * 2, (size_t)256 * 256 * 2};
          F2 f{WSB(OFF_SB), a->in[12] + l * 1024, a->in[14] + l * 1024, (const float*)(ws + OFF_TAB) + TAB_LAM, a->in[3] + (size_t)l * MS * 1024, WSB(OFF_SA), WSB(OFF_SC), a->out + O_SLH + (size_t)l * MS * 1024};
          gemm_phase(lds, 1024, 256, 4, S, f);
          thin_gemm(lds, WSB(OFF_SB), 1024, WSB(OFF_WGT), 256, 256, 8, 1, f, c, G); }
        REP(31) if (PH_ON(31)) { PH_HEAD s5_carry(a, l, lds); }
        GSYNC();
        REP(4) if (PH_ON(4)) { PH_HEAD lru_scan(a, l, lds, ((PROBE_DUP) == 4 && rep_ == 0) ? WSB(OFF_SB) : WSB(OFF_SA)); }
        REP(23) if (PH_ON(23)) { PH_HEAD s5_sample(a, l); }
        REP(41) if (PH_ON(41)) { PH_HEAD
          Sched S{4, 1, 32, G, c, 0, (const char*)WSB(OFF_UCG), (const char*)(ws + OFF_TF), (size_t)NCHK * KS5 * 2, (size_t)256 * KS5 * 2, (size_t)256 * KS5 * 2, 0};
          FS5 f{WSB(OFF_UCG), a->in[27] + l * 512, WSB(OFF_SE)};
          gemm_phase(lds, KS5, KS5, 6, S, f); }
        GSYNC();
        }
        REP(5) if (PH_ON(5)) {
            { PH_HEAD
              Sched S{64, 2, 1, G, c, 0, (const char*)WSB(OFF_SE), (const char*)(ws + OFF_WGLU), 0, 0, (size_t)256 * 512 * 2, (size_t)256 * 512 * 2};
              F4 f{WSB(OFF_SE), a->in[29] + l * 512, WSB(OFF_SF)};
              gemm_phase(lds, 512, 512, 8, S, f);
              const int hb = G >> 1;
              thin_gemm(lds, WSB(OFF_SE), 512, WSB(OFF_WGLU), 512, 512, 2, 0, f, c >= hb ? c - hb : -1, G - hb); }
            { PH_HEAD
              const int hb = G >> 1, cr = c >= hb ? c - hb : c + (G - hb);
              const bf16_t* Wg = WSB(OFF_WIN) + (size_t)2560 * 1024;
              Sched S{64, 12, 1, G, cr, 0, (const char*)WSB(OFF_XB), (const char*)Wg, 0, 0, (size_t)256 * 1024 * 2, (size_t)256 * 1024 * 2};
              FG8 f{(const float*)(ws + OFF_RSQ), a->in[30] + l * 3072, ws + OFF_GT8};
              gemm_phase(lds, 1024, 1024, 16, S, f);
              thin_gemm(lds, WSB(OFF_XB), 1024, Wg, 1024, 1024, 12, 0, f, c >= hb ? c - hb : -1, G - hb); }
        }
        GSYNC();
        REP(6) if (PH_ON(6)) {
            { PH_HEAD
              SchedM3 S{G, c, (const char*)WSB(OFF_SA), (const char*)WSB(OFF_YB), (const char*)WSB(OFF_SF), (const char*)WSB(OFF_WPA), (const char*)WSB(OFF_WPB), (const char*)WSB(OFF_WPC)};
              FMS f{ws + OFF_GT8, WSB(OFF_MRG)};
              gemm_phase_t<FMS, SchedM3, true>(lds, 1024, 1024, 16, S, f); }
            { PH_HEAD
              thin_merge(lds, WSB(OFF_SA), WSB(OFF_YB), WSB(OFF_SF), WSB(OFF_WPA), WSB(OFF_WPB), WSB(OFF_WPC), ws + OFF_GT8, WSB(OFF_MRG), c, G); }
        }
        GSYNC();
        if (PH_ON(7)) { PH_HEAD
          Sched S{64, 4, 1, G, c, 0, (const char*)WSB(OFF_MRG), (const char*)(ws + OFF_WOUT), 0, 0, (size_t)256 * 1024 * 2, (size_t)256 * 1024 * 2};
          F6T<false> f{l == 0 ? a->in[0] : a->out, l == 0 ? a->in[1] : a->out + (size_t)MP * 1024, a->out, WSB(OFF_XB), (float*)(ws + OFF_RSQ2)};
          gemm_phase(lds, 1024, 1024, 16, S, f);
          F6T<true> ft{f.xs_p, f.xs_s, f.xd, f.xb, f.rsq};
          thin_gemm(lds, WSB(OFF_MRG), 1024, WSB(OFF_WOUT), 1024, 1024, 4, 0, ft, c, G); }
        GSYNC();
        REP(8) if (PH_ON(8)) { PH_HEAD
          Sched S{65, 22, 1, G, c, 0, (const char*)WSB(OFF_XB), (const char*)(ws + OFF_WF1), 0, 0, (size_t)256 * 1024 * 2, (size_t)256 * 1024 * 2};
          F7 f{(const float*)(ws + OFF_RSQ2), WSB(OFF_SA)};
          gemm_phase(lds, 1024, 1024, 16, S, f); }
        GSYNC();
        if (PH_ON(9)) { PH_HEAD
          Sched S{64, 4, 1, G, c, 0, (const char*)WSB(OFF_SA), (const char*)(ws + OFF_WF2), 0, 0, (size_t)256 * DFF * 2, (size_t)256 * DFF * 2};
          F6T<false> f{a->out, a->out + (size_t)MP * 1024, a->out, WSB(OFF_XB), (float*)(ws + OFF_RSQ)};
          gemm_phase(lds, DFF, DFF, DFF / 64, S, f);
          F6T<true> ft{f.xs_p, f.xs_s, f.xd, f.xb, f.rsq};
          thin_gemm(lds, WSB(OFF_SA), DFF, WSB(OFF_WF2), DFF, DFF, 4, 0, ft, c, G); }
        GSYNC();
    }
    { PH_HEAD const int tid = otid(); const int wv = tid >> 6, lane = tid & 63; const float* gf = a->in[38]; const float* RSQ = (const float*)(ws + OFF_RSQ);
      f32x4 vn[4], pn4; const int rstep = gridDim.x * 8; int row = blockIdx.x * 8 + wv; f32x4 gv[4];
#pragma unroll
      for (int i = 0; i < 4; ++i) gv[i] = *(const f32x4*)(gf + i * 256 + lane * 4);
      if (row < MT) { pn4 = *(const f32x4*)(RSQ + (size_t)row * 16 + (lane & 3) * 4);
#pragma unroll
          for (int i = 0; i < 4; ++i) vn[i] = *(const f32x4*)(a->out + (size_t)row * 1024 + i * 256 + lane * 4); }
      for (; row < MT; row += rstep) { f32x4 vc[4]; const f32x4 pc = pn4;
#pragma unroll
          for (int i = 0; i < 4; ++i) vc[i] = vn[i];
          if (row + rstep < MT) { const int rn = row + rstep; pn4 = *(const f32x4*)(RSQ + (size_t)rn * 16 + (lane & 3) * 4);
#pragma unroll
              for (int i = 0; i < 4; ++i) vn[i] = *(const f32x4*)(a->out + (size_t)rn * 1024 + i * 256 + lane * 4); }
          float sq = (pc[0] + pc[1]) + (pc[2] + pc[3]); sq += __shfl_xor(sq, 1); sq += __shfl_xor(sq, 2);
          const float rs = rsqrtf(sq * (1.0f / 1024.0f) + EPS); float* x = a->out + (size_t)row * 1024;
#pragma unroll
          for (int i = 0; i < 4; ++i) *(f32x4*)(x + i * 256 + lane * 4) = vc[i] * rs * gv[i]; } }
}

extern "C" void kernel_launch(void* const* d_in, const int* in_sizes, int n_in, void* d_out, int out_size, void* d_ws, size_t ws_size, hipStream_t stream) {
    static int grid_blocks = 0;
    if (!grid_blocks) {
        int dev = 0, cus = 0, per_cu = 0;
        hipGetDevice(&dev);
        hipDeviceGetAttribute(&cus, hipDeviceAttributeMultiprocessorCount, dev);
        hipFuncSetAttribute((const void*)fwd_megakernel, hipFuncAttributeMaxDynamicSharedMemorySize, LDS_BYTES);
        hipOccupancyMaxActiveBlocksPerMultiprocessor(&per_cu, (const void*)fwd_megakernel, 512, LDS_BYTES);
        if (per_cu < 1) { fprintf(stderr, "occupancy query says %d blocks/CU\n", per_cu); per_cu = 1; }
        if (per_cu > 1) per_cu = 1;
        grid_blocks = cus * per_cu;
        if (n_in != 39 || ws_size < WS_END) fprintf(stderr, "kernel_launch: unexpected n_in %d / ws_size %zu (need %zu)\n", n_in, ws_size, (size_t)WS_END);
    }
    (void)hipMemsetAsync((unsigned char*)d_ws + OFF_BAR, 0, 16384, stream);
    KArgs a{};
    for (int i = 0; i < 39; ++i) a.in[i] = (const float*)d_in[i];
    a.out = (float*)d_out; a.ws = (unsigned char*)d_ws;
    void* args[] = {&a};
    hipError_t e = hipLaunchCooperativeKernel((const void*)fwd_megakernel, dim3(grid_blocks), dim3(512), args, LDS_BYTES, stream);
    if (e != hipSuccess) fprintf(stderr, "cooperative launch failed: %s (grid %d)\n", hipGetErrorString(e), grid_blocks);
}
```

```cpp
#include <hip/hip_runtime.h>
#include <hip/hip_cooperative_groups.h>
#include <cstdio>
namespace cg = cooperative_groups;

#define LAS __attribute__((address_space(3)))
typedef unsigned short bf16_t;
typedef short bf16x8 __attribute__((ext_vector_type(8)));
typedef float f32x4 __attribute__((ext_vector_type(4)));
typedef unsigned u32x4 __attribute__((ext_vector_type(4)));
typedef unsigned u32x2 __attribute__((ext_vector_type(2)));

constexpr int D = 1024, SEQ = 2048, NBATCH = 8, MP = 16384, MS = 128, MT = MP + MS;
constexpr int INW = 5632, DFF = 2816, WB = 512, NG = 32, NPC = 64, NLAYER = 2;
constexpr int NCHK = 1024;
constexpr int KS5 = 384;
constexpr float EPS = 1e-6f;

constexpr size_t O_PLC = 16908288, O_PLH = 16957440, O_PCC = 16973824, O_PSR = 17219584, O_PSI = 17252352,
                 O_SLC = 17285120, O_SLH = 18071552, O_SCC = 18333696, O_SSR = 22265856, O_SSI = 22790144;

constexpr size_t SZ34 = (size_t)MT * 1024 * 2, SZ17 = (size_t)MT * 512 * 2;
constexpr size_t OFF_WIN = 0;
constexpr size_t OFF_WGT = OFF_WIN + (size_t)5632 * 1024 * 2;
constexpr size_t OFF_WGLU = OFF_WGT + (size_t)2048 * 256 * 2;
constexpr size_t OFF_WPA = OFF_WGLU + (size_t)512 * 512 * 2;
constexpr size_t OFF_WPB = OFF_WPA + (size_t)1024 * 1024 * 2;
constexpr size_t OFF_WPC = OFF_WPB + (size_t)1024 * 512 * 2;
constexpr size_t OFF_WOUT = OFF_WPC + (size_t)1024 * 512 * 2;
constexpr size_t OFF_WF1 = OFF_WOUT + (size_t)1024 * 1024 * 2;
constexpr size_t OFF_WF2 = OFF_WF1 + (size_t)5632 * 1024 * 2;
constexpr size_t OFF_TF = OFF_WF2 + (size_t)1024 * 2816 * 2;
constexpr size_t OFF_ET = OFF_TF + (size_t)32 * 256 * KS5 * 2;
constexpr size_t OFF_TAB = OFF_ET + (size_t)(32 * 128 + 128) * 256 * 2;
constexpr int TAB_LAM = 4096 + 4096 + 65536;
constexpr size_t OFF_RSQ = OFF_TAB + (size_t)(TAB_LAM + 1024) * 4;
constexpr size_t OFF_RSQ2 = OFF_RSQ + (size_t)MT * 16 * 4;
constexpr size_t OFF_XB = OFF_RSQ2 + (size_t)MT * 16 * 4;
constexpr size_t OFF_SA = OFF_XB + SZ34;
constexpr size_t OFF_SB = OFF_SA + SZ34;
constexpr size_t OFF_SC = OFF_SB + SZ34;
constexpr size_t OFF_UCG = OFF_SC + SZ34;
constexpr size_t OFF_UCS = OFF_UCG + (size_t)32 * 1024 * KS5 * 2;
constexpr size_t OFF_SE = OFF_UCS + (size_t)128 * 512 * 2;
constexpr size_t OFF_YB = OFF_SE + SZ17;
constexpr size_t OFF_SF = OFF_YB + SZ17;
constexpr size_t SZG8 = (((size_t)MT * 3072) + 255) & ~(size_t)255;
constexpr size_t OFF_GT8 = OFF_SB;
constexpr int G8_SPLIT = 11008;
static_assert((size_t)G8_SPLIT * 3072 == SZ34 && (size_t)(MT - G8_SPLIT) * 3072 <= (size_t)32 * 1024 * KS5 * 2, "gate array placement");
constexpr size_t OFF_MRG = OFF_SC;
constexpr size_t OFF_BAR = OFF_SF + SZ17;
constexpr size_t WS_END = OFF_BAR + 16384;
static_assert((size_t)32 * 1024 * 128 * 4 <= SZ17, "ends fits");
static_assert((size_t)MT * 2816 * 2 <= 3 * SZ34, "act fits");
static_assert(WS_END <= (size_t)256 * 1024 * 1024, "workspace");

constexpr int LDS_BYTES = 128 * 1024 + 1024;

struct KArgs { const float* in[39]; float* out; unsigned char* ws; };
typedef const __attribute__((address_space(4))) KArgs* KArgsP;
__device__ __forceinline__ KArgsP kargs() { auto p = __builtin_amdgcn_kernarg_segment_ptr(); asm volatile("" : "+s"(p)); return (KArgsP)p; }

__device__ __forceinline__ unsigned cvt_pk_bf16(float lo, float hi) { unsigned r; asm volatile("v_cvt_pk_bf16_f32 %0, %1, %2" : "=v"(r) : "v"(lo), "v"(hi)); return r; }
__device__ __forceinline__ bf16_t f2bf(float f) { return (bf16_t)(cvt_pk_bf16(f, 0.f) & 0xffffu); }
__device__ __forceinline__ float bf2f(unsigned b) { return __uint_as_float(b << 16); }
__device__ __forceinline__ void store8(bf16_t* p, const float* v) { u32x4 w; w.x = cvt_pk_bf16(v[0], v[1]); w.y = cvt_pk_bf16(v[2], v[3]); w.z = cvt_pk_bf16(v[4], v[5]); w.w = cvt_pk_bf16(v[6], v[7]); *(u32x4*)p = w; }
__device__ __forceinline__ void store4(bf16_t* p, const f32x4 v) { u32x2 w; w.x = cvt_pk_bf16(v[0], v[1]); w.y = cvt_pk_bf16(v[2], v[3]); *(u32x2*)p = w; }
struct PkSt { u32x2 pk[2]; };
template <int SLOT> __device__ __forceinline__ void wstore(PkSt& ps, const int n, bf16_t* p, const f32x4 v) {
    u32x2 w; w.x = cvt_pk_bf16(v[0], v[1]); w.y = cvt_pk_bf16(v[2], v[3]);
    if (n == 0) ps.pk[SLOT] = w; else { u32x4 q; q.x = ps.pk[SLOT].x; q.y = ps.pk[SLOT].y; q.z = w.x; q.w = w.y; *(u32x4*)(p - 4) = q; }
}
__device__ __forceinline__ void unpack8(const u32x4 w, float* v) {
    v[0] = __uint_as_float(w.x << 16); v[1] = __uint_as_float(w.x & 0xffff0000u); v[2] = __uint_as_float(w.y << 16); v[3] = __uint_as_float(w.y & 0xffff0000u);
    v[4] = __uint_as_float(w.z << 16); v[5] = __uint_as_float(w.z & 0xffff0000u); v[6] = __uint_as_float(w.w << 16); v[7] = __uint_as_float(w.w & 0xffff0000u); }
__device__ __forceinline__ void load8(const bf16_t* p, float* v) { unpack8(*(const u32x4*)p, v); }
__device__ __forceinline__ size_t g8row(int row) { return (size_t)row * 3072 + (row >= G8_SPLIT ? SZ34 : (size_t)0); }
__device__ __forceinline__ float sigm(float x) { return __builtin_amdgcn_rcpf(1.0f + __expf(-x)); }
template <int CTRL> __device__ __forceinline__ float dppx(float v) { return __int_as_float(__builtin_amdgcn_update_dpp(0, __float_as_int(v), CTRL, 0xf, 0xf, false)); }
__device__ __forceinline__ float wave_sum(float v) {
    v += dppx<0xB1>(v); v += dppx<0x4E>(v); v += dppx<0x141>(v); v += dppx<0x140>(v);
    { auto r = __builtin_amdgcn_permlane16_swap(__float_as_uint(v), __float_as_uint(v), false, false); v = __uint_as_float(r[0]) + __uint_as_float(r[1]); }
    { auto r = __builtin_amdgcn_permlane32_swap(__float_as_uint(v), __float_as_uint(v), false, false); v = __uint_as_float(r[0]) + __uint_as_float(r[1]); }
    return v;
}

__device__ __forceinline__ int otid() { int t = threadIdx.x; asm volatile("" : "+v"(t)); return t; }
__device__ __forceinline__ int oblk() { int t = blockIdx.x; asm volatile("" : "+s"(t)); return t; }
constexpr int BM = 256, BK = 64, HALF = 128, HTB = HALF * BK * 2, NXCD = 8, WGM = 8;
__device__ __forceinline__ int lds_byte(int r, int c) { const int st = (r >> 4) * 2 + (c >> 5), rr = r & 15, cc = c & 31, ob = rr * 64 + cc * 2; return st * 1024 + (ob ^ (((ob >> 9) & 1) << 5)); }
__device__ __forceinline__ void stage_rc(int b, int& R, int& C) { const int st = b / 1024, sb = b % 1024, swz = sb ^ (((sb >> 9) & 1) << 5); R = (st >> 1) * 16 + swz / 64; C = (st & 1) * 32 + (swz % 64) / 2; }
__device__ __forceinline__ int perm32(int rho) { const int n = rho >> 4, i = rho & 15; return 8 * (i >> 2) + 4 * n + (i & 3); }

struct Unit { int pm, pn, g, sm, fin; const char* A; const char* B; };
struct Sched {
    int nM, nN, nGrp, G, c, bd; const char* A;     const char* B; size_t a_g, b_g, a_pm, b_pn; long L0 = 0, Lend = (1L << 40);
    __device__ __forceinline__ bool next(int i, Unit& u) const {
        const long L = L0 + (long)i * G + c; const int nwg = nM * nN; if (L >= (long)nwg * nGrp || L >= Lend) return false;
        const int g = (int)(L / nwg); int wgid = (int)(L % nwg);
        { const int q = nwg / NXCD, r = nwg % NXCD, xcd = wgid % NXCD, off = wgid / NXCD; wgid = (xcd < r ? xcd * (q + 1) : r * (q + 1) + (xcd - r) * q) + off; }
        const int nig = WGM * nN, gid = wgid / nig, fm = gid * WGM, gsz = (nM - fm) < WGM ? (nM - fm) : WGM;
        u.pm = fm + ((wgid % nig) % gsz); u.pn = (wgid % nig) / gsz; u.g = g; u.sm = 0; u.fin = 1;
        u.A = A + (size_t)g * a_g + (size_t)u.pm * a_pm + (bd ? (size_t)(u.pn >> 1) * 512 : 0); u.B = B + (size_t)g * b_g + (size_t)u.pn * b_pn; return true;
    }
};

struct SchedM3 {
    int G, c; const char* YA; const char* YB; const char* YC; const char* WPA; const char* WPB; const char* WPC;
    __device__ __forceinline__ bool next(int i, Unit& u) const {
        const int rnd = i / 3, seg = i - rnd * 3; int wgid = c + rnd * G; if (wgid >= 256) return false;
        { const int q = 256 / NXCD, xcd = wgid % NXCD, off = wgid / NXCD; wgid = xcd * q + off; }
        const int nig = WGM * 4, gid = wgid / nig, fm = gid * WGM;
        u.pm = fm + ((wgid % nig) % WGM); u.pn = (wgid % nig) / WGM; u.g = seg; u.sm = seg ? 1 : 0; u.fin = (seg == 2);
        const size_t pa = (size_t)u.pm * 256 * 2, pb = (size_t)u.pn * 256 * 2;
        if (seg == 0) { u.A = YA + pa * 1024; u.B = WPA + pb * 1024; }
        else if (seg == 1) { u.A = YB + pa * 512; u.B = WPB + pb * 512; }
        else { u.A = YC + pa * 512; u.B = WPC + pb * 512; }
        return true;
    }
};

template <class F, class SC, bool MIX>
__device__ __forceinline__ void gemm_phase_t(LAS unsigned char* lds, const int lda, const int ldb, const int nt_, const SC& S, const F& E) {
    const int tid = otid(), wid = __builtin_amdgcn_readfirstlane(tid >> 6), lane = tid & 63, wr = wid >> 2, wc = wid & 3, fr = lane & 15, fq = lane >> 4;
    unsigned voffA[2], voffB[2];
#pragma unroll
    for (int i = 0; i < 2; ++i) { int R, C; stage_rc(tid * 16 + i * 8192, R, C); const int Rb = (R & ~31) + perm32(R & 31);
        voffA[i] = (unsigned)(R * (MIX ? 512 : lda) + C) * 2u; voffB[i] = (unsigned)(Rb * (MIX ? 512 : ldb) + C) * 2u; }
    const size_t kstep = (size_t)(BK * 2);
    const size_t hA0 = (size_t)HALF * lda * 2, hB0 = (size_t)HALF * ldb * 2;
    const unsigned ldsw = (unsigned)wid * 1024u;
    const int aoff = lds_byte(wr * 64 + fr, fq * 8), boff = lds_byte(wc * 32 + fr, fq * 8);
#define PG8_SA(b, h) (((b) * 2 + (h)) * HTB)
#define PG8_SB(b, h) ((4 + (b) * 2 + (h)) * HTB)
#define PG8_STAGE(bufoff, gbase, voff, m2) do { _Pragma("unroll") for (int _i = 0; _i < 2; ++_i) \
        __builtin_amdgcn_global_load_lds((const unsigned*)((const char*)(gbase) + ((voff)[_i] + ((voff)[_i] & (m2)))), (LAS unsigned*)(lds + (bufoff) + ldsw + _i * 8192), 16, 0, 0); } while (0)
#define PG8_LDA(dst, b, h) do { _Pragma("unroll") for (int m = 0; m < 4; ++m) _Pragma("unroll") for (int k = 0; k < 2; ++k) dst[m][k] = *(const LAS bf16x8*)(lds + PG8_SA(b, h) + aoff + m * 2048 + k * 1024); } while (0)
#define PG8_LDB(dst, b, h) do { _Pragma("unroll") for (int n = 0; n < 2; ++n) _Pragma("unroll") for (int k = 0; k < 2; ++k) dst[n][k] = *(const LAS bf16x8*)(lds + PG8_SB(b, h) + boff + n * 2048 + k * 1024); } while (0)
#define PG8_MMA(ai, bj, At, Bt) do { __builtin_amdgcn_s_setprio(1); _Pragma("unroll") for (int m = 0; m < 4; ++m) _Pragma("unroll") for (int n = 0; n < 2; ++n) _Pragma("unroll") for (int k = 0; k < 2; ++k) \
        acc[ai][bj][m][n] = __builtin_amdgcn_mfma_f32_16x16x32_bf16(Bt[n][k], At[m][k], acc[ai][bj][m][n], 0, 0, 0); __builtin_amdgcn_s_setprio(0); } while (0)
#define PG8_WAIT_V(n) asm volatile("s_waitcnt vmcnt(" #n ")" ::: "memory")
#define PG8_WAIT_L(n) asm volatile("s_waitcnt lgkmcnt(" #n ")" ::: "memory")
#define PG8_BAR __builtin_amdgcn_s_barrier()
#define PG8_SCHED __builtin_amdgcn_sched_barrier(0)
    Unit cur, nxt; int ui = 0;
    if (!S.next(0, cur)) return;
    f32x4 acc[2][2][4][2];
    if constexpr (F::ACC_INIT) E.init(acc, cur.pm, cur.pn, wr, wc, fr, fq); else {
#pragma unroll
    for (int a = 0; a < 2; ++a)
#pragma unroll
        for (int b = 0; b < 2; ++b)
#pragma unroll
            for (int m = 0; m < 4; ++m)
#pragma unroll
                for (int n = 0; n < 2; ++n) acc[a][b][m][n] = (f32x4){0.f, 0.f, 0.f, 0.f};
    }
    bf16x8 At[4][2], B0[2][2], B1[2][2];
    const char* cA = cur.A; const char* cB = cur.B;
    unsigned cm = (MIX && !cur.sm) ? ~1023u : 0u; size_t hA = MIX ? (cur.sm ? (size_t)131072 : (size_t)262144) : hA0, hB = MIX ? hA : hB0; int nt = MIX ? (cur.sm ? 8 : 16) : nt_;
    PG8_STAGE(PG8_SB(0, 0), cB, voffB, cm); PG8_STAGE(PG8_SA(0, 0), cA, voffA, cm); PG8_STAGE(PG8_SB(0, 1), cB + hB, voffB, cm); PG8_STAGE(PG8_SA(0, 1), cA + hA, voffA, cm);
    if (wr == 1) PG8_BAR;
    PG8_WAIT_V(4); PG8_BAR;
    PG8_STAGE(PG8_SB(1, 0), cB + kstep, voffB, cm); PG8_STAGE(PG8_SA(1, 0), cA + kstep, voffA, cm); PG8_STAGE(PG8_SB(1, 1), cB + hB + kstep, voffB, cm);
    PG8_WAIT_V(6); PG8_BAR;
    for (;;) {
        const bool has_next = S.next(ui + 1, nxt);
        const char* nA = has_next ? nxt.A : cA; const char* nB = has_next ? nxt.B : cB;
        const unsigned nm = (MIX && has_next) ? (nxt.sm ? 0u : ~1023u) : cm;
        const size_t nhA = (MIX && has_next) ? (nxt.sm ? (size_t)131072 : (size_t)262144) : hA, nhB = MIX ? nhA : hB;
#pragma unroll 1
        for (int t = 0; t < nt; t += 2) {
            const bool last = (t == nt - 2);
            const char* a1 = cA + (size_t)(t + 1) * kstep;
            const char* a2 = last ? nA : cA + (size_t)(t + 2) * kstep; const char* b2 = last ? nB : cB + (size_t)(t + 2) * kstep;
            const char* a3 = a2 + kstep; const char* b3 = b2 + kstep;
            const unsigned m2 = (MIX && last) ? nm : cm; const size_t h2A = (MIX && last) ? nhA : hA, h2B = (MIX && last) ? nhB : hB;
            PG8_LDB(B0, 0, 0); PG8_SCHED; PG8_LDA(At, 0, 0); PG8_STAGE(PG8_SA(1, 1), a1 + hA, voffA, cm);
            PG8_WAIT_L(8); PG8_BAR; PG8_WAIT_L(0); PG8_MMA(0, 0, At, B0); PG8_BAR; PG8_SCHED;
            PG8_LDB(B1, 0, 1); PG8_STAGE(PG8_SB(0, 0), b2, voffB, m2);
            PG8_BAR; PG8_WAIT_L(0); PG8_MMA(0, 1, At, B1); PG8_BAR;
            PG8_LDA(At, 0, 1); PG8_STAGE(PG8_SA(0, 0), a2, voffA, m2);
            PG8_BAR; PG8_WAIT_L(0); PG8_MMA(1, 0, At, B0); PG8_BAR; PG8_SCHED;
            PG8_STAGE(PG8_SB(0, 1), b2 + h2B, voffB, m2);
            PG8_WAIT_V(6); PG8_BAR; PG8_MMA(1, 1, At, B1); PG8_BAR;
            PG8_LDB(B0, 1, 0); PG8_SCHED; PG8_LDA(At, 1, 0); PG8_STAGE(PG8_SA(0, 1), a2 + h2A, voffA, m2);
            PG8_WAIT_L(8); PG8_BAR; PG8_WAIT_L(0); PG8_MMA(0, 0, At, B0); PG8_BAR; PG8_SCHED;
            PG8_LDB(B1, 1, 1); PG8_STAGE(PG8_SB(1, 0), b3, voffB, m2);
            PG8_BAR; PG8_WAIT_L(0); PG8_MMA(0, 1, At, B1); PG8_BAR;
            PG8_LDA(At, 1, 1); PG8_STAGE(PG8_SA(1, 0), a3, voffA, m2);
            PG8_BAR; PG8_WAIT_L(0); PG8_MMA(1, 0, At, B0); PG8_BAR; PG8_SCHED;
            PG8_STAGE(PG8_SB(1, 1), b3 + h2B, voffB, m2);
            PG8_WAIT_V(6); PG8_BAR; PG8_MMA(1, 1, At, B1); PG8_BAR;
        }
        {
            int row0 = cur.pm * BM + wr * 64 + fr; asm volatile("" : "+v"(row0));
            const typename F::UCtx uc = E.unit_ctx(cur.pn, wc, fq, cur.g);
            typename F::Pre pre = E.row_pre(row0, fq, cur.pn, wc, cur.g);
#pragma unroll
            for (int rg = 0; rg < 8; ++rg) { const int ai = rg >> 2, m = rg & 3;
                int row = cur.pm * BM + ai * HALF + wr * 64 + m * 16 + fr;
                asm volatile("" : "+v"(row));
                typename F::Pre pre_n = pre;
                if (rg < 7) { int rown = cur.pm * BM + ((rg + 1) >> 2) * HALF + wr * 64 + ((rg + 1) & 3) * 16 + fr; asm volatile("" : "+v"(rown)); pre_n = E.row_pre(rown, fq, cur.pn, wc, cur.g); }
                asm volatile("" ::: "memory");
                typename F::State st; E.row_begin(st, pre); PkSt ps;
#pragma unroll
                for (int n = 0; n < 2; ++n) { E.op(st, ps, uc, row, cur.pn, cur.g, wc * 32 + 8 * fq + 4 * n, n, acc[ai][0][m][n], acc[ai][1][m][n]); }
                E.row_end(st, row, cur.pn, wc);
                pre = pre_n;
            }
        }
        if (!has_next) break;
        if constexpr (F::ACC_INIT) E.init(acc, nxt.pm, nxt.pn, wr, wc, fr, fq); else if (!MIX || cur.fin) {
#pragma unroll
        for (int a = 0; a < 2; ++a)
#pragma unroll
            for (int b = 0; b < 2; ++b)
#pragma unroll
                for (int m = 0; m < 4; ++m)
#pragma unroll
                    for (int n = 0; n < 2; ++n) acc[a][b][m][n] = (f32x4){0.f, 0.f, 0.f, 0.f};
        }
        cur = nxt; cA = nA; cB = nB; ++ui;
        if (MIX) { cm = nm; hA = nhA; hB = nhB; nt = cur.sm ? 8 : 16; }
    }
    PG8_WAIT_V(0);
    if (wr == 0) PG8_BAR;
    PG8_BAR;
#undef PG8_SA
#undef PG8_SB
#undef PG8_STAGE
#undef PG8_LDA
#undef PG8_LDB
#undef PG8_MMA
#undef PG8_WAIT_V
#undef PG8_WAIT_L
#undef PG8_BAR
#undef PG8_SCHED
}

template <class F>
__device__ __forceinline__ void gemm_phase(LAS unsigned char* lds, const int lda, const int ldb, const int nt, const Sched& S, const F& E) { gemm_phase_t<F, Sched, false>(lds, lda, ldb, nt, S, E); }

template <class F>
__device__ __forceinline__ void thin_gemm(LAS unsigned char* lds, const bf16_t* A, const int lda, const bf16_t* Bt, const int ldb, const int K, const int nN, const int bd, const F& E, const int bi, const int nb) {
    const int tid = otid(), wid = tid >> 6, lane = tid & 63, fr = lane & 15, fq = lane >> 4;
    LAS f32x4* red = (LAS f32x4*)lds;
    const int nitems = 8 * nN * 4, kw = K >> 3;
    if (bi >= 0) for (int item = bi; item < nitems; item += nb) {
        const int rg = item & 7, wc = (item >> 3) & 3, pn = item >> 5;
        const bf16_t* ap = A + (size_t)(MP + 16 * rg + fr) * lda + (bd ? (pn >> 1) * 256 : 0) + wid * kw + 8 * fq;
        const bf16_t* bp[4];
#pragma unroll
        for (int n = 0; n < 4; ++n) bp[n] = Bt + (size_t)(256 * pn + 128 * (n >> 1) + 32 * wc + 8 * (fr >> 2) + 4 * (n & 1) + (fr & 3)) * ldb + wid * kw + 8 * fq;
        f32x4 acc[4];
#pragma unroll
        for (int n = 0; n < 4; ++n) acc[n] = (f32x4){0.f, 0.f, 0.f, 0.f};
        for (int kb = 0; kb < kw; kb += 128) {
            bf16x8 av[4], bv[4][4];
#pragma unroll
            for (int i = 0; i < 4; ++i) if (kb + 32 * i < kw) { av[i] = *(const bf16x8*)(ap + kb + 32 * i);
#pragma unroll
                for (int n = 0; n < 4; ++n) bv[i][n] = *(const bf16x8*)(bp[n] + kb + 32 * i); }
#pragma unroll
            for (int i = 0; i < 4; ++i) if (kb + 32 * i < kw) {
#pragma unroll
                for (int n = 0; n < 4; ++n) acc[n] = __builtin_amdgcn_mfma_f32_16x16x32_bf16(bv[i][n], av[i], acc[n], 0, 0, 0); }
        }
#pragma unroll
        for (int n = 0; n < 4; ++n) red[(wid * 4 + n) * 64 + lane] = acc[n];
        __syncthreads();
        if (wid == 0) {
            f32x4 sv[4];
#pragma unroll
            for (int n = 0; n < 4; ++n) { f32x4 s = red[n * 64 + lane];
#pragma unroll
                for (int w = 1; w < 8; ++w) s += red[(w * 4 + n) * 64 + lane];
                sv[n] = s; }
            const int row = MP + 16 * rg + fr; typename F::State st; E.row_begin(st, E.row_pre(row, fq, pn, wc, 0));
            const typename F::UCtx uc = E.unit_ctx(pn, wc, fq, 0);
            PkSt ps;
#pragma unroll
            for (int n = 0; n < 2; ++n) E.op(st, ps, uc, row, pn, 0, wc * 32 + 8 * fq + 4 * n, n, sv[n], sv[2 + n]);
            E.row_end(st, row, pn, wc);
        }
        __syncthreads();
    }
}

__device__ __forceinline__ void thin_merge(LAS unsigned char* lds, const bf16_t* YA, const bf16_t* YB, const bf16_t* YC, const bf16_t* WPA, const bf16_t* WPB, const bf16_t* WPC,
                                           const unsigned char* g8, bf16_t* mrg, const int bi, const int nb) {
    const int tid = otid(), wid = tid >> 6, lane = tid & 63, fr = lane & 15, fq = lane >> 4;
    LAS f32x4* red = (LAS f32x4*)lds;
    for (int item = bi; item < 8 * 4 * 4; item += nb) {
        const int rg = item & 7, wc = (item >> 3) & 3, pn = item >> 5, row = MP + 16 * rg + fr;
        int brow[4];
#pragma unroll
        for (int n = 0; n < 4; ++n) brow[n] = 256 * pn + 128 * (n >> 1) + 32 * wc + 8 * (fr >> 2) + 4 * (n & 1) + (fr & 3);
        f32x4 tot[4];
#pragma unroll
        for (int n = 0; n < 4; ++n) tot[n] = (f32x4){0.f, 0.f, 0.f, 0.f};
#pragma unroll
        for (int seg = 0; seg < 3; ++seg) {
            const bf16_t* A = seg == 0 ? YA : (seg == 1 ? YB : YC); const bf16_t* B = seg == 0 ? WPA : (seg == 1 ? WPB : WPC);
            const int K = seg == 0 ? 1024 : 512, kw = K >> 3, nst = kw >> 5;
            bf16x8 av[4], bv[4][4]; unsigned gw[4];
#pragma unroll
            for (int i = 0; i < 4; ++i) if (i < nst) { av[i] = *(const bf16x8*)(A + (size_t)row * K + wid * kw + 32 * i + 8 * fq);
#pragma unroll
                for (int n = 0; n < 4; ++n) bv[i][n] = *(const bf16x8*)(B + (size_t)brow[n] * K + wid * kw + 32 * i + 8 * fq); }
#pragma unroll
            for (int n = 0; n < 4; ++n) gw[n] = *(const unsigned*)(g8 + g8row(row) + seg * 1024 + 256 * pn + 128 * (n >> 1) + 32 * wc + 8 * fq + 4 * (n & 1));
            f32x4 acc[4];
#pragma unroll
            for (int n = 0; n < 4; ++n) acc[n] = (f32x4){0.f, 0.f, 0.f, 0.f};
#pragma unroll
            for (int i = 0; i < 4; ++i) if (i < nst) {
#pragma unroll
                for (int n = 0; n < 4; ++n) acc[n] = __builtin_amdgcn_mfma_f32_16x16x32_bf16(bv[i][n], av[i], acc[n], 0, 0, 0); }
#pragma unroll
            for (int n = 0; n < 4; ++n) tot[n] += acc[n] * ((f32x4){(float)(gw[n] & 255u), (float)((gw[n] >> 8) & 255u), (float)((gw[n] >> 16) & 255u), (float)(gw[n] >> 24)} * (1.0f / 255.0f));
        }
#pragma unroll
        for (int n = 0; n < 4; ++n) red[(wid * 4 + n) * 64 + lane] = tot[n];
        __syncthreads();
        if (wid == 0) {
#pragma unroll
            for (int n = 0; n < 4; ++n) { f32x4 sv = red[n * 64 + lane];
#pragma unroll
                for (int w = 1; w < 8; ++w) sv += red[(w * 4 + n) * 64 + lane];
                store4(mrg + (size_t)row * 1024 + 256 * pn + 128 * (n >> 1) + 32 * wc + 8 * fq + 4 * (n & 1), sv); }
        }
        __syncthreads();
    }
}

__device__ __forceinline__ f32x4 load4(const bf16_t* p) { const u32x2 w = *(const u32x2*)p; return (f32x4){__uint_as_float(w.x << 16), __uint_as_float(w.x & 0xffff0000u), __uint_as_float(w.y << 16), __uint_as_float(w.y & 0xffff0000u)}; }
__device__ __forceinline__ f32x4 sigm4(const f32x4 x) { return (f32x4){sigm(x[0]), sigm(x[1]), sigm(x[2]), sigm(x[3])}; }
__device__ __forceinline__ float row_rs4(const float* rsq, int row, int fq) {
    const f32x4 a = *(const f32x4*)(rsq + (size_t)row * 16 + fq * 4); float s = (a[0] + a[1]) + (a[2] + a[3]);
    s += __shfl_xor(s, 16); s += __shfl_xor(s, 32); return rsqrtf(s * (1.0f / 1024.0f) + EPS);
}
__device__ __forceinline__ float sum_fq4(float s) {
    { auto r = __builtin_amdgcn_permlane16_swap(__float_as_uint(s), __float_as_uint(s), false, false); s = __uint_as_float(r[0]) + __uint_as_float(r[1]); }
    { auto r = __builtin_amdgcn_permlane32_swap(__float_as_uint(s), __float_as_uint(s), false, false); s = __uint_as_float(r[0]) + __uint_as_float(r[1]); }
    return s;
}
__device__ __forceinline__ float rs_from4(const f32x4 a) { const float s = sum_fq4((a[0] + a[1]) + (a[2] + a[3])); return rsqrtf(s * (1.0f / 1024.0f) + EPS); }
__device__ __forceinline__ float row_rs(const float* rsq, int row) {
    const f32x4* p = (const f32x4*)(rsq + (size_t)row * 16); const f32x4 a = p[0], b = p[1], c = p[2], d = p[3];
    const float s = ((a[0] + a[1]) + (a[2] + a[3])) + ((b[0] + b[1]) + (b[2] + b[3])) + ((c[0] + c[1]) + (c[2] + c[3])) + ((d[0] + d[1]) + (d[2] + d[3]));
    return rsqrtf(s * (1.0f / 1024.0f) + EPS);
}
struct StNone { };
struct StF { float x; };
struct F1 {
    typedef StF State;
    static constexpr bool ACC_INIT = false;
    typedef StNone UCtx;
    __device__ __forceinline__ UCtx unit_ctx(int, int, int, int) const { return UCtx(); }
    const float* rsq; bf16_t* ua; bf16_t* glu; bf16_t* ucg; bf16_t* ucs;
    typedef f32x4 Pre;
    __device__ __forceinline__ Pre row_pre(int row, int fq, int, int, int) const { return *(const f32x4*)(rsq + (size_t)row * 16 + fq * 4); }
    __device__ __forceinline__ void row_begin(State& st, const Pre& p) const { st.x = rs_from4(p); }
    __device__ __forceinline__ void row_end(State&, int, int, int) const {}
    __device__ __forceinline__ void op(State& st, PkSt& ps, const UCtx& uc, int row, int pn, int, int lc, const int n, f32x4& a, f32x4& b) const {
        if (row >= MT) return;
        const f32x4 va = a * st.x, vb = b * st.x;
        if (pn < 4) { bf16_t* p = ua + (size_t)row * 1024 + pn * 256 + lc; wstore<0>(ps, n, p, va); wstore<1>(ps, n, p + 128, vb); }
        else if (pn < 8) wstore<0>(ps, n, glu + (size_t)row * 512 + (pn - 4) * 128 + lc, va * sigm4(vb));
        else {
#pragma unroll
            for (int h = 0; h < 2; ++h) { const int cc = (pn - 8) * 256 + lc + 128 * h; bf16_t* dst;
                if (row < MP) dst = ucg + ((size_t)(cc >> 4) * NCHK + (row >> 4)) * KS5 + (row & 15) * 16 + (cc & 15);
                else dst = ucs + (size_t)(row - MP) * 512 + cc;
                if (h) wstore<1>(ps, n, dst, vb); else wstore<0>(ps, n, dst, va); }
        }
    }
};
struct StU4 { u32x4 v; };
struct F2 {
    typedef StU4 State; typedef StU4 Pre;
    static constexpr bool ACC_INIT = false;
    struct UCtx { f32x4 brg[2], big[2], lm[2]; };
    __device__ __forceinline__ UCtx unit_ctx(int pn, int wc, int fq, int) const { UCtx u; const int ch = pn * 128 + wc * 32 + 8 * fq;
#pragma unroll
        for (int n = 0; n < 2; ++n) { u.brg[n] = *(const f32x4*)(b_rg + ch + 4 * n); u.big[n] = *(const f32x4*)(b_ig + ch + 4 * n); u.lm[n] = *(const f32x4*)(lam + ch + 4 * n); }
        return u; }
    const bf16_t* ca; const float* b_rg; const float* b_ig; const float* lam; const float* h0; bf16_t* la; bf16_t* bx; float* out_h;
    __device__ __forceinline__ Pre row_pre(int row, int fq, int pn, int wc, int) const { Pre p; p.v = *(const u32x4*)(ca + (size_t)row * 1024 + pn * 128 + wc * 32 + 8 * fq); return p; }
    __device__ __forceinline__ void row_begin(State& st, const Pre& p) const { st = p; }
    __device__ __forceinline__ void row_end(State&, int, int, int) const {}
    __device__ __forceinline__ void op(State& st, PkSt& ps, const UCtx& uc, int row, int pn, int, int lc, const int n, f32x4& a, f32x4& b) const {
        const int ch0 = pn * 128 + lc; const unsigned w0 = n ? st.v.z : st.v.x, w1 = n ? st.v.w : st.v.y;
        const f32x4 c4 = (f32x4){__uint_as_float(w0 << 16), __uint_as_float(w0 & 0xffff0000u), __uint_as_float(w1 << 16), __uint_as_float(w1 & 0xffff0000u)};
        const f32x4 r = sigm4(a + uc.brg[n]), ig = sigm4(b + uc.big[n]), l_a = r * uc.lm[n];
        f32x4 bxv;
#pragma unroll
        for (int j = 0; j < 4; ++j) bxv[j] = __builtin_amdgcn_sqrtf(fmaxf(1.0f - __expf(2.0f * l_a[j]), 0.f)) * ig[j] * c4[j];
        if (row < MP) { wstore<0>(ps, n, la + (size_t)row * 1024 + ch0, l_a); wstore<1>(ps, n, bx + (size_t)row * 1024 + ch0, bxv); }
        else { const size_t o = (size_t)(row - MP) * 1024 + ch0; const f32x4 hp = *(const f32x4*)(h0 + o); f32x4 h;
#pragma unroll
            for (int j = 0; j < 4; ++j) h[j] = __expf(l_a[j]) * hp[j] + bxv[j];
            *(f32x4*)(out_h + o) = h; wstore<0>(ps, n, la + (size_t)row * 1024 + ch0, h); }
    }
};
struct FEnd {
    typedef StNone State;
    static constexpr bool ACC_INIT = false;
    typedef StNone UCtx;
    __device__ __forceinline__ UCtx unit_ctx(int, int, int, int) const { return UCtx(); }
    float* ends;
    typedef StNone Pre;
    __device__ __forceinline__ Pre row_pre(int, int, int, int, int) const { return Pre(); }
    __device__ __forceinline__ void row_begin(State&, const Pre&) const {}
    __device__ __forceinline__ void row_end(State&, int, int, int) const {}
    __device__ __forceinline__ void op(State&, PkSt& ps, const UCtx& uc, int row, int, int g, int lc, const int n, f32x4& a, f32x4&) const { *(f32x4*)(ends + ((size_t)g * NCHK + row) * 128 + lc) = a; }
};
__device__ __forceinline__ float gelu_tanh(float x) { const float u = 0.7978845608028654f * (x + 0.044715f * x * x * x); return x * sigm(2.0f * u); }
struct StU8 { u32x2 v[4]; };
struct FS5 {
    typedef StU8 State; typedef StU8 Pre;
    static constexpr bool ACC_INIT = false;
    struct UCtx { f32x4 d[2]; };
    __device__ __forceinline__ UCtx unit_ctx(int, int, int fq, int g) const { UCtx u; u.d[0] = *(const f32x4*)(dsk + g * 16 + ((8 * fq) & 15)); u.d[1] = *(const f32x4*)(dsk + g * 16 + ((8 * fq + 4) & 15)); return u; }
    const bf16_t* ucg; const float* dsk; bf16_t* yc0;
    __device__ __forceinline__ Pre row_pre(int row, int fq, int, int wc, int g) const { Pre p; const bf16_t* base = ucg + ((size_t)g * NCHK + row) * KS5 + wc * 32 + 8 * fq;
#pragma unroll
        for (int h = 0; h < 2; ++h) { const u32x4 q = *(const u32x4*)(base + 128 * h); p.v[h] = (u32x2){q.x, q.y}; p.v[2 + h] = (u32x2){q.z, q.w}; }
        return p; }
    __device__ __forceinline__ void row_begin(State& st, const Pre& p) const { st = p; }
    __device__ __forceinline__ void row_end(State&, int, int, int) const {}
    __device__ __forceinline__ void op(State& st, PkSt& ps, const UCtx& uc, int row, int, int g, int lc, const int n, f32x4& a, f32x4& b) const {
#pragma unroll
        for (int h = 0; h < 2; ++h) { const int col = lc + 128 * h, i = col >> 4, c0 = col & 15; const u32x2 w = st.v[n * 2 + h];
            const f32x4 u4 = (f32x4){__uint_as_float(w.x << 16), __uint_as_float(w.x & 0xffff0000u), __uint_as_float(w.y << 16), __uint_as_float(w.y & 0xffff0000u)};
            const f32x4 y = (h ? b : a) + uc.d[n] * u4;
            const f32x4 gy = (f32x4){gelu_tanh(y[0]), gelu_tanh(y[1]), gelu_tanh(y[2]), gelu_tanh(y[3])}; bf16_t* dp = yc0 + (size_t)(row * 16 + i) * 512 + g * 16 + c0;
            if (h) wstore<1>(ps, n, dp, gy); else wstore<0>(ps, n, dp, gy); }
    }
};
struct F4 {
    typedef StU8 State; typedef StU8 Pre;
    static constexpr bool ACC_INIT = false;
    struct UCtx { f32x4 b[2][2]; };
    __device__ __forceinline__ UCtx unit_ctx(int pn, int wc, int fq, int) const { UCtx u; const float* p = bg + pn * 256 + wc * 32 + 8 * fq;
#pragma unroll
        for (int n = 0; n < 2; ++n)
#pragma unroll
            for (int h = 0; h < 2; ++h) u.b[n][h] = *(const f32x4*)(p + 128 * h + 4 * n);
        return u; }
    const bf16_t* yc0; const float* bg; bf16_t* yc;
    __device__ __forceinline__ Pre row_pre(int row, int fq, int pn, int wc, int) const { Pre p; const bf16_t* base = yc0 + (size_t)row * 512 + pn * 256 + wc * 32 + 8 * fq;
#pragma unroll
        for (int h = 0; h < 2; ++h) { const u32x4 q = *(const u32x4*)(base + 128 * h); p.v[h] = (u32x2){q.x, q.y}; p.v[2 + h] = (u32x2){q.z, q.w}; }
        return p; }
    __device__ __forceinline__ void row_begin(State& st, const Pre& p) const { st = p; }
    __device__ __forceinline__ void row_end(State&, int, int, int) const {}
    __device__ __forceinline__ void op(State& st, PkSt& ps, const UCtx& uc, int row, int pn, int, int lc, const int n, f32x4& a, f32x4& b) const {
#pragma unroll
        for (int h = 0; h < 2; ++h) { const int col = pn * 256 + lc + 128 * h; const u32x2 w = st.v[n * 2 + h];
            const f32x4 y4 = (f32x4){__uint_as_float(w.x << 16), __uint_as_float(w.x & 0xffff0000u), __uint_as_float(w.y << 16), __uint_as_float(w.y & 0xffff0000u)};
            const f32x4 yo = y4 * sigm4((h ? b : a) + uc.b[n][h]); if (h) wstore<1>(ps, n, yc + (size_t)row * 512 + col, yo); else wstore<0>(ps, n, yc + (size_t)row * 512 + col, yo); }
    }
};
struct FG8 {
    typedef StF State;
    static constexpr bool ACC_INIT = false;
    struct UCtx { f32x4 b[2][2]; };
    __device__ __forceinline__ UCtx unit_ctx(int pn, int wc, int fq, int) const { UCtx u; const float* p = bgate + pn * 256 + wc * 32 + 8 * fq;
#pragma unroll
        for (int n = 0; n < 2; ++n)
#pragma unroll
            for (int h = 0; h < 2; ++h) u.b[n][h] = *(const f32x4*)(p + 128 * h + 4 * n);
        return u; }
    const float* rsq; const float* bgate; unsigned char* g8;
    typedef f32x4 Pre;
    __device__ __forceinline__ Pre row_pre(int row, int fq, int, int, int) const { return *(const f32x4*)(rsq + (size_t)row * 16 + fq * 4); }
    __device__ __forceinline__ void row_begin(State& st, const Pre& p) const { st.x = rs_from4(p); }
    __device__ __forceinline__ void row_end(State&, int, int, int) const {}
    __device__ __forceinline__ void op(State& st, PkSt& ps, const UCtx& uc, int row, int pn, int, int lc, const int n, f32x4& a, f32x4& b) const {
#pragma unroll
        for (int h = 0; h < 2; ++h) { const int col = pn * 256 + lc + 128 * h; f32x4 g = sigm4((h ? b : a) * st.x + uc.b[(lc >> 2) & 1][h]) * 255.0f + 0.5f; g = __builtin_elementwise_max(g, (f32x4){1.f, 1.f, 1.f, 1.f});
            const unsigned gw = (unsigned)g[0] | ((unsigned)g[1] << 8) | ((unsigned)g[2] << 16) | ((unsigned)g[3] << 24);
            if (n == 0) ps.pk[h].x = gw; else *(u32x2*)(g8 + g8row(row) + col - 4) = (u32x2){ps.pk[h].x, gw}; }
    }
};
struct StG { unsigned w[8]; };
struct FMS {
    typedef StG State; typedef StG Pre;
    static constexpr bool ACC_INIT = false;
    typedef StNone UCtx;
    __device__ __forceinline__ UCtx unit_ctx(int, int, int, int) const { return UCtx(); }
    const unsigned char* g8; bf16_t* mrg;
    __device__ __forceinline__ Pre row_pre(int row, int fq, int pn, int wc, int seg) const { Pre p; const unsigned char* base = g8 + g8row(row) + seg * 1024 + pn * 256 + wc * 32 + 8 * fq;
#pragma unroll
        for (int h = 0; h < 2; ++h) { const u32x2 gnum = *(const u32x2*)(base + 128 * h); u32x2 gden = (u32x2){0x01010101u, 0x01010101u}; if (seg < 2) gden = *(const u32x2*)(base + 1024 + 128 * h);
            p.w[(0 * 2 + h) * 2] = gnum.x; p.w[(1 * 2 + h) * 2] = gnum.y; p.w[(0 * 2 + h) * 2 + 1] = gden.x; p.w[(1 * 2 + h) * 2 + 1] = gden.y; }
        return p; }
    __device__ __forceinline__ void row_begin(State& st, const Pre& p) const { st = p; }
    __device__ __forceinline__ void row_end(State&, int, int, int) const {}
    __device__ __forceinline__ void op(State& st, PkSt& ps, const UCtx& uc, int row, int pn, int seg, int lc, const int n, f32x4& a, f32x4& b) const {
#pragma unroll
        for (int h = 0; h < 2; ++h) { const unsigned gn = st.w[(n * 2 + h) * 2], gd = st.w[(n * 2 + h) * 2 + 1]; f32x4& v = h ? b : a;
            const f32x4 num = (f32x4){(float)(gn & 255u), (float)((gn >> 8) & 255u), (float)((gn >> 16) & 255u), (float)(gn >> 24)};
            if (seg < 2) { const f32x4 den = (f32x4){(float)(gd & 255u), (float)((gd >> 8) & 255u), (float)((gd >> 16) & 255u), (float)(gd >> 24)};
                v = v * num * (f32x4){__builtin_amdgcn_rcpf(den[0]), __builtin_amdgcn_rcpf(den[1]), __builtin_amdgcn_rcpf(den[2]), __builtin_amdgcn_rcpf(den[3])}; }
            else { const f32x4 mo = v * num * (1.0f / 255.0f); bf16_t* dp = mrg + (size_t)row * 1024 + pn * 256 + lc + 128 * h; if (h) wstore<1>(ps, n, dp, mo); else wstore<0>(ps, n, dp, mo); } }
    }
};
template <bool RES> struct F6T {
    typedef StF State;
    static constexpr bool ACC_INIT = !RES;
    typedef StNone UCtx;
    __device__ __forceinline__ UCtx unit_ctx(int, int, int, int) const { return UCtx(); }
    const float* xs_p; const float* xs_s; float* xd; bf16_t* xb; float* rsq;
    typedef StNone Pre;
    __device__ __forceinline__ Pre row_pre(int, int, int, int, int) const { return Pre(); }
    __device__ __forceinline__ void row_begin(State& st, const Pre&) const { st.x = 0.f; }
    __device__ __forceinline__ void row_end(State& st, int row, int pn, int wc) const {
        const float ss = sum_fq4(st.x);
        if ((__lane_id()) < 16) rsq[(size_t)row * 16 + pn * 4 + wc] = ss; }
    __device__ __forceinline__ void init(f32x4 (&acc)[2][2][4][2], int pm, int pn, int wr, int wc, int fr, int fq) const {
#pragma unroll
        for (int ai = 0; ai < 2; ++ai)
#pragma unroll
            for (int m = 0; m < 4; ++m) { const int row = pm * BM + ai * HALF + wr * 64 + m * 16 + fr;
                const float* src = ((row < MP) ? xs_p + (size_t)row * 1024 : xs_s + (size_t)(row - MP) * 1024) + pn * 256 + wc * 32 + 8 * fq;
#pragma unroll
                for (int bj = 0; bj < 2; ++bj)
#pragma unroll
                    for (int n = 0; n < 2; ++n) acc[ai][bj][m][n] = *(const f32x4*)(src + 128 * bj + 4 * n); }
    }
    __device__ __forceinline__ void op(State& st, PkSt& ps, const UCtx& uc, int row, int pn, int, int lc, const int n, f32x4& a, f32x4& b) const {
        const float* src = (row < MP) ? xs_p + (size_t)row * 1024 : xs_s + (size_t)(row - MP) * 1024;
#pragma unroll
        for (int h = 0; h < 2; ++h) { const int col = pn * 256 + lc + 128 * h; f32x4 v = (h ? b : a); if (RES) v += *(const f32x4*)(src + col);
            st.x += (v[0] * v[0] + v[1] * v[1]) + (v[2] * v[2] + v[3] * v[3]);
            *(f32x4*)(xd + (size_t)row * 1024 + col) = v; if (h) wstore<1>(ps, n, xb + (size_t)row * 1024 + col, v); else wstore<0>(ps, n, xb + (size_t)row * 1024 + col, v); }
    }
};
struct F7 {
    typedef StF State;
    static constexpr bool ACC_INIT = false;
    typedef StNone UCtx;
    __device__ __forceinline__ UCtx unit_ctx(int, int, int, int) const { return UCtx(); }
    const float* rsq; bf16_t* act;
    typedef f32x4 Pre;
    __device__ __forceinline__ Pre row_pre(int row, int fq, int, int, int) const { return *(const f32x4*)(rsq + (size_t)row * 16 + fq * 4); }
    __device__ __forceinline__ void row_begin(State& st, const Pre& p) const { st.x = rs_from4(p); }
    __device__ __forceinline__ void row_end(State&, int, int, int) const {}
    __device__ __forceinline__ void op(State& st, PkSt& ps, const UCtx& uc, int row, int pn, int, int lc, const int n, f32x4& a, f32x4& b) const {
        if (row >= MT) return;
        const f32x4 gte = a * st.x, up = b * st.x; wstore<0>(ps, n, act + (size_t)row * DFF + pn * 128 + lc, gte * sigm4(gte) * up);
    }
};

template <int MODE> __device__ __forceinline__ int srccol(int n) {
    if (MODE == 1) { if (n >= 1024 && n < 2048) { const int q = (n - 1024) >> 8, r = (n - 1024) & 255; return r < 128 ? 1024 + 128 * q + r : 1536 + 128 * q + (r - 128); } return n; }
    if (MODE == 2) { const int t = n >> 8, r = n & 255; return r < 128 ? 128 * t + r : DFF + 128 * t + (r - 128); }
    return n;
}
template <int MODE>
__device__ __forceinline__ int conv_T(LAS float* tile, const float* src, int ldsrc, const float* scale, bf16_t* dst, int ldd, int N, int K, int nb, int bi, int base) {
    const int tid = otid(), ntn = N >> 8, ntiles = ntn * (K >> 6);
    int t = bi - (base % nb); if (t < 0) t += nb;
    const int q = tid & 63, kr = tid >> 6; f32x4 v[8]; float sc8[8];
#define CT_LOAD(tt) do { const int n0_ = ((tt) % ntn) << 8, k0_ = ((tt) / ntn) << 6, sc_ = srccol<MODE>(n0_ + 4 * q); \
        _Pragma("unroll") for (int i = 0; i < 8; ++i) { v[i] = *(const f32x4*)(src + (size_t)(k0_ + i * 8 + kr) * ldsrc + sc_); sc8[i] = scale ? scale[k0_ + i * 8 + kr] : 1.0f; } } while (0)
    if (t < ntiles) CT_LOAD(t);
    for (; t < ntiles; t += nb) {
        const int n0 = (t % ntn) << 8, k0 = (t / ntn) << 6;
#pragma unroll
        for (int i = 0; i < 8; ++i) *(LAS f32x4*)(tile + (i * 8 + kr) * 260 + 4 * q) = v[i] * sc8[i];
        __syncthreads();
        if (t + nb < ntiles) CT_LOAD(t + nb);
        { const int n = tid >> 1, kh = tid & 1;
#pragma unroll
          for (int j4 = 0; j4 < 4; ++j4) { float w[8];
#pragma unroll
              for (int j = 0; j < 8; ++j) w[j] = tile[(kh * 32 + j4 * 8 + j) * 260 + n];
              store8(dst + (size_t)(n0 + n) * ldd + k0 + kh * 32 + j4 * 8, w); } }
        __syncthreads();
    }
#undef CT_LOAD
    return base + ntiles;
}

__device__ __forceinline__ void s5_build(KArgsP a, int l, int g, LAS unsigned char* lds, const int part, const int nparts) {
    const int tid = otid();
    LAS float* apr = (LAS float*)lds; LAS float* api = apr + 17 * 64; LAS float* bbr = api + 17 * 64; LAS float* bbi = bbr + 1024;
    LAS float* ccr = bbi + 1024; LAS float* cci = ccr + 1024; LAS float* kk = cci + 1024;
    const float* lam_re = a->in[20] + (size_t)(l * 32 + g) * 64; const float* lam_im = a->in[21] + (size_t)(l * 32 + g) * 64;
    const float dt = expf(a->in[22][l * 32 + g]);
    bf16_t* TF = (bf16_t*)(a->ws + OFF_TF); bf16_t* ET = (bf16_t*)(a->ws + OFF_ET); float* TAB = (float*)(a->ws + OFF_TAB);
    for (int idx = tid; idx < 17 * 64; idx += 512) { const int d = idx >> 6, p = idx & 63; const float lr = lam_re[p], li = lam_im[p];
        const float mag = expf((float)d * lr * dt);
        double x = (double)d * (double)li * (double)dt; x -= 6.283185307179586 * rint(x * 0.15915494309189535); const float xr = (float)x;
        apr[idx] = mag * cosf(xr); api[idx] = mag * sinf(xr); }
    __syncthreads();
    for (int idx = tid; idx < 1024; idx += 512) { const int p = idx >> 4; const float lr = lam_re[p], li = lam_im[p], ar = apr[64 + p], ai = api[64 + p], den = lr * lr + li * li;
        const float qr = ((ar - 1.0f) * lr + ai * li) / den, qi = (ai * lr - (ar - 1.0f) * li) / den;
        const float br = a->in[23][(size_t)(l * 32 + g) * 1024 + idx], bi = a->in[24][(size_t)(l * 32 + g) * 1024 + idx];
        bbr[idx] = qr * br - qi * bi; bbi[idx] = qr * bi + qi * br;
        ccr[idx] = a->in[25][(size_t)(l * 32 + g) * 1024 + idx]; cci[idx] = a->in[26][(size_t)(l * 32 + g) * 1024 + idx]; }
    __syncthreads();
    if (part == 0 && tid < 64) { TAB[(g * 64 + tid) * 2] = apr[64 + tid]; TAB[(g * 64 + tid) * 2 + 1] = api[64 + tid]; TAB[4096 + (g * 64 + tid) * 2] = apr[16 * 64 + tid]; TAB[4096 + (g * 64 + tid) * 2 + 1] = api[16 * 64 + tid]; }
    if (part == 0) for (int idx = tid; idx < 1024; idx += 512) { TAB[8192 + ((size_t)g * 1024 + idx) * 2] = bbr[idx]; TAB[8192 + ((size_t)g * 1024 + idx) * 2 + 1] = bbi[idx]; }
    for (int idx = tid; idx < 4096; idx += 512) { const int d = idx >> 8, c = (idx >> 4) & 15, c2 = idx & 15; float s = 0.f;
        for (int p = 0; p < 64; ++p) { const float Pr = apr[d * 64 + p], Pi = api[d * 64 + p], Br = bbr[p * 16 + c2], Bi = bbi[p * 16 + c2];
            const float Wr = Pr * Br - Pi * Bi, Wi = Pr * Bi + Pi * Br; s += ccr[c * 64 + p] * Wr - cci[c * 64 + p] * Wi; }
        kk[idx] = s; }
    __syncthreads();
    const int tfn = 256 / nparts, etn = 128 / nparts;
    for (int idx = part * tfn * KS5 + tid; idx < (part + 1) * tfn * KS5; idx += 512) { const int n = idx / KS5, k = idx % KS5, i = n >> 4, c = n & 15; float v;
        if (k < 256) { const int j = k >> 4, c2 = k & 15; v = (i >= j) ? kk[(i - j) * 256 + c * 16 + c2] : 0.f; }
        else if (k < 320) { const int p = k - 256; v = ccr[c * 64 + p] * apr[(i + 1) * 64 + p] - cci[c * 64 + p] * api[(i + 1) * 64 + p]; }
        else { const int p = k - 320; v = -(ccr[c * 64 + p] * api[(i + 1) * 64 + p] + cci[c * 64 + p] * apr[(i + 1) * 64 + p]); }
        TF[((size_t)g * 256 + n) * KS5 + k] = f2bf(v); }
    for (int idx = part * etn * 256 + tid; idx < (part + 1) * etn * 256; idx += 512) { const int n = idx >> 8, k = idx & 255, p = n & 63, j = k >> 4, c2 = k & 15, d = 15 - j;
        const float Pr = apr[d * 64 + p], Pi = api[d * 64 + p], Br = bbr[p * 16 + c2], Bi = bbi[p * 16 + c2];
        ET[((size_t)g * 128 + n) * 256 + k] = f2bf(n < 64 ? (Pr * Br - Pi * Bi) : (Pr * Bi + Pi * Br)); }
    if (g == 31 && part == 0) for (int idx = tid; idx < 128 * 256; idx += 512) ET[(size_t)32 * 128 * 256 + idx] = 0;
    __syncthreads();
}

__device__ __forceinline__ void phase0(KArgsP a, int l, LAS unsigned char* lds) {
    const int tid = otid(), blk = blockIdx.x, nblk = gridDim.x;
    LAS float* tile = (LAS float*)lds; unsigned char* ws = a->ws;
    const int nsb = (nblk >= 256) ? 128 : 0, nb = nblk - nsb;
    if (blk < nb) { int base = 0;
        base = conv_T<1>(tile, a->in[8] + (size_t)l * 1024 * INW, INW, a->in[7] + l * 1024, (bf16_t*)(ws + OFF_WIN), 1024, INW, 1024, nb, blk, base);
        base = conv_T<2>(tile, a->in[36] + (size_t)l * 1024 * INW, INW, a->in[35] + l * 1024, (bf16_t*)(ws + OFF_WF1), 1024, INW, 1024, nb, blk, base);
        base = conv_T<0>(tile, a->in[37] + (size_t)l * DFF * 1024, 1024, nullptr, (bf16_t*)(ws + OFF_WF2), DFF, 1024, DFF, nb, blk, base);
        base = conv_T<0>(tile, a->in[31] + (size_t)l * 1024 * 1024, 1024, nullptr, (bf16_t*)(ws + OFF_WPA), 1024, 1024, 1024, nb, blk, base);
        base = conv_T<0>(tile, a->in[34] + (size_t)l * 1024 * 1024, 1024, nullptr, (bf16_t*)(ws + OFF_WOUT), 1024, 1024, 1024, nb, blk, base);
        base = conv_T<0>(tile, a->in[32] + (size_t)l * 512 * 1024, 1024, nullptr, (bf16_t*)(ws + OFF_WPB), 512, 1024, 512, nb, blk, base);
        base = conv_T<0>(tile, a->in[33] + (size_t)l * 512 * 1024, 1024, nullptr, (bf16_t*)(ws + OFF_WPC), 512, 1024, 512, nb, blk, base);
        base = conv_T<0>(tile, a->in[28] + (size_t)l * 512 * 512, 512, nullptr, (bf16_t*)(ws + OFF_WGLU), 512, 512, 512, nb, blk, base);
    }
    { bf16_t* wgt = (bf16_t*)(ws + OFF_WGT); const float* wrg = a->in[11] + (size_t)l * 8 * 128 * 128; const float* wig = a->in[13] + (size_t)l * 8 * 128 * 128;
      for (int idx = blk * 512 + tid; idx < 2048 * 256; idx += nblk * 512) { const int n = idx >> 8, k = idx & 255, h = n >> 8, s = (n >> 7) & 1, j = n & 127; float v = 0.f;
          if ((k >> 7) == (h & 1)) v = (s ? wig : wrg)[((size_t)h * 128 + (k & 127)) * 128 + j];
          wgt[idx] = f2bf(v); } }
    { float* TAB = (float*)(ws + OFF_TAB); for (int idx = blk * 512 + tid; idx < 1024; idx += nblk * 512) TAB[TAB_LAM + idx] = -8.0f * log1pf(expf(-a->in[15][l * 1024 + idx])); }
    if (nsb) { if (blk >= nb) s5_build(a, l, (blk - nb) >> 2, lds, (blk - nb) & 3, 4); } else { for (int g = blk; g < 32; g += nblk) s5_build(a, l, g, lds, 0, 1); }
    if (l == 0) {
        bf16_t* xb = (bf16_t*)(ws + OFF_XB); float* rsq = (float*)(ws + OFF_RSQ); const int wv = tid >> 6, lane = tid & 63;
        f32x4 vn[4]; const int rstep = nblk * 8; int row = blk * 8 + wv;
        if (row < MT) { const float* src = (row < MP) ? a->in[0] + (size_t)row * 1024 : a->in[1] + (size_t)(row - MP) * 1024;
#pragma unroll
            for (int i = 0; i < 4; ++i) vn[i] = *(const f32x4*)(src + i * 256 + lane * 4); }
        for (; row < MT; row += rstep) { f32x4 vc[4]; float ss = 0.f;
#pragma unroll
            for (int i = 0; i < 4; ++i) vc[i] = vn[i];
            if (row + rstep < MT) { const int rn = row + rstep; const float* src = (rn < MP) ? a->in[0] + (size_t)rn * 1024 : a->in[1] + (size_t)(rn - MP) * 1024;
#pragma unroll
                for (int i = 0; i < 4; ++i) vn[i] = *(const f32x4*)(src + i * 256 + lane * 4); }
#pragma unroll
            for (int i = 0; i < 4; ++i) { const f32x4 v = vc[i]; ss += v[0] * v[0] + v[1] * v[1] + v[2] * v[2] + v[3] * v[3];
                u32x2 w; w.x = cvt_pk_bf16(v[0], v[1]); w.y = cvt_pk_bf16(v[2], v[3]); *(u32x2*)(xb + (size_t)row * 1024 + i * 256 + lane * 4) = w; }
            ss = wave_sum(ss); if (lane < 16) rsq[(size_t)row * 16 + lane] = (lane == 0) ? ss : 0.f; }
    }
}

__device__ __forceinline__ void conv_a_phase(KArgsP a, int l) {
    const bf16_t* ua = (const bf16_t*)(a->ws + OFF_SA); bf16_t* ca = (bf16_t*)(a->ws + OFF_SB);
    const float* w = a->in[9] + (size_t)l * 4 * 1024; const float* bias = a->in[10] + (size_t)l * 1024;
    const int tid = otid();
    const int c8 = (tid & 127) * 8;
    float wv[4][8], bv[8];
#pragma unroll
    for (int k = 0; k < 4; ++k) { const f32x4 p = *(const f32x4*)(w + k * 1024 + c8), q = *(const f32x4*)(w + k * 1024 + c8 + 4);
#pragma unroll
        for (int j = 0; j < 4; ++j) { wv[k][j] = p[j]; wv[k][4 + j] = q[j]; } }
    { const f32x4 p = *(const f32x4*)(bias + c8), q = *(const f32x4*)(bias + c8 + 4);
#pragma unroll
      for (int j = 0; j < 4; ++j) { bv[j] = p[j]; bv[4 + j] = q[j]; } }
    const int step = gridDim.x * 512; int idx = blockIdx.x * 512 + tid;
    u32x4 xv[4];
    if (idx < MT * 128) { const int row = idx >> 7;
#pragma unroll
        for (int k = 0; k < 4; ++k) { const int rr = row - 3 + k; xv[k] = *(const u32x4*)(ua + (size_t)(rr < 0 ? 0 : rr) * 1024 + c8); } }
    for (; idx < MT * 128; idx += step) {
        const int row = idx >> 7; float acc[8], x[8]; u32x4 xc[4];
#pragma unroll
        for (int k = 0; k < 4; ++k) xc[k] = xv[k];
        if (idx + step < MT * 128) { const int rown = (idx + step) >> 7;
#pragma unroll
            for (int k = 0; k < 4; ++k) { const int rr = rown - 3 + k; xv[k] = *(const u32x4*)(ua + (size_t)(rr < 0 ? 0 : rr) * 1024 + c8); } }
#pragma unroll
        for (int j = 0; j < 8; ++j) acc[j] = bv[j];
        unpack8(xc[3], x);
        if (row < MP) { const int t = row & (SEQ - 1), b = row >> 11;
#pragma unroll
            for (int k = 0; k < 4; ++k) { if (t - 3 + k >= 0) { float xk[8]; unpack8(xc[k], xk);
#pragma unroll
                for (int j = 0; j < 8; ++j) acc[j] += wv[k][j] * xk[j]; } }
            if (t >= SEQ - 3) { float* o = a->out + O_PLC + (((size_t)l * NBATCH + b) * 3 + (t - (SEQ - 3))) * 1024 + c8;
#pragma unroll
                for (int j = 0; j < 8; ++j) o[j] = x[j]; }
        } else { const int s = row - MP; const float* st = a->in[2] + ((size_t)l * MS + s) * 3 * 1024 + c8; float* o = a->out + O_SLC + ((size_t)l * MS + s) * 3 * 1024 + c8;
#pragma unroll
            for (int j = 0; j < 8; ++j) { const float s0 = st[j], s1 = st[1024 + j], s2 = st[2048 + j];
                acc[j] += wv[0][j] * s0 + wv[1][j] * s1 + wv[2][j] * s2 + wv[3][j] * x[j]; o[j] = s1; o[1024 + j] = s2; o[2048 + j] = x[j]; }
        }
        store8(ca + (size_t)row * 1024 + c8, acc);
    }
}

__device__ __forceinline__ void cfm_phase(KArgsP a, int l, LAS unsigned char* lds) {
    const int tid = otid(), half = tid >> 8, cp = tid & 255, wv = tid >> 6, lane = tid & 63;
    const bf16_t* glu = (const bf16_t*)(a->ws + OFF_SE); bf16_t* yb = (bf16_t*)(a->ws + OFF_YB);
    LAS unsigned* in = (LAS unsigned*)lds;
    LAS float* part = (LAS float*)(lds + 62 * 1024);
    const float* wdw = a->in[16] + (size_t)l * 31 * 512 + 2 * cp;
    typedef float f32x2 __attribute__((ext_vector_type(2)));
    LAS f32x2* wl = (LAS f32x2*)(lds + 65536);
    for (int idx = tid; idx < 31 * 256; idx += 512) { const f32x2 wk = *(const f32x2*)(a->in[16] + (size_t)l * 31 * 512 + 2 * idx);
        u32x2 pk; pk.x = cvt_pk_bf16(wk.x, 0.f); pk.y = cvt_pk_bf16(0.f, wk.y); ((LAS u32x2*)wl)[idx] = pk; }
    const float bs0 = a->in[17][l * 512 + 2 * cp], bs1 = a->in[17][l * 512 + 2 * cp + 1];
    const float lg0 = a->in[18][l * 512 + 2 * cp], lg1 = a->in[18][l * 512 + 2 * cp + 1], lb0 = a->in[19][l * 512 + 2 * cp], lb1 = a->in[19][l * 512 + 2 * cp + 1];
    u32x4 pv[8];
#define CFM_LOAD(tl) do { const int b_ = (tl) >> 6, t0_ = ((tl) & 63) * 32; \
        _Pragma("unroll") for (int i = 0; i < 8; ++i) { const int idx = tid + 512 * i, r = idx >> 6, c16 = idx & 63, t = t0_ - 30 + r; pv[i] = (u32x4){0u, 0u, 0u, 0u}; \
            if (idx < 62 * 64 && t >= 0) pv[i] = *(const u32x4*)(glu + ((size_t)b_ * SEQ + t) * 512 + c16 * 8); } } while (0)
    if ((int)blockIdx.x < 512) CFM_LOAD((int)blockIdx.x);
    const int ntl = (gridDim.x == 256) ? 768 : 512 + 64;
    for (int tile0 = blockIdx.x; tile0 < ntl; tile0 += gridDim.x) {
        int tile = tile0;
        if (gridDim.x == 256 && tile0 >= 512) { tile = 512 + (((int)blockIdx.x + 64) & 255); if (tile >= 512 + 64) continue; }
        if (tile < 512) {
            const int b = tile >> 6, t0 = (tile & 63) * 32;
#pragma unroll
            for (int i = 0; i < 8; ++i) { const int idx = tid + 512 * i; if (idx < 62 * 64) *(LAS u32x4*)(in + (idx >> 6) * 256 + (idx & 63) * 4) = pv[i]; }
            if (tile + (int)gridDim.x < 512) CFM_LOAD(tile + (int)gridDim.x);
            __syncthreads();
            float val0[16], val1[16];
#pragma unroll
            for (int j = 0; j < 16; ++j) { val0[j] = bs0; val1[j] = bs1; }
#pragma unroll 1
            for (int k = 0; k < 31; ++k) { const u32x2 wk = ((const LAS u32x2*)wl)[k * 256 + cp]; const LAS unsigned* ip = in + (half * 16 + k) * 256 + cp;
#pragma unroll
                for (int j = 0; j < 16; ++j) { const unsigned xw = ip[j * 256];
                    asm("v_dot2c_f32_bf16 %0, %1, %2" : "+v"(val0[j]) : "v"(xw), "v"(wk.x));
                    asm("v_dot2c_f32_bf16 %0, %1, %2" : "+v"(val1[j]) : "v"(xw), "v"(wk.y)); } }
#pragma unroll
            for (int ti = 0; ti < 16; ++ti) { float s = val0[ti] + val1[ti], q = val0[ti] * val0[ti] + val1[ti] * val1[ti]; s = wave_sum(s); q = wave_sum(q);
                if (lane == 0) { part[((half * 16 + ti) * 4 + (wv & 3)) * 2] = s; part[((half * 16 + ti) * 4 + (wv & 3)) * 2 + 1] = q; } }
            if (t0 + 32 == SEQ) {
                float* o = a->out + O_PCC + ((size_t)l * NBATCH + b) * 30 * 512;
                for (int idx = tid; idx < 30 * 256; idx += 512) { const int r = idx >> 8, c = idx & 255; const unsigned xw = in[(32 + r) * 256 + c]; o[r * 512 + 2 * c] = __uint_as_float(xw << 16); o[r * 512 + 2 * c + 1] = __uint_as_float(xw & 0xffff0000u); } }
            __syncthreads();
#pragma unroll
            for (int ti = 0; ti < 16; ++ti) { const LAS float* pp = part + (half * 16 + ti) * 8; const float S = (pp[0] + pp[2]) + (pp[4] + pp[6]), Q = (pp[1] + pp[3]) + (pp[5] + pp[7]);
                const float mean = S * (1.0f / 512.0f), var = fmaxf(Q * (1.0f / 512.0f) - mean * mean, 0.f), rstd = rsqrtf(var + EPS);
                float y0 = (val0[ti] - mean) * rstd * lg0 + lb0, y1 = (val1[ti] - mean) * rstd * lg1 + lb1; y0 *= sigm(y0); y1 *= sigm(y1);
                *(unsigned*)(yb + ((size_t)b * SEQ + t0 + half * 16 + ti) * 512 + 2 * cp) = cvt_pk_bf16(y0, y1); }
            __syncthreads();
        } else {
            const int s = (tile - 512) * 2 + half; const float* st = a->in[4] + ((size_t)l * MS + s) * 30 * 512 + 2 * cp; float* o = a->out + O_SCC + ((size_t)l * MS + s) * 30 * 512 + 2 * cp;
            float a0 = bs0, a1 = bs1;
#pragma unroll 2
            for (int k = 0; k < 30; ++k) { const float x0 = st[k * 512], x1 = st[k * 512 + 1]; a0 += wdw[k * 512] * x0; a1 += wdw[k * 512 + 1] * x1; if (k >= 1) { o[(k - 1) * 512] = x0; o[(k - 1) * 512 + 1] = x1; } }
            { const unsigned xw = *(const unsigned*)(glu + (size_t)(MP + s) * 512 + 2 * cp); const float x0 = __uint_as_float(xw << 16), x1 = __uint_as_float(xw & 0xffff0000u);
              a0 += wdw[30 * 512] * x0; a1 += wdw[30 * 512 + 1] * x1; o[29 * 512] = x0; o[29 * 512 + 1] = x1; }
            float sm = wave_sum(a0 + a1), q = wave_sum(a0 * a0 + a1 * a1);
            if (lane == 0) { part[(half * 4 + (wv & 3)) * 2] = sm; part[(half * 4 + (wv & 3)) * 2 + 1] = q; }
            __syncthreads();
            { const LAS float* pp = part + half * 8; const float S = (pp[0] + pp[2]) + (pp[4] + pp[6]), Q = (pp[1] + pp[3]) + (pp[5] + pp[7]);
              const float mean = S * (1.0f / 512.0f), var = fmaxf(Q * (1.0f / 512.0f) - mean * mean, 0.f), rstd = rsqrtf(var + EPS);
              float y0 = (a0 - mean) * rstd * lg0 + lb0, y1 = (a1 - mean) * rstd * lg1 + lb1; y0 *= sigm(y0); y1 *= sigm(y1);
              *(unsigned*)(yb + (size_t)(MP + s) * 512 + 2 * cp) = cvt_pk_bf16(y0, y1); }
            __syncthreads();
        }
    }
}

#undef CFM_LOAD
__device__ __forceinline__ void s5_sample(KArgsP a, int l) {
    const int tid = otid(); const int wv = tid >> 6, p = tid & 63; const float* TAB = (const float*)(a->ws + OFF_TAB);
    const bf16_t* ucs = (const bf16_t*)(a->ws + OFF_UCS); bf16_t* yc0 = (bf16_t*)(a->ws + OFF_SE);
    for (int w = blockIdx.x * 8 + wv; w < MS * 32; w += gridDim.x * 8) { const int s = w >> 5, g = w & 31;
        float u[16]; load8(ucs + (size_t)s * 512 + g * 16, u); load8(ucs + (size_t)s * 512 + g * 16 + 8, u + 8);
        const float ar = TAB[(g * 64 + p) * 2], ai = TAB[(g * 64 + p) * 2 + 1]; const float* bb = TAB + 8192 + ((size_t)g * 1024 + p * 16) * 2;
        const size_t si = (((size_t)l * MS + s) * 32 + g) * 64 + p; const float s0r = a->in[5][si], s0i = a->in[6][si];
        float xr = ar * s0r - ai * s0i, xi = ar * s0i + ai * s0r;
#pragma unroll
        for (int c = 0; c < 16; ++c) { xr += bb[2 * c] * u[c]; xi += bb[2 * c + 1] * u[c]; }
        a->out[O_SSR + si] = xr; a->out[O_SSI + si] = xi;
        const float* cr = a->in[25] + (size_t)(l * 32 + g) * 1024; const float* ci = a->in[26] + (size_t)(l * 32 + g) * 1024; float mine = 0.f;
#pragma unroll
        for (int c = 0; c < 16; ++c) { const float t = wave_sum(cr[c * 64 + p] * xr - ci[c * 64 + p] * xi); if (p == c) mine = t; }
        float up = 0.f;
#pragma unroll
        for (int c = 0; c < 16; ++c) up = (p == c) ? u[c] : up;
        if (p < 16) yc0[(size_t)(MP + s) * 512 + g * 16 + p] = f2bf(gelu_tanh(mine + a->in[27][l * 512 + g * 16 + p] * up));
    }
}

__device__ __forceinline__ void s5_carry_bg(KArgsP a, int l, LAS unsigned char* lds, const int b, const int g) {
    const int tid = otid(), seg = tid >> 6, p = tid & 63; const float* TAB = (const float*)(a->ws + OFF_TAB);
    const float* ends = (const float*)(a->ws + OFF_SF); bf16_t* ucg = (bf16_t*)(a->ws + OFF_UCG); LAS float* sT = (LAS float*)lds;
    {
        const float ar = TAB[4096 + (g * 64 + p) * 2], ai = TAB[4096 + (g * 64 + p) * 2 + 1];
        const size_t c0 = (size_t)g * NCHK + b * 128 + seg * 16; float er[16], ei[16];
#pragma unroll
        for (int k = 0; k < 16; ++k) { er[k] = ends[(c0 + k) * 128 + p]; ei[k] = ends[(c0 + k) * 128 + 64 + p]; }
        float Lr[17], Li[17]; Lr[0] = 0.f; Li[0] = 0.f;
#pragma unroll
        for (int k = 0; k < 16; ++k) { Lr[k + 1] = ar * Lr[k] - ai * Li[k] + er[k]; Li[k + 1] = ar * Li[k] + ai * Lr[k] + ei[k]; }
        sT[(seg * 64 + p) * 2] = Lr[16]; sT[(seg * 64 + p) * 2 + 1] = Li[16];
        __syncthreads();
        float br = ar, bi = ai;
#pragma unroll
        for (int i = 0; i < 4; ++i) { const float t = br * br - bi * bi; bi = 2.f * br * bi; br = t; }
        float Sr = 0.f, Si = 0.f;
        for (int s2 = 0; s2 < seg; ++s2) { const float tr = sT[(s2 * 64 + p) * 2], ti = sT[(s2 * 64 + p) * 2 + 1]; const float nr = br * Sr - bi * Si + tr; Si = br * Si + bi * Sr + ti; Sr = nr; }
        float pr = 1.f, pi = 0.f;
#pragma unroll
        for (int k = 0; k < 16; ++k) { const float vr = Lr[k] + pr * Sr - pi * Si, vi = Li[k] + pr * Si + pi * Sr;
            ucg[(c0 + k) * KS5 + 256 + p] = f2bf(vr); ucg[(c0 + k) * KS5 + 320 + p] = f2bf(vi);
            const float t = pr * ar - pi * ai; pi = pr * ai + pi * ar; pr = t; }
        if (seg == 7) { const size_t o = (((size_t)l * NBATCH + b) * 32 + g) * 64 + p; a->out[O_PSR + o] = Lr[16] + br * Sr - bi * Si; a->out[O_PSI + o] = Li[16] + br * Si + bi * Sr; }
        __syncthreads();
    }
}
__device__ __forceinline__ void s5_carry(KArgsP a, int l, LAS unsigned char* lds) { for (int w = blockIdx.x; w < NBATCH * 32; w += gridDim.x) s5_carry_bg(a, l, lds, w >> 5, w & 31); }

__device__ __forceinline__ void lru_scan(KArgsP a, int l, LAS unsigned char* lds, bf16_t* dst_alt) {
    const int tid = otid(), cq = tid & 7, chunk = tid >> 3;
    bf16_t* la = (bf16_t*)(a->ws + OFF_SA); const bf16_t* bx = (const bf16_t*)(a->ws + OFF_SC);
    LAS f32x4* sP = (LAS f32x4*)lds; LAS f32x4* sH = sP + 64 * 8;
    for (int w = blockIdx.x; w < NBATCH * 32; w += gridDim.x) { const int b = w >> 5, cg_ = w & 31;
        const size_t base = ((size_t)b * SEQ + chunk * 32) * 1024 + cg_ * 32 + cq * 4;
        f32x4 P = (f32x4){1.f, 1.f, 1.f, 1.f}, h = (f32x4){0.f, 0.f, 0.f, 0.f};
        u32x2 lw[32], bw[32];
#pragma unroll
        for (int j = 0; j < 32; ++j) { lw[j] = *(const u32x2*)(la + base + (size_t)j * 1024); bw[j] = *(const u32x2*)(bx + base + (size_t)j * 1024); }
#pragma unroll
        for (int j = 0; j < 32; ++j) { const f32x4 av = (f32x4){__expf(bf2f(lw[j].x & 0xffffu)), __expf(bf2f(lw[j].x >> 16)), __expf(bf2f(lw[j].y & 0xffffu)), __expf(bf2f(lw[j].y >> 16))};
            const f32x4 bv = (f32x4){bf2f(bw[j].x & 0xffffu), bf2f(bw[j].x >> 16), bf2f(bw[j].y & 0xffffu), bf2f(bw[j].y >> 16)};
            h = av * h + bv; P = P * av; }
        sP[chunk * 8 + cq] = P; sH[chunk * 8 + cq] = h;
        __syncthreads();
        f32x4 cin = (f32x4){0.f, 0.f, 0.f, 0.f};
        for (int c2 = 0; c2 < chunk; ++c2) cin = sP[c2 * 8 + cq] * cin + sH[c2 * 8 + cq];
        h = cin;
#pragma unroll
        for (int j = 0; j < 32; ++j) { asm volatile("" : "+v"(lw[j].x), "+v"(lw[j].y), "+v"(bw[j].x), "+v"(bw[j].y));
            const f32x4 av = (f32x4){__expf(bf2f(lw[j].x & 0xffffu)), __expf(bf2f(lw[j].x >> 16)), __expf(bf2f(lw[j].y & 0xffffu)), __expf(bf2f(lw[j].y >> 16))};
            const f32x4 bv = (f32x4){bf2f(bw[j].x & 0xffffu), bf2f(bw[j].x >> 16), bf2f(bw[j].y & 0xffffu), bf2f(bw[j].y >> 16)};
            h = av * h + bv; u32x2 o; o.x = cvt_pk_bf16(h[0], h[1]); o.y = cvt_pk_bf16(h[2], h[3]); *(u32x2*)(dst_alt + base + (size_t)j * 1024) = o; }
        if (chunk == 63) *(f32x4*)(a->out + O_PLH + ((size_t)l * NBATCH + b) * 1024 + cg_ * 32 + cq * 4) = h;
        __syncthreads();
    }
}


#define XB_TMO      128
#define XB_XCNT(j)  (256  + 64 * (j))
#define XB_XSUB(j)  (1280 + 64 * (j))
#define XB_XGEN(j)  (2304 + 64 * (j))
#define XB_TOP      3328
#define XB_TOPGEN   3392
#define XCD_BAR_WORDS 3456
#define XB_SPIN_CAP (1u << 18)
__device__ __forceinline__ unsigned xb_ld(unsigned* p)              { return __hip_atomic_load(p, __ATOMIC_RELAXED, __HIP_MEMORY_SCOPE_AGENT); }
__device__ __forceinline__ unsigned xb_add(unsigned* p, unsigned v) { return __hip_atomic_fetch_add(p, v, __ATOMIC_RELAXED, __HIP_MEMORY_SCOPE_AGENT); }
__device__ __forceinline__ unsigned xb_xcc_id() { return (unsigned)__builtin_amdgcn_s_getreg((3 << 11) | 20) & 0xFu; }
#define XB_SPIN(cond, bar) do { unsigned _sp = 0; while (cond) { __builtin_amdgcn_s_sleep(1); \
    if ((++_sp & 255u) == 0u) { if (xb_ld(&(bar)[XB_TMO])) break; if (_sp > XB_SPIN_CAP) { atomicAdd(&(bar)[XB_TMO], 1u); break; } } } } while (0)
__device__ __forceinline__ void xcd_barrier_complete(unsigned* bar, unsigned x, unsigned& nloc, unsigned& nx) {
    const unsigned G = gridDim.x * gridDim.y * gridDim.z;
    unsigned sum, cnt, mine, sp = 0u;
    for (;;) {
        sum = 0u; cnt = 0u; mine = 0u;
#pragma unroll
        for (unsigned j = 0; j < 16; ++j) { const unsigned c = xb_ld(&bar[XB_XCNT(j)]); sum += c; cnt += (c > 0u) ? 1u : 0u; mine = (j == x) ? c : mine; }
        if (sum == G) break;
        __builtin_amdgcn_s_sleep(1);
        if ((++sp & 255u) == 0u) { if (xb_ld(&bar[XB_TMO])) break; if (sp > XB_SPIN_CAP) { atomicAdd(&bar[XB_TMO], 1u); break; } }
    }
    nloc = mine > 0u ? mine : 1u; nx = cnt > 0u ? cnt : 1u;
}
__device__ __forceinline__ void xcd_barrier(unsigned* bar, volatile LAS unsigned* st) {
    asm volatile("s_waitcnt vmcnt(0)" ::: "memory");
    __syncthreads();
    if (threadIdx.x == 0) {
        const unsigned x = xb_xcc_id();
        __builtin_amdgcn_s_waitcnt(0);
        unsigned nloc = st[0], nx = st[1];
        if (nloc == 0u) { xcd_barrier_complete(bar, x, nloc, nx); st[0] = nloc; st[1] = nx; }
        const unsigned old = xb_add(&bar[XB_XSUB(x)], 1u);
        const unsigned gen = old / nloc;
        if (old + 1u == (gen + 1u) * nloc) {
            __builtin_amdgcn_fence(__ATOMIC_RELEASE, "agent");
            asm volatile("s_waitcnt vmcnt(0)" ::: "memory");
            const unsigned og = xb_add(&bar[XB_TOP], 1u);
            const unsigned tg = og / nx;
            if (og + 1u == (tg + 1u) * nx) xb_add(&bar[XB_TOPGEN], 1u);
            else XB_SPIN(xb_ld(&bar[XB_TOPGEN]) == tg, bar);
            __builtin_amdgcn_fence(__ATOMIC_ACQUIRE, "agent");
            xb_add(&bar[XB_XGEN(x)], 1u);
            asm volatile("s_waitcnt vmcnt(0)" ::: "memory");
        } else {
            XB_SPIN(xb_ld(&bar[XB_XGEN(x)]) == gen, bar);
            __builtin_amdgcn_fence(__ATOMIC_ACQUIRE, "agent");
            asm volatile("s_waitcnt vmcnt(0)" ::: "memory");
        }
    }
    __syncthreads();
}

#ifndef PROBE_DUP
#define PROBE_DUP -1
#endif
#define REP(k) for (int rep_ = 0; rep_ < ((PROBE_DUP) == (k) ? 2 : 1); ++rep_)
#define XBAR() xcd_barrier((unsigned*)(kargs()->ws + OFF_BAR), (volatile LAS unsigned*)(lds + 131072 + 512))
#define GSYNC() do { XBAR(); if ((PROBE_DUP) == 100) XBAR(); } while (0)
#ifndef PH_ONLY
#define PH_ON(n) true
#else
#define PH_ON(n) ((n) == PH_ONLY)
#endif
__global__ void __launch_bounds__(512) fwd_megakernel(KArgs a_by_value) {
    extern __shared__ __attribute__((aligned(16))) unsigned char lds_raw[];
    LAS unsigned char* lds = (LAS unsigned char*)lds_raw;
    cg::grid_group grid = cg::this_grid();
    { volatile LAS unsigned* st = (volatile LAS unsigned*)(lds + 131072 + 512); if (threadIdx.x == 0) { st[0] = 0u; st[1] = 0u; }
      __syncthreads();
      if (threadIdx.x == 0) (void)xb_add((unsigned*)(kargs()->ws + OFF_BAR) + XB_XCNT(xb_xcc_id()), 1u); }
    grid.sync();
#define WSB(off) ((bf16_t*)(ws + (off)))
#define PH_HEAD KArgsP a = kargs(); unsigned char* ws = a->ws; const int G = gridDim.x, c = oblk(); (void)G; (void)c; (void)ws;

    for (int l = 0; l < NLAYER; ++l) {
        REP(0) if (PH_ON(0)) { PH_HEAD phase0(a, l, lds); }
        GSYNC();
        REP(1) if (PH_ON(1)) { PH_HEAD
          Sched S{65, 10, 1, G, c, 0, (const char*)WSB(OFF_XB), (const char*)WSB(OFF_WIN), 0, 0, (size_t)256 * 1024 * 2, (size_t)256 * 1024 * 2};
          F1 f{(const float*)(ws + OFF_RSQ), WSB(OFF_SA), WSB(OFF_SE), WSB(OFF_UCG), WSB(OFF_UCS)};
          gemm_phase(lds, 1024, 1024, 16, S, f); }
        GSYNC();
        REP(20) if (PH_ON(20)) { PH_HEAD conv_a_phase(a, l); }
        REP(21) if (PH_ON(21)) { PH_HEAD cfm_phase(a, l, lds); }
        REP(22) if (PH_ON(22)) { PH_HEAD
          Sched S{4, 1, 32, G, c, 0, (const char*)WSB(OFF_UCG), (const char*)(ws + OFF_ET), (size_t)NCHK * KS5 * 2, (size_t)128 * 256 * 2, (size_t)256 * KS5 * 2, 0};
          FEnd f{(float*)(ws + OFF_SF)};
          gemm_phase(lds, KS5, 256, 4, S, f);
          if (G == 256) { Unit u; if (S.next(0, u)) { s5_carry_bg(a, l, lds, 2 * u.pm, u.g); s5_carry_bg(a, l, lds, 2 * u.pm + 1, u.g); } } }
        GSYNC();
        if (gridDim.x == 256) {
            REP(3) if (PH_ON(3)) { PH_HEAD
              const bool lo = c < 128;
              Sched S{64, 8, 1, 128, lo ? c : c - 128, 1, (const char*)WSB(OFF_SB), (const char*)(ws + OFF_WGT), 0, 0, (size_t)256 * 1024 * 2, (size_t)256 * 256 * 2, lo ? 0L : 384L, lo ? 384L : 512L};
              F2 f{WSB(OFF_SB), a->in[12] + l * 1024, a->in[14] + l * 1024, (const float*)(ws + OFF_TAB) + TAB_LAM, a->in[3] + (size_t)l * MS * 1024, WSB(OFF_SA), WSB(OFF_SC), a->out + O_SLH + (size_t)l * MS * 1024};
              gemm_phase(lds, 1024, 256, 4, S, f);
              thin_gemm(lds, WSB(OFF_SB), 1024, WSB(OFF_WGT), 256, 256, 8, 1, f, c, G); }
            REP(41) if (PH_ON(41)) { PH_HEAD
              if (c >= 128) { Sched S{4, 1, 32, G, c - 128, 0, (const char*)WSB(OFF_UCG), (const char*)(ws + OFF_TF), (size_t)NCHK * KS5 * 2, (size_t)256 * KS5 * 2, (size_t)256 * KS5 * 2, 0};
                FS5 f{WSB(OFF_UCG), a->in[27] + l * 512, WSB(OFF_SE)};
                gemm_phase(lds, KS5, KS5, 6, S, f); } }
            REP(23) if (PH_ON(23)) { PH_HEAD s5_sample(a, l); }
            GSYNC();
            REP(4) if (PH_ON(4)) { PH_HEAD lru_scan(a, l, lds, WSB(OFF_SA)); }
        } else {
        REP(3) if (PH_ON(3)) { PH_HEAD
          Sched S{64, 8, 1, G, c, 1, (const char*)WSB(OFF_SB), (const char*)(ws + OFF_WGT), 0, 0, (size_t)256 * 1024 * 2, (size_t)256 * 256 * 2};
          F2 f{WSB(OFF_SB), a->in[12] + l * 1024, a->in[14] + l * 1024, (const float*)(ws + OFF_TAB) + TAB_LAM, a->in[3] + (size_t)l * MS * 1024, WSB(OFF_SA), WSB(OFF_SC), a->out + O_SLH + (size_t)l * MS * 1024};
          gemm_phase(lds, 1024, 256, 4, S, f);
          thin_gemm(lds, WSB(OFF_SB), 1024, WSB(OFF_WGT), 256, 256, 8, 1, f, c, G); }
        REP(31) if (PH_ON(31)) { PH_HEAD s5_carry(a, l, lds); }
        GSYNC();
        REP(4) if (PH_ON(4)) { PH_HEAD lru_scan(a, l, lds, ((PROBE_DUP) == 4 && rep_ == 0) ? WSB(OFF_SB) : WSB(OFF_SA)); }
        REP(23) if (PH_ON(23)) { PH_HEAD s5_sample(a, l); }
        REP(41) if (PH_ON(41)) { PH_HEAD
          Sched S{4, 1, 32, G, c, 0, (const char*)WSB(OFF_UCG), (const char*)(ws + OFF_TF), (size_t)NCHK * KS5 * 2, (size_t)256 * KS5 * 2, (size_t)256 * KS5 * 2, 0};
          FS5 f{WSB(OFF_UCG), a->in[27] + l * 512, WSB(OFF_SE)};
          gemm_phase(lds, KS5, KS5, 6, S, f); }
        GSYNC();
        }
        REP(5) if (PH_ON(5)) {
            { PH_HEAD
              Sched S{64, 2, 1, G, c, 0, (const char*)WSB(OFF_SE), (const char*)(ws + OFF_WGLU), 0, 0, (size_t)256 * 512 * 2, (size_t)256 * 512 * 2};
              F4 f{WSB(OFF_SE), a->in[29] + l * 512, WSB(OFF_SF)};
              gemm_phase(lds, 512, 512, 8, S, f);
              const int hb = G >> 1;
              thin_gemm(lds, WSB(OFF_SE), 512, WSB(OFF_WGLU), 512, 512, 2, 0, f, c >= hb ? c - hb : -1, G - hb); }
            { PH_HEAD
              const int hb = G >> 1, cr = c >= hb ? c - hb : c + (G - hb);
              const bf16_t* Wg = WSB(OFF_WIN) + (size_t)2560 * 1024;
              Sched S{64, 12, 1, G, cr, 0, (const char*)WSB(OFF_XB), (const char*)Wg, 0, 0, (size_t)256 * 1024 * 2, (size_t)256 * 1024 * 2};
              FG8 f{(const float*)(ws + OFF_RSQ), a->in[30] + l * 3072, ws + OFF_GT8};
              gemm_phase(lds, 1024, 1024, 16, S, f);
              thin_gemm(lds, WSB(OFF_XB), 1024, Wg, 1024, 1024, 12, 0, f, c >= hb ? c - hb : -1, G - hb); }
        }
        GSYNC();
        REP(6) if (PH_ON(6)) {
            { PH_HEAD
              SchedM3 S{G, c, (const char*)WSB(OFF_SA), (const char*)WSB(OFF_YB), (const char*)WSB(OFF_SF), (const char*)WSB(OFF_WPA), (const char*)WSB(OFF_WPB), (const char*)WSB(OFF_WPC)};
              FMS f{ws + OFF_GT8, WSB(OFF_MRG)};
              gemm_phase_t<FMS, SchedM3, true>(lds, 1024, 1024, 16, S, f); }
            { PH_HEAD
              thin_merge(lds, WSB(OFF_SA), WSB(OFF_YB), WSB(OFF_SF), WSB(OFF_WPA), WSB(OFF_WPB), WSB(OFF_WPC), ws + OFF_GT8, WSB(OFF_MRG), c, G); }
        }
        GSYNC();
        if (PH_ON(7)) { PH_HEAD
          Sched S{64, 4, 1, G, c, 0, (const char*)WSB(OFF_MRG), (const char*)(ws + OFF_WOUT), 0, 0, (size_t)256 * 1024 * 2, (size_t)256 * 1024 * 2};
          F6T<false> f{l == 0 ? a->in[0] : a->out, l == 0 ? a->in[1] : a->out + (size_t)MP * 1024, a->out, WSB(OFF_XB), (float*)(ws + OFF_RSQ2)};
          gemm_phase(lds, 1024, 1024, 16, S, f);
          F6T<true> ft{f.xs_p, f.xs_s, f.xd, f.xb, f.rsq};
          thin_gemm(lds, WSB(OFF_MRG), 1024, WSB(OFF_WOUT), 1024, 1024, 4, 0, ft, c, G); }
        GSYNC();
        REP(8) if (PH_ON(8)) { PH_HEAD
          Sched S{65, 22, 1, G, c, 0, (const char*)WSB(OFF_XB), (const char*)(ws + OFF_WF1), 0, 0, (size_t)256 * 1024 * 2, (size_t)256 * 1024 * 2};
          F7 f{(const float*)(ws + OFF_RSQ2), WSB(OFF_SA)};
          gemm_phase(lds, 1024, 1024, 16, S, f); }
        GSYNC();
        if (PH_ON(9)) { PH_HEAD
          Sched S{64, 4, 1, G, c, 0, (const char*)WSB(OFF_SA), (const char*)(ws + OFF_WF2), 0, 0, (size_t)256 * DFF * 2, (size_t)256 * DFF * 2};
          F6T<false> f{a->out, a->out + (size_t)MP * 1024, a->out, WSB(OFF_XB), (float*)(ws + OFF_RSQ)};
          gemm_phase(lds, DFF, DFF, DFF / 64, S, f);
          F6T<true> ft{f.xs_p, f.xs_s, f.xd, f.xb, f.rsq};
          thin_gemm(lds, WSB(OFF_SA), DFF, WSB(OFF_WF2), DFF, DFF, 4, 0, ft, c, G); }
        GSYNC();
    }
    { PH_HEAD const int tid = otid(); const int wv = tid >> 6, lane = tid & 63; const float* gf = a->in[38]; const float* RSQ = (const float*)(ws + OFF_RSQ);
      f32x4 vn[4], pn4; const int rstep = gridDim.x * 8; int row = blockIdx.x * 8 + wv; f32x4 gv[4];
#pragma unroll
      for (int i = 0; i < 4; ++i) gv[i] = *(const f32x4*)(gf + i * 256 + lane * 4);
      if (row < MT) { pn4 = *(const f32x4*)(RSQ + (size_t)row * 16 + (lane & 3) * 4);
#pragma unroll
          for (int i = 0; i < 4; ++i) vn[i] = *(const f32x4*)(a->out + (size_t)row * 1024 + i * 256 + lane * 4); }
      for (; row < MT; row += rstep) { f32x4 vc[4]; const f32x4 pc = pn4;
#pragma unroll
          for (int i = 0; i < 4; ++i) vc[i] = vn[i];
          if (row + rstep < MT) { const int rn = row + rstep; pn4 = *(const f32x4*)(RSQ + (size_t)rn * 16 + (lane & 3) * 4);
#pragma unroll
              for (int i = 0; i < 4; ++i) vn[i] = *(const f32x4*)(a->out + (size_t)rn * 1024 + i * 256 + lane * 4); }
          float sq = (pc[0] + pc[1]) + (pc[2] + pc[3]); sq += __shfl_xor(sq, 1); sq += __shfl_xor(sq, 2);
          const float rs = rsqrtf(sq * (1.0f / 1024.0f) + EPS); float* x = a->out + (size_t)row * 1024;
#pragma unroll
          for (int i = 0; i < 4; ++i) *(f32x4*)(x + i * 256 + lane * 4) = vc[i] * rs * gv[i]; } }
}

extern "C" void kernel_launch(void* const* d_in, const int* in_sizes, int n_in, void* d_out, int out_size, void* d_ws, size_t ws_size, hipStream_t stream) {
    static int grid_blocks = 0;
    if (!grid_blocks) {
        int dev = 0, cus = 0, per_cu = 0;
        hipGetDevice(&dev);
        hipDeviceGetAttribute(&cus, hipDeviceAttributeMultiprocessorCount, dev);
        hipFuncSetAttribute((const void*)fwd_megakernel, hipFuncAttributeMaxDynamicSharedMemorySize, LDS_BYTES);
        hipOccupancyMaxActiveBlocksPerMultiprocessor(&per_cu, (const void*)fwd_megakernel, 512, LDS_BYTES);
        if (per_cu < 1) { fprintf(stderr, "occupancy query says %d blocks/CU\n", per_cu); per_cu = 1; }
        if (per_cu > 1) per_cu = 1;
        grid_blocks = cus * per_cu;
        if (n_in != 39 || ws_size < WS_END) fprintf(stderr, "kernel_launch: unexpected n_in %d / ws_size %zu (need %zu)\n", n_in, ws_size, (size_t)WS_END);
    }
    (void)hipMemsetAsync((unsigned char*)d_ws + OFF_BAR, 0, 16384, stream);
    KArgs a{};
    for (int i = 0; i < 39; ++i) a.in[i] = (const float*)d_in[i];
    a.out = (float*)d_out; a.ws = (unsigned char*)d_ws;
    void* args[] = {&a};
    hipError_t e = hipLaunchCooperativeKernel((const void*)fwd_megakernel, dim3(grid_blocks), dim3(512), args, LDS_BYTES, stream);
    if (e != hipSuccess) fprintf(stderr, "cooperative launch failed: %s (grid %d)\n", hipGetErrorString(e), grid_blocks);
}
```

```cpp
#include <hip/hip_runtime.h>
#include <hip/hip_cooperative_groups.h>
#include <cstdio>
namespace cg = cooperative_groups;

#define LAS __attribute__((address_space(3)))
typedef unsigned short bf16_t;
typedef short bf16x8 __attribute__((ext_vector_type(8)));
typedef float f32x4 __attribute__((ext_vector_type(4)));
typedef unsigned u32x4 __attribute__((ext_vector_type(4)));
typedef unsigned u32x2 __attribute__((ext_vector_type(2)));

constexpr int D = 1024, SEQ = 2048, NBATCH = 8, MP = 16384, MS = 128, MT = MP + MS;
constexpr int INW = 5632, DFF = 2816, WB = 512, NG = 32, NPC = 64, NLAYER = 2;
constexpr int NCHK = 1024;
constexpr int KS5 = 384;
constexpr float EPS = 1e-6f;

constexpr size_t O_PLC = 16908288, O_PLH = 16957440, O_PCC = 16973824, O_PSR = 17219584, O_PSI = 17252352,
                 O_SLC = 17285120, O_SLH = 18071552, O_SCC = 18333696, O_SSR = 22265856, O_SSI = 22790144;

constexpr size_t SZ34 = (size_t)MT * 1024 * 2, SZ17 = (size_t)MT * 512 * 2;
constexpr size_t OFF_WIN = 0;
constexpr size_t OFF_WGT = OFF_WIN + (size_t)5632 * 1024 * 2;
constexpr size_t OFF_WGLU = OFF_WGT + (size_t)2048 * 256 * 2;
constexpr size_t OFF_WPA = OFF_WGLU + (size_t)512 * 512 * 2;
constexpr size_t OFF_WPB = OFF_WPA + (size_t)1024 * 1024 * 2;
constexpr size_t OFF_WPC = OFF_WPB + (size_t)1024 * 512 * 2;
constexpr size_t OFF_WOUT = OFF_WPC + (size_t)1024 * 512 * 2;
constexpr size_t OFF_WF1 = OFF_WOUT + (size_t)1024 * 1024 * 2;
constexpr size_t OFF_WF2 = OFF_WF1 + (size_t)5632 * 1024 * 2;
constexpr size_t OFF_TF = OFF_WF2 + (size_t)1024 * 2816 * 2;
constexpr size_t OFF_ET = OFF_TF + (size_t)32 * 256 * KS5 * 2;
constexpr size_t OFF_TAB = OFF_ET + (size_t)(32 * 128 + 128) * 256 * 2;
constexpr int TAB_LAM = 4096 + 4096 + 65536;
constexpr size_t OFF_RSQ = OFF_TAB + (size_t)(TAB_LAM + 1024) * 4;
constexpr size_t OFF_RSQ2 = OFF_RSQ + (size_t)MT * 16 * 4;
constexpr size_t OFF_XB = OFF_RSQ2 + (size_t)MT * 16 * 4;
constexpr size_t OFF_SA = OFF_XB + SZ34;
constexpr size_t OFF_SB = OFF_SA + SZ34;
constexpr size_t OFF_SC = OFF_SB + SZ34;
constexpr size_t OFF_UCG = OFF_SC + SZ34;
constexpr size_t OFF_UCS = OFF_UCG + (size_t)32 * 1024 * KS5 * 2;
constexpr size_t OFF_SE = OFF_UCS + (size_t)128 * 512 * 2;
constexpr size_t OFF_YB = OFF_SE + SZ17;
constexpr size_t OFF_SF = OFF_YB + SZ17;
constexpr size_t SZG8 = (((size_t)MT * 3072) + 255) & ~(size_t)255;
constexpr size_t OFF_GT8 = OFF_SB;
constexpr int G8_SPLIT = 11008;
static_assert((size_t)G8_SPLIT * 3072 == SZ34 && (size_t)(MT - G8_SPLIT) * 3072 <= (size_t)32 * 1024 * KS5 * 2, "gate array placement");
constexpr size_t OFF_MRG = OFF_SC;
constexpr size_t OFF_BAR = OFF_SF + SZ17;
constexpr size_t WS_END = OFF_BAR + 16384;
static_assert((size_t)32 * 1024 * 128 * 4 <= SZ17, "ends fits");
static_assert((size_t)MT * 2816 * 2 <= 3 * SZ34, "act fits");
static_assert(WS_END <= (size_t)256 * 1024 * 1024, "workspace");

constexpr int LDS_BYTES = 128 * 1024 + 1024;

struct KArgs { const float* in[39]; float* out; unsigned char* ws; };
typedef const __attribute__((address_space(4))) KArgs* KArgsP;
__device__ __forceinline__ KArgsP kargs() { auto p = __builtin_amdgcn_kernarg_segment_ptr(); asm volatile("" : "+s"(p)); return (KArgsP)p; }

__device__ __forceinline__ unsigned cvt_pk_bf16(float lo, float hi) { unsigned r; asm volatile("v_cvt_pk_bf16_f32 %0, %1, %2" : "=v"(r) : "v"(lo), "v"(hi)); return r; }
__device__ __forceinline__ bf16_t f2bf(float f) { return (bf16_t)(cvt_pk_bf16(f, 0.f) & 0xffffu); }
__device__ __forceinline__ float bf2f(unsigned b) { return __uint_as_float(b << 16); }
__device__ __forceinline__ void store8(bf16_t* p, const float* v) { u32x4 w; w.x = cvt_pk_bf16(v[0], v[1]); w.y = cvt_pk_bf16(v[2], v[3]); w.z = cvt_pk_bf16(v[4], v[5]); w.w = cvt_pk_bf16(v[6], v[7]); *(u32x4*)p = w; }
__device__ __forceinline__ void store4(bf16_t* p, const f32x4 v) { u32x2 w; w.x = cvt_pk_bf16(v[0], v[1]); w.y = cvt_pk_bf16(v[2], v[3]); *(u32x2*)p = w; }
struct PkSt { u32x2 pk[2]; };
template <int SLOT> __device__ __forceinline__ void wstore(PkSt& ps, const int n, bf16_t* p, const f32x4 v) {
    u32x2 w; w.x = cvt_pk_bf16(v[0], v[1]); w.y = cvt_pk_bf16(v[2], v[3]);
    if (n == 0) ps.pk[SLOT] = w; else { u32x4 q; q.x = ps.pk[SLOT].x; q.y = ps.pk[SLOT].y; q.z = w.x; q.w = w.y; *(u32x4*)(p - 4) = q; }
}
__device__ __forceinline__ void unpack8(const u32x4 w, float* v) {
    v[0] = __uint_as_float(w.x << 16); v[1] = __uint_as_float(w.x & 0xffff0000u); v[2] = __uint_as_float(w.y << 16); v[3] = __uint_as_float(w.y & 0xffff0000u);
    v[4] = __uint_as_float(w.z << 16); v[5] = __uint_as_float(w.z & 0xffff0000u); v[6] = __uint_as_float(w.w << 16); v[7] = __uint_as_float(w.w & 0xffff0000u); }
__device__ __forceinline__ void load8(const bf16_t* p, float* v) { unpack8(*(const u32x4*)p, v); }
__device__ __forceinline__ size_t g8row(int row) { return (size_t)row * 3072 + (row >= G8_SPLIT ? SZ34 : (size_t)0); }
__device__ __forceinline__ float sigm(float x) { return __builtin_amdgcn_rcpf(1.0f + __expf(-x)); }
template <int CTRL> __device__ __forceinline__ float dppx(float v) { return __int_as_float(__builtin_amdgcn_update_dpp(0, __float_as_int(v), CTRL, 0xf, 0xf, false)); }
__device__ __forceinline__ float wave_sum(float v) {
    v += dppx<0xB1>(v); v += dppx<0x4E>(v); v += dppx<0x141>(v); v += dppx<0x140>(v);
    { auto r = __builtin_amdgcn_permlane16_swap(__float_as_uint(v), __float_as_uint(v), false, false); v = __uint_as_float(r[0]) + __uint_as_float(r[1]); }
    { auto r = __builtin_amdgcn_permlane32_swap(__float_as_uint(v), __float_as_uint(v), false, false); v = __uint_as_float(r[0]) + __uint_as_float(r[1]); }
    return v;
}

__device__ __forceinline__ int otid() { int t = threadIdx.x; asm volatile("" : "+v"(t)); return t; }
__device__ __forceinline__ int oblk() { int t = blockIdx.x; asm volatile("" : "+s"(t)); return t; }
constexpr int BM = 256, BK = 64, HALF = 128, HTB = HALF * BK * 2, NXCD = 8, WGM = 8;
__device__ __forceinline__ int lds_byte(int r, int c) { const int st = (r >> 4) * 2 + (c >> 5), rr = r & 15, cc = c & 31, ob = rr * 64 + cc * 2; return st * 1024 + (ob ^ (((ob >> 9) & 1) << 5)); }
__device__ __forceinline__ void stage_rc(int b, int& R, int& C) { const int st = b / 1024, sb = b % 1024, swz = sb ^ (((sb >> 9) & 1) << 5); R = (st >> 1) * 16 + swz / 64; C = (st & 1) * 32 + (swz % 64) / 2; }
__device__ __forceinline__ int perm32(int rho) { const int n = rho >> 4, i = rho & 15; return 8 * (i >> 2) + 4 * n + (i & 3); }

struct Unit { int pm, pn, g, sm, fin; const char* A; const char* B; };
struct Sched {
    int nM, nN, nGrp, G, c, bd; const char* A;     const char* B; size_t a_g, b_g, a_pm, b_pn; long L0 = 0, Lend = (1L << 40);
    __device__ __forceinline__ bool next(int i, Unit& u) const {
        const long L = L0 + (long)i * G + c; const int nwg = nM * nN; if (L >= (long)nwg * nGrp || L >= Lend) return false;
        const int g = (int)(L / nwg); int wgid = (int)(L % nwg);
        { const int q = nwg / NXCD, r = nwg % NXCD, xcd = wgid % NXCD, off = wgid / NXCD; wgid = (xcd < r ? xcd * (q + 1) : r * (q + 1) + (xcd - r) * q) + off; }
        const int nig = WGM * nN, gid = wgid / nig, fm = gid * WGM, gsz = (nM - fm) < WGM ? (nM - fm) : WGM;
        u.pm = fm + ((wgid % nig) % gsz); u.pn = (wgid % nig) / gsz; u.g = g; u.sm = 0; u.fin = 1;
        u.A = A + (size_t)g * a_g + (size_t)u.pm * a_pm + (bd ? (size_t)(u.pn >> 1) * 512 : 0); u.B = B + (size_t)g * b_g + (size_t)u.pn * b_pn; return true;
    }
};

struct SchedM3 {
    int G, c; const char* YA; const char* YB; const char* YC; const char* WPA; const char* WPB; const char* WPC;
    __device__ __forceinline__ bool next(int i, Unit& u) const {
        const int rnd = i / 3, seg = i - rnd * 3; int wgid = c + rnd * G; if (wgid >= 256) return false;
        { const int q = 256 / NXCD, xcd = wgid % NXCD, off = wgid / NXCD; wgid = xcd * q + off; }
        const int nig = WGM * 4, gid = wgid / nig, fm = gid * WGM;
        u.pm = fm + ((wgid % nig) % WGM); u.pn = (wgid % nig) / WGM; u.g = seg; u.sm = seg ? 1 : 0; u.fin = (seg == 2);
        const size_t pa = (size_t)u.pm * 256 * 2, pb = (size_t)u.pn * 256 * 2;
        if (seg == 0) { u.A = YA + pa * 1024; u.B = WPA + pb * 1024; }
        else if (seg == 1) { u.A = YB + pa * 512; u.B = WPB + pb * 512; }
        else { u.A = YC + pa * 512; u.B = WPC + pb * 512; }
        return true;
    }
};

template <class F, class SC, bool MIX>
__device__ __forceinline__ void gemm_phase_t(LAS unsigned char* lds, const int lda, const int ldb, const int nt_, const SC& S, const F& E) {
    const int tid = otid(), wid = __builtin_amdgcn_readfirstlane(tid >> 6), lane = tid & 63, wr = wid >> 2, wc = wid & 3, fr = lane & 15, fq = lane >> 4;
    unsigned voffA[2], voffB[2];
#pragma unroll
    for (int i = 0; i < 2; ++i) { int R, C; stage_rc(tid * 16 + i * 8192, R, C); const int Rb = (R & ~31) + perm32(R & 31);
        voffA[i] = (unsigned)(R * (MIX ? 512 : lda) + C) * 2u; voffB[i] = (unsigned)(Rb * (MIX ? 512 : ldb) + C) * 2u; }
    const size_t kstep = (size_t)(BK * 2);
    const size_t hA0 = (size_t)HALF * lda * 2, hB0 = (size_t)HALF * ldb * 2;
    const unsigned ldsw = (unsigned)wid * 1024u;
    const int aoff = lds_byte(wr * 64 + fr, fq * 8), boff = lds_byte(wc * 32 + fr, fq * 8);
#define PG8_SA(b, h) (((b) * 2 + (h)) * HTB)
#define PG8_SB(b, h) ((4 + (b) * 2 + (h)) * HTB)
#define PG8_STAGE(bufoff, gbase, voff, m2) do { _Pragma("unroll") for (int _i = 0; _i < 2; ++_i) \
        __builtin_amdgcn_global_load_lds((const unsigned*)((const char*)(gbase) + ((voff)[_i] + ((voff)[_i] & (m2)))), (LAS unsigned*)(lds + (bufoff) + ldsw + _i * 8192), 16, 0, 0); } while (0)
#define PG8_LDA(dst, b, h) do { _Pragma("unroll") for (int m = 0; m < 4; ++m) _Pragma("unroll") for (int k = 0; k < 2; ++k) dst[m][k] = *(const LAS bf16x8*)(lds + PG8_SA(b, h) + aoff + m * 2048 + k * 1024); } while (0)
#define PG8_LDB(dst, b, h) do { _Pragma("unroll") for (int n = 0; n < 2; ++n) _Pragma("unroll") for (int k = 0; k < 2; ++k) dst[n][k] = *(const LAS bf16x8*)(lds + PG8_SB(b, h) + boff + n * 2048 + k * 1024); } while (0)
#define PG8_MMA(ai, bj, At, Bt) do { __builtin_amdgcn_s_setprio(1); _Pragma("unroll") for (int m = 0; m < 4; ++m) _Pragma("unroll") for (int n = 0; n < 2; ++n) _Pragma("unroll") for (int k = 0; k < 2; ++k) \
        acc[ai][bj][m][n] = __builtin_amdgcn_mfma_f32_16x16x32_bf16(Bt[n][k], At[m][k], acc[ai][bj][m][n], 0, 0, 0); __builtin_amdgcn_s_setprio(0); } while (0)
#define PG8_WAIT_V(n) asm volatile("s_waitcnt vmcnt(" #n ")" ::: "memory")
#define PG8_WAIT_L(n) asm volatile("s_waitcnt lgkmcnt(" #n ")" ::: "memory")
#define PG8_BAR __builtin_amdgcn_s_barrier()
#define PG8_SCHED __builtin_amdgcn_sched_barrier(0)
    Unit cur, nxt; int ui = 0;
    if (!S.next(0, cur)) return;
    f32x4 acc[2][2][4][2];
    if constexpr (F::ACC_INIT) E.init(acc, cur.pm, cur.pn, wr, wc, fr, fq); else {
#pragma unroll
    for (int a = 0; a < 2; ++a)
#pragma unroll
        for (int b = 0; b < 2; ++b)
#pragma unroll
            for (int m = 0; m < 4; ++m)
#pragma unroll
                for (int n = 0; n < 2; ++n) acc[a][b][m][n] = (f32x4){0.f, 0.f, 0.f, 0.f};
    }
    bf16x8 At[4][2], B0[2][2], B1[2][2];
    const char* cA = cur.A; const char* cB = cur.B;
    unsigned cm = (MIX && !cur.sm) ? ~1023u : 0u; size_t hA = MIX ? (cur.sm ? (size_t)131072 : (size_t)262144) : hA0, hB = MIX ? hA : hB0; int nt = MIX ? (cur.sm ? 8 : 16) : nt_;
    PG8_STAGE(PG8_SB(0, 0), cB, voffB, cm); PG8_STAGE(PG8_SA(0, 0), cA, voffA, cm); PG8_STAGE(PG8_SB(0, 1), cB + hB, voffB, cm); PG8_STAGE(PG8_SA(0, 1), cA + hA, voffA, cm);
    if (wr == 1) PG8_BAR;
    PG8_WAIT_V(4); PG8_BAR;
    PG8_STAGE(PG8_SB(1, 0), cB + kstep, voffB, cm); PG8_STAGE(PG8_SA(1, 0), cA + kstep, voffA, cm); PG8_STAGE(PG8_SB(1, 1), cB + hB + kstep, voffB, cm);
    PG8_WAIT_V(6); PG8_BAR;
    for (;;) {
        const bool has_next = S.next(ui + 1, nxt);
        const char* nA = has_next ? nxt.A : cA; const char* nB = has_next ? nxt.B : cB;
        const unsigned nm = (MIX && has_next) ? (nxt.sm ? 0u : ~1023u) : cm;
        const size_t nhA = (MIX && has_next) ? (nxt.sm ? (size_t)131072 : (size_t)262144) : hA, nhB = MIX ? nhA : hB;
#pragma unroll 1
        for (int t = 0; t < nt; t += 2) {
            const bool last = (t == nt - 2);
            const char* a1 = cA + (size_t)(t + 1) * kstep;
            const char* a2 = last ? nA : cA + (size_t)(t + 2) * kstep; const char* b2 = last ? nB : cB + (size_t)(t + 2) * kstep;
            const char* a3 = a2 + kstep; const char* b3 = b2 + kstep;
            const unsigned m2 = (MIX && last) ? nm : cm; const size_t h2A = (MIX && last) ? nhA : hA, h2B = (MIX && last) ? nhB : hB;
            PG8_LDB(B0, 0, 0); PG8_SCHED; PG8_LDA(At, 0, 0); PG8_STAGE(PG8_SA(1, 1), a1 + hA, voffA, cm);
            PG8_WAIT_L(8); PG8_BAR; PG8_WAIT_L(0); PG8_MMA(0, 0, At, B0); PG8_BAR; PG8_SCHED;
            PG8_LDB(B1, 0, 1); PG8_STAGE(PG8_SB(0, 0), b2, voffB, m2);
            PG8_BAR; PG8_WAIT_L(0); PG8_MMA(0, 1, At, B1); PG8_BAR;
            PG8_LDA(At, 0, 1); PG8_STAGE(PG8_SA(0, 0), a2, voffA, m2);
            PG8_BAR; PG8_WAIT_L(0); PG8_MMA(1, 0, At, B0); PG8_BAR; PG8_SCHED;
            PG8_STAGE(PG8_SB(0, 1), b2 + h2B, voffB, m2);
            PG8_WAIT_V(6); PG8_BAR; PG8_MMA(1, 1, At, B1); PG8_BAR;
            PG8_LDB(B0, 1, 0); PG8_SCHED; PG8_LDA(At, 1, 0); PG8_STAGE(PG8_SA(0, 1), a2 + h2A, voffA, m2);
            PG8_WAIT_L(8); PG8_BAR; PG8_WAIT_L(0); PG8_MMA(0, 0, At, B0); PG8_BAR; PG8_SCHED;
            PG8_LDB(B1, 1, 1); PG8_STAGE(PG8_SB(1, 0), b3, voffB, m2);
            PG8_BAR; PG8_WAIT_L(0); PG8_MMA(0, 1, At, B1); PG8_BAR;
            PG8_LDA(At, 1, 1); PG8_STAGE(PG8_SA(1, 0), a3, voffA, m2);
            PG8_BAR; PG8_WAIT_L(0); PG8_MMA(1, 0, At, B0); PG8_BAR; PG8_SCHED;
            PG8_STAGE(PG8_SB(1, 1), b3 + h2B, voffB, m2);
            PG8_WAIT_V(6); PG8_BAR; PG8_MMA(1, 1, At, B1); PG8_BAR;
        }
        {
            int row0 = cur.pm * BM + wr * 64 + fr; asm volatile("" : "+v"(row0));
            const typename F::UCtx uc = E.unit_ctx(cur.pn, wc, fq, cur.g);
            typename F::Pre pre = E.row_pre(row0, fq, cur.pn, wc, cur.g);
#pragma unroll
            for (int rg = 0; rg < 8; ++rg) { const int ai = rg >> 2, m = rg & 3;
                int row = cur.pm * BM + ai * HALF + wr * 64 + m * 16 + fr;
                asm volatile("" : "+v"(row));
                typename F::Pre pre_n = pre;
                if (rg < 7) { int rown = cur.pm * BM + ((rg + 1) >> 2) * HALF + wr * 64 + ((rg + 1) & 3) * 16 + fr; asm volatile("" : "+v"(rown)); pre_n = E.row_pre(rown, fq, cur.pn, wc, cur.g); }
                typename F::State st; E.row_begin(st, pre); PkSt ps;
#pragma unroll
                for (int n = 0; n < 2; ++n) { E.op(st, ps, uc, row, cur.pn, cur.g, wc * 32 + 8 * fq + 4 * n, n, acc[ai][0][m][n], acc[ai][1][m][n]); }
                E.row_end(st, row, cur.pn, wc);
                pre = pre_n;
            }
        }
        if (!has_next) break;
        if constexpr (F::ACC_INIT) E.init(acc, nxt.pm, nxt.pn, wr, wc, fr, fq); else if (!MIX || cur.fin) {
#pragma unroll
        for (int a = 0; a < 2; ++a)
#pragma unroll
            for (int b = 0; b < 2; ++b)
#pragma unroll
                for (int m = 0; m < 4; ++m)
#pragma unroll
                    for (int n = 0; n < 2; ++n) acc[a][b][m][n] = (f32x4){0.f, 0.f, 0.f, 0.f};
        }
        cur = nxt; cA = nA; cB = nB; ++ui;
        if (MIX) { cm = nm; hA = nhA; hB = nhB; nt = cur.sm ? 8 : 16; }
    }
    PG8_WAIT_V(0);
    if (wr == 0) PG8_BAR;
    PG8_BAR;
#undef PG8_SA
#undef PG8_SB
#undef PG8_STAGE
#undef PG8_LDA
#undef PG8_LDB
#undef PG8_MMA
#undef PG8_WAIT_V
#undef PG8_WAIT_L
#undef PG8_BAR
#undef PG8_SCHED
}

template <class F>
__device__ __forceinline__ void gemm_phase(LAS unsigned char* lds, const int lda, const int ldb, const int nt, const Sched& S, const F& E) { gemm_phase_t<F, Sched, false>(lds, lda, ldb, nt, S, E); }

template <class F>
__device__ __forceinline__ void thin_gemm(LAS unsigned char* lds, const bf16_t* A, const int lda, const bf16_t* Bt, const int ldb, const int K, const int nN, const int bd, const F& E, const int bi, const int nb) {
    const int tid = otid(), wid = tid >> 6, lane = tid & 63, fr = lane & 15, fq = lane >> 4;
    LAS f32x4* red = (LAS f32x4*)lds;
    const int nitems = 8 * nN * 4, kw = K >> 3;
    if (bi >= 0) for (int item = bi; item < nitems; item += nb) {
        const int rg = item & 7, wc = (item >> 3) & 3, pn = item >> 5;
        const bf16_t* ap = A + (size_t)(MP + 16 * rg + fr) * lda + (bd ? (pn >> 1) * 256 : 0) + wid * kw + 8 * fq;
        const bf16_t* bp[4];
#pragma unroll
        for (int n = 0; n < 4; ++n) bp[n] = Bt + (size_t)(256 * pn + 128 * (n >> 1) + 32 * wc + 8 * (fr >> 2) + 4 * (n & 1) + (fr & 3)) * ldb + wid * kw + 8 * fq;
        f32x4 acc[4];
#pragma unroll
        for (int n = 0; n < 4; ++n) acc[n] = (f32x4){0.f, 0.f, 0.f, 0.f};
        for (int kb = 0; kb < kw; kb += 128) {
            bf16x8 av[4], bv[4][4];
#pragma unroll
            for (int i = 0; i < 4; ++i) if (kb + 32 * i < kw) { av[i] = *(const bf16x8*)(ap + kb + 32 * i);
#pragma unroll
                for (int n = 0; n < 4; ++n) bv[i][n] = *(const bf16x8*)(bp[n] + kb + 32 * i); }
#pragma unroll
            for (int i = 0; i < 4; ++i) if (kb + 32 * i < kw) {
#pragma unroll
                for (int n = 0; n < 4; ++n) acc[n] = __builtin_amdgcn_mfma_f32_16x16x32_bf16(bv[i][n], av[i], acc[n], 0, 0, 0); }
        }
#pragma unroll
        for (int n = 0; n < 4; ++n) red[(wid * 4 + n) * 64 + lane] = acc[n];
        __syncthreads();
        if (wid == 0) {
            f32x4 sv[4];
#pragma unroll
            for (int n = 0; n < 4; ++n) { f32x4 s = red[n * 64 + lane];
#pragma unroll
                for (int w = 1; w < 8; ++w) s += red[(w * 4 + n) * 64 + lane];
                sv[n] = s; }
            const int row = MP + 16 * rg + fr; typename F::State st; E.row_begin(st, E.row_pre(row, fq, pn, wc, 0));
            const typename F::UCtx uc = E.unit_ctx(pn, wc, fq, 0);
            PkSt ps;
#pragma unroll
            for (int n = 0; n < 2; ++n) E.op(st, ps, uc, row, pn, 0, wc * 32 + 8 * fq + 4 * n, n, sv[n], sv[2 + n]);
            E.row_end(st, row, pn, wc);
        }
        __syncthreads();
    }
}

__device__ __forceinline__ void thin_merge(LAS unsigned char* lds, const bf16_t* YA, const bf16_t* YB, const bf16_t* YC, const bf16_t* WPA, const bf16_t* WPB, const bf16_t* WPC,
                                           const unsigned char* g8, bf16_t* mrg, const int bi, const int nb) {
    const int tid = otid(), wid = tid >> 6, lane = tid & 63, fr = lane & 15, fq = lane >> 4;
    LAS f32x4* red = (LAS f32x4*)lds;
    for (int item = bi; item < 8 * 4 * 4; item += nb) {
        const int rg = item & 7, wc = (item >> 3) & 3, pn = item >> 5, row = MP + 16 * rg + fr;
        int brow[4];
#pragma unroll
        for (int n = 0; n < 4; ++n) brow[n] = 256 * pn + 128 * (n >> 1) + 32 * wc + 8 * (fr >> 2) + 4 * (n & 1) + (fr & 3);
        f32x4 tot[4];
#pragma unroll
        for (int n = 0; n < 4; ++n) tot[n] = (f32x4){0.f, 0.f, 0.f, 0.f};
#pragma unroll
        for (int seg = 0; seg < 3; ++seg) {
            const bf16_t* A = seg == 0 ? YA : (seg == 1 ? YB : YC); const bf16_t* B = seg == 0 ? WPA : (seg == 1 ? WPB : WPC);
            const int K = seg == 0 ? 1024 : 512, kw = K >> 3, nst = kw >> 5;
            bf16x8 av[4], bv[4][4]; unsigned gw[4];
#pragma unroll
            for (int i = 0; i < 4; ++i) if (i < nst) { av[i] = *(const bf16x8*)(A + (size_t)row * K + wid * kw + 32 * i + 8 * fq);
#pragma unroll
                for (int n = 0; n < 4; ++n) bv[i][n] = *(const bf16x8*)(B + (size_t)brow[n] * K + wid * kw + 32 * i + 8 * fq); }
#pragma unroll
            for (int n = 0; n < 4; ++n) gw[n] = *(const unsigned*)(g8 + g8row(row) + seg * 1024 + 256 * pn + 128 * (n >> 1) + 32 * wc + 8 * fq + 4 * (n & 1));
            f32x4 acc[4];
#pragma unroll
            for (int n = 0; n < 4; ++n) acc[n] = (f32x4){0.f, 0.f, 0.f, 0.f};
#pragma unroll
            for (int i = 0; i < 4; ++i) if (i < nst) {
#pragma unroll
                for (int n = 0; n < 4; ++n) acc[n] = __builtin_amdgcn_mfma_f32_16x16x32_bf16(bv[i][n], av[i], acc[n], 0, 0, 0); }
#pragma unroll
            for (int n = 0; n < 4; ++n) tot[n] += acc[n] * ((f32x4){(float)(gw[n] & 255u), (float)((gw[n] >> 8) & 255u), (float)((gw[n] >> 16) & 255u), (float)(gw[n] >> 24)} * (1.0f / 255.0f));
        }
#pragma unroll
        for (int n = 0; n < 4; ++n) red[(wid * 4 + n) * 64 + lane] = tot[n];
        __syncthreads();
        if (wid == 0) {
#pragma unroll
            for (int n = 0; n < 4; ++n) { f32x4 sv = red[n * 64 + lane];
#pragma unroll
                for (int w = 1; w < 8; ++w) sv += red[(w * 4 + n) * 64 + lane];
                store4(mrg + (size_t)row * 1024 + 256 * pn + 128 * (n >> 1) + 32 * wc + 8 * fq + 4 * (n & 1), sv); }
        }
        __syncthreads();
    }
}

__device__ __forceinline__ f32x4 load4(const bf16_t* p) { const u32x2 w = *(const u32x2*)p; return (f32x4){__uint_as_float(w.x << 16), __uint_as_float(w.x & 0xffff0000u), __uint_as_float(w.y << 16), __uint_as_float(w.y & 0xffff0000u)}; }
__device__ __forceinline__ f32x4 sigm4(const f32x4 x) { return (f32x4){sigm(x[0]), sigm(x[1]), sigm(x[2]), sigm(x[3])}; }
__device__ __forceinline__ float row_rs4(const float* rsq, int row, int fq) {
    const f32x4 a = *(const f32x4*)(rsq + (size_t)row * 16 + fq * 4); float s = (a[0] + a[1]) + (a[2] + a[3]);
    s += __shfl_xor(s, 16); s += __shfl_xor(s, 32); return rsqrtf(s * (1.0f / 1024.0f) + EPS);
}
__device__ __forceinline__ float sum_fq4(float s) {
    { auto r = __builtin_amdgcn_permlane16_swap(__float_as_uint(s), __float_as_uint(s), false, false); s = __uint_as_float(r[0]) + __uint_as_float(r[1]); }
    { auto r = __builtin_amdgcn_permlane32_swap(__float_as_uint(s), __float_as_uint(s), false, false); s = __uint_as_float(r[0]) + __uint_as_float(r[1]); }
    return s;
}
__device__ __forceinline__ float rs_from4(const f32x4 a) { const float s = sum_fq4((a[0] + a[1]) + (a[2] + a[3])); return rsqrtf(s * (1.0f / 1024.0f) + EPS); }
__device__ __forceinline__ float row_rs(const float* rsq, int row) {
    const f32x4* p = (const f32x4*)(rsq + (size_t)row * 16); const f32x4 a = p[0], b = p[1], c = p[2], d = p[3];
    const float s = ((a[0] + a[1]) + (a[2] + a[3])) + ((b[0] + b[1]) + (b[2] + b[3])) + ((c[0] + c[1]) + (c[2] + c[3])) + ((d[0] + d[1]) + (d[2] + d[3]));
    return rsqrtf(s * (1.0f / 1024.0f) + EPS);
}
struct StNone { };
struct StF { float x; };
struct F1 {
    typedef StF State;
    static constexpr bool ACC_INIT = false;
    typedef StNone UCtx;
    __device__ __forceinline__ UCtx unit_ctx(int, int, int, int) const { return UCtx(); }
    const float* rsq; bf16_t* ua; bf16_t* glu; bf16_t* ucg; bf16_t* ucs;
    typedef f32x4 Pre;
    __device__ __forceinline__ Pre row_pre(int row, int fq, int, int, int) const { return *(const f32x4*)(rsq + (size_t)row * 16 + fq * 4); }
    __device__ __forceinline__ void row_begin(State& st, const Pre& p) const { st.x = rs_from4(p); }
    __device__ __forceinline__ void row_end(State&, int, int, int) const {}
    __device__ __forceinline__ void op(State& st, PkSt& ps, const UCtx& uc, int row, int pn, int, int lc, const int n, f32x4& a, f32x4& b) const {
        if (row >= MT) return;
        const f32x4 va = a * st.x, vb = b * st.x;
        if (pn < 4) { bf16_t* p = ua + (size_t)row * 1024 + pn * 256 + lc; wstore<0>(ps, n, p, va); wstore<1>(ps, n, p + 128, vb); }
        else if (pn < 8) wstore<0>(ps, n, glu + (size_t)row * 512 + (pn - 4) * 128 + lc, va * sigm4(vb));
        else {
#pragma unroll
            for (int h = 0; h < 2; ++h) { const int cc = (pn - 8) * 256 + lc + 128 * h; bf16_t* dst;
                if (row < MP) dst = ucg + ((size_t)(cc >> 4) * NCHK + (row >> 4)) * KS5 + (row & 15) * 16 + (cc & 15);
                else dst = ucs + (size_t)(row - MP) * 512 + cc;
                if (h) wstore<1>(ps, n, dst, vb); else wstore<0>(ps, n, dst, va); }
        }
    }
};
struct StU4 { u32x4 v; };
struct F2 {
    typedef StU4 State; typedef StU4 Pre;
    static constexpr bool ACC_INIT = false;
    struct UCtx { f32x4 brg[2], big[2], lm[2]; };
    __device__ __forceinline__ UCtx unit_ctx(int pn, int wc, int fq, int) const { UCtx u; const int ch = pn * 128 + wc * 32 + 8 * fq;
#pragma unroll
        for (int n = 0; n < 2; ++n) { u.brg[n] = *(const f32x4*)(b_rg + ch + 4 * n); u.big[n] = *(const f32x4*)(b_ig + ch + 4 * n); u.lm[n] = *(const f32x4*)(lam + ch + 4 * n); }
        return u; }
    const bf16_t* ca; const float* b_rg; const float* b_ig; const float* lam; const float* h0; bf16_t* la; bf16_t* bx; float* out_h;
    __device__ __forceinline__ Pre row_pre(int row, int fq, int pn, int wc, int) const { Pre p; p.v = *(const u32x4*)(ca + (size_t)row * 1024 + pn * 128 + wc * 32 + 8 * fq); return p; }
    __device__ __forceinline__ void row_begin(State& st, const Pre& p) const { st = p; }
    __device__ __forceinline__ void row_end(State&, int, int, int) const {}
    __device__ __forceinline__ void op(State& st, PkSt& ps, const UCtx& uc, int row, int pn, int, int lc, const int n, f32x4& a, f32x4& b) const {
        const int ch0 = pn * 128 + lc; const unsigned w0 = n ? st.v.z : st.v.x, w1 = n ? st.v.w : st.v.y;
        const f32x4 c4 = (f32x4){__uint_as_float(w0 << 16), __uint_as_float(w0 & 0xffff0000u), __uint_as_float(w1 << 16), __uint_as_float(w1 & 0xffff0000u)};
        const f32x4 r = sigm4(a + uc.brg[n]), ig = sigm4(b + uc.big[n]), l_a = r * uc.lm[n];
        f32x4 bxv;
#pragma unroll
        for (int j = 0; j < 4; ++j) bxv[j] = __builtin_amdgcn_sqrtf(fmaxf(1.0f - __expf(2.0f * l_a[j]), 0.f)) * ig[j] * c4[j];
        if (row < MP) { wstore<0>(ps, n, la + (size_t)row * 1024 + ch0, l_a); wstore<1>(ps, n, bx + (size_t)row * 1024 + ch0, bxv); }
        else { const size_t o = (size_t)(row - MP) * 1024 + ch0; const f32x4 hp = *(const f32x4*)(h0 + o); f32x4 h;
#pragma unroll
            for (int j = 0; j < 4; ++j) h[j] = __expf(l_a[j]) * hp[j] + bxv[j];
            *(f32x4*)(out_h + o) = h; wstore<0>(ps, n, la + (size_t)row * 1024 + ch0, h); }
    }
};
struct FEnd {
    typedef StNone State;
    static constexpr bool ACC_INIT = false;
    typedef StNone UCtx;
    __device__ __forceinline__ UCtx unit_ctx(int, int, int, int) const { return UCtx(); }
    float* ends;
    typedef StNone Pre;
    __device__ __forceinline__ Pre row_pre(int, int, int, int, int) const { return Pre(); }
    __device__ __forceinline__ void row_begin(State&, const Pre&) const {}
    __device__ __forceinline__ void row_end(State&, int, int, int) const {}
    __device__ __forceinline__ void op(State&, PkSt& ps, const UCtx& uc, int row, int, int g, int lc, const int n, f32x4& a, f32x4&) const { *(f32x4*)(ends + ((size_t)g * NCHK + row) * 128 + lc) = a; }
};
__device__ __forceinline__ float gelu_tanh(float x) { const float u = 0.7978845608028654f * (x + 0.044715f * x * x * x); return x * sigm(2.0f * u); }
struct StU8 { u32x2 v[4]; };
struct FS5 {
    typedef StU8 State; typedef StU8 Pre;
    static constexpr bool ACC_INIT = false;
    struct UCtx { f32x4 d[2]; };
    __device__ __forceinline__ UCtx unit_ctx(int, int, int fq, int g) const { UCtx u; u.d[0] = *(const f32x4*)(dsk + g * 16 + ((8 * fq) & 15)); u.d[1] = *(const f32x4*)(dsk + g * 16 + ((8 * fq + 4) & 15)); return u; }
    const bf16_t* ucg; const float* dsk; bf16_t* yc0;
    __device__ __forceinline__ Pre row_pre(int row, int fq, int, int wc, int g) const { Pre p; const bf16_t* base = ucg + ((size_t)g * NCHK + row) * KS5 + wc * 32 + 8 * fq;
#pragma unroll
        for (int h = 0; h < 2; ++h) { const u32x4 q = *(const u32x4*)(base + 128 * h); p.v[h] = (u32x2){q.x, q.y}; p.v[2 + h] = (u32x2){q.z, q.w}; }
        return p; }
    __device__ __forceinline__ void row_begin(State& st, const Pre& p) const { st = p; }
    __device__ __forceinline__ void row_end(State&, int, int, int) const {}
    __device__ __forceinline__ void op(State& st, PkSt& ps, const UCtx& uc, int row, int, int g, int lc, const int n, f32x4& a, f32x4& b) const {
#pragma unroll
        for (int h = 0; h < 2; ++h) { const int col = lc + 128 * h, i = col >> 4, c0 = col & 15; const u32x2 w = st.v[n * 2 + h];
            const f32x4 u4 = (f32x4){__uint_as_float(w.x << 16), __uint_as_float(w.x & 0xffff0000u), __uint_as_float(w.y << 16), __uint_as_float(w.y & 0xffff0000u)};
            const f32x4 y = (h ? b : a) + uc.d[n] * u4;
            const f32x4 gy = (f32x4){gelu_tanh(y[0]), gelu_tanh(y[1]), gelu_tanh(y[2]), gelu_tanh(y[3])}; bf16_t* dp = yc0 + (size_t)(row * 16 + i) * 512 + g * 16 + c0;
            if (h) wstore<1>(ps, n, dp, gy); else wstore<0>(ps, n, dp, gy); }
    }
};
struct F4 {
    typedef StU8 State; typedef StU8 Pre;
    static constexpr bool ACC_INIT = false;
    struct UCtx { f32x4 b[2][2]; };
    __device__ __forceinline__ UCtx unit_ctx(int pn, int wc, int fq, int) const { UCtx u; const float* p = bg + pn * 256 + wc * 32 + 8 * fq;
#pragma unroll
        for (int n = 0; n < 2; ++n)
#pragma unroll
            for (int h = 0; h < 2; ++h) u.b[n][h] = *(const f32x4*)(p + 128 * h + 4 * n);
        return u; }
    const bf16_t* yc0; const float* bg; bf16_t* yc;
    __device__ __forceinline__ Pre row_pre(int row, int fq, int pn, int wc, int) const { Pre p; const bf16_t* base = yc0 + (size_t)row * 512 + pn * 256 + wc * 32 + 8 * fq;
#pragma unroll
        for (int h = 0; h < 2; ++h) { const u32x4 q = *(const u32x4*)(base + 128 * h); p.v[h] = (u32x2){q.x, q.y}; p.v[2 + h] = (u32x2){q.z, q.w}; }
        return p; }
    __device__ __forceinline__ void row_begin(State& st, const Pre& p) const { st = p; }
    __device__ __forceinline__ void row_end(State&, int, int, int) const {}
    __device__ __forceinline__ void op(State& st, PkSt& ps, const UCtx& uc, int row, int pn, int, int lc, const int n, f32x4& a, f32x4& b) const {
#pragma unroll
        for (int h = 0; h < 2; ++h) { const int col = pn * 256 + lc + 128 * h; const u32x2 w = st.v[n * 2 + h];
            const f32x4 y4 = (f32x4){__uint_as_float(w.x << 16), __uint_as_float(w.x & 0xffff0000u), __uint_as_float(w.y << 16), __uint_as_float(w.y & 0xffff0000u)};
            const f32x4 yo = y4 * sigm4((h ? b : a) + uc.b[n][h]); if (h) wstore<1>(ps, n, yc + (size_t)row * 512 + col, yo); else wstore<0>(ps, n, yc + (size_t)row * 512 + col, yo); }
    }
};
struct FG8 {
    typedef StF State;
    static constexpr bool ACC_INIT = false;
    struct UCtx { f32x4 b[2][2]; };
    __device__ __forceinline__ UCtx unit_ctx(int pn, int wc, int fq, int) const { UCtx u; const float* p = bgate + pn * 256 + wc * 32 + 8 * fq;
#pragma unroll
        for (int n = 0; n < 2; ++n)
#pragma unroll
            for (int h = 0; h < 2; ++h) u.b[n][h] = *(const f32x4*)(p + 128 * h + 4 * n);
        return u; }
    const float* rsq; const float* bgate; unsigned char* g8;
    typedef f32x4 Pre;
    __device__ __forceinline__ Pre row_pre(int row, int fq, int, int, int) const { return *(const f32x4*)(rsq + (size_t)row * 16 + fq * 4); }
    __device__ __forceinline__ void row_begin(State& st, const Pre& p) const { st.x = rs_from4(p); }
    __device__ __forceinline__ void row_end(State&, int, int, int) const {}
    __device__ __forceinline__ void op(State& st, PkSt& ps, const UCtx& uc, int row, int pn, int, int lc, const int n, f32x4& a, f32x4& b) const {
#pragma unroll
        for (int h = 0; h < 2; ++h) { const int col = pn * 256 + lc + 128 * h; f32x4 g = sigm4((h ? b : a) * st.x + uc.b[(lc >> 2) & 1][h]) * 255.0f + 0.5f; g = __builtin_elementwise_max(g, (f32x4){1.f, 1.f, 1.f, 1.f});
            const unsigned gw = (unsigned)g[0] | ((unsigned)g[1] << 8) | ((unsigned)g[2] << 16) | ((unsigned)g[3] << 24);
            if (n == 0) ps.pk[h].x = gw; else *(u32x2*)(g8 + g8row(row) + col - 4) = (u32x2){ps.pk[h].x, gw}; }
    }
};
struct StG { unsigned w[8]; };
struct FMS {
    typedef StG State; typedef StG Pre;
    static constexpr bool ACC_INIT = false;
    typedef StNone UCtx;
    __device__ __forceinline__ UCtx unit_ctx(int, int, int, int) const { return UCtx(); }
    const unsigned char* g8; bf16_t* mrg;
    __device__ __forceinline__ Pre row_pre(int row, int fq, int pn, int wc, int seg) const { Pre p; const unsigned char* base = g8 + g8row(row) + seg * 1024 + pn * 256 + wc * 32 + 8 * fq;
#pragma unroll
        for (int h = 0; h < 2; ++h) { const u32x2 gnum = *(const u32x2*)(base + 128 * h); u32x2 gden = (u32x2){0x01010101u, 0x01010101u}; if (seg < 2) gden = *(const u32x2*)(base + 1024 + 128 * h);
            p.w[(0 * 2 + h) * 2] = gnum.x; p.w[(1 * 2 + h) * 2] = gnum.y; p.w[(0 * 2 + h) * 2 + 1] = gden.x; p.w[(1 * 2 + h) * 2 + 1] = gden.y; }
        return p; }
    __device__ __forceinline__ void row_begin(State& st, const Pre& p) const { st = p; }
    __device__ __forceinline__ void row_end(State&, int, int, int) const {}
    __device__ __forceinline__ void op(State& st, PkSt& ps, const UCtx& uc, int row, int pn, int seg, int lc, const int n, f32x4& a, f32x4& b) const {
#pragma unroll
        for (int h = 0; h < 2; ++h) { const unsigned gn = st.w[(n * 2 + h) * 2], gd = st.w[(n * 2 + h) * 2 + 1]; f32x4& v = h ? b : a;
            const f32x4 num = (f32x4){(float)(gn & 255u), (float)((gn >> 8) & 255u), (float)((gn >> 16) & 255u), (float)(gn >> 24)};
            if (seg < 2) { const f32x4 den = (f32x4){(float)(gd & 255u), (float)((gd >> 8) & 255u), (float)((gd >> 16) & 255u), (float)(gd >> 24)};
                v = v * num * (f32x4){__builtin_amdgcn_rcpf(den[0]), __builtin_amdgcn_rcpf(den[1]), __builtin_amdgcn_rcpf(den[2]), __builtin_amdgcn_rcpf(den[3])}; }
            else { const f32x4 mo = v * num * (1.0f / 255.0f); bf16_t* dp = mrg + (size_t)row * 1024 + pn * 256 + lc + 128 * h; if (h) wstore<1>(ps, n, dp, mo); else wstore<0>(ps, n, dp, mo); } }
    }
};
template <bool RES> struct F6T {
    typedef StF State;
    static constexpr bool ACC_INIT = !RES;
    typedef StNone UCtx;
    __device__ __forceinline__ UCtx unit_ctx(int, int, int, int) const { return UCtx(); }
    const float* xs_p; const float* xs_s; float* xd; bf16_t* xb; float* rsq;
    typedef StNone Pre;
    __device__ __forceinline__ Pre row_pre(int, int, int, int, int) const { return Pre(); }
    __device__ __forceinline__ void row_begin(State& st, const Pre&) const { st.x = 0.f; }
    __device__ __forceinline__ void row_end(State& st, int row, int pn, int wc) const {
        const float ss = sum_fq4(st.x);
        if ((__lane_id()) < 16) rsq[(size_t)row * 16 + pn * 4 + wc] = ss; }
    __device__ __forceinline__ void init(f32x4 (&acc)[2][2][4][2], int pm, int pn, int wr, int wc, int fr, int fq) const {
#pragma unroll
        for (int ai = 0; ai < 2; ++ai)
#pragma unroll
            for (int m = 0; m < 4; ++m) { const int row = pm * BM + ai * HALF + wr * 64 + m * 16 + fr;
                const float* src = ((row < MP) ? xs_p + (size_t)row * 1024 : xs_s + (size_t)(row - MP) * 1024) + pn * 256 + wc * 32 + 8 * fq;
#pragma unroll
                for (int bj = 0; bj < 2; ++bj)
#pragma unroll
                    for (int n = 0; n < 2; ++n) acc[ai][bj][m][n] = *(const f32x4*)(src + 128 * bj + 4 * n); }
    }
    __device__ __forceinline__ void op(State& st, PkSt& ps, const UCtx& uc, int row, int pn, int, int lc, const int n, f32x4& a, f32x4& b) const {
        const float* src = (row < MP) ? xs_p + (size_t)row * 1024 : xs_s + (size_t)(row - MP) * 1024;
#pragma unroll
        for (int h = 0; h < 2; ++h) { const int col = pn * 256 + lc + 128 * h; f32x4 v = (h ? b : a); if (RES) v += *(const f32x4*)(src + col);
            st.x += (v[0] * v[0] + v[1] * v[1]) + (v[2] * v[2] + v[3] * v[3]);
            *(f32x4*)(xd + (size_t)row * 1024 + col) = v; if (h) wstore<1>(ps, n, xb + (size_t)row * 1024 + col, v); else wstore<0>(ps, n, xb + (size_t)row * 1024 + col, v); }
    }
};
struct F7 {
    typedef StF State;
    static constexpr bool ACC_INIT = false;
    typedef StNone UCtx;
    __device__ __forceinline__ UCtx unit_ctx(int, int, int, int) const { return UCtx(); }
    const float* rsq; bf16_t* act;
    typedef f32x4 Pre;
    __device__ __forceinline__ Pre row_pre(int row, int fq, int, int, int) const { return *(const f32x4*)(rsq + (size_t)row * 16 + fq * 4); }
    __device__ __forceinline__ void row_begin(State& st, const Pre& p) const { st.x = rs_from4(p); }
    __device__ __forceinline__ void row_end(State&, int, int, int) const {}
    __device__ __forceinline__ void op(State& st, PkSt& ps, const UCtx& uc, int row, int pn, int, int lc, const int n, f32x4& a, f32x4& b) const {
        if (row >= MT) return;
        const f32x4 gte = a * st.x, up = b * st.x; wstore<0>(ps, n, act + (size_t)row * DFF + pn * 128 + lc, gte * sigm4(gte) * up);
    }
};

template <int MODE> __device__ __forceinline__ int srccol(int n) {
    if (MODE == 1) { if (n >= 1024 && n < 2048) { const int q = (n - 1024) >> 8, r = (n - 1024) & 255; return r < 128 ? 1024 + 128 * q + r : 1536 + 128 * q + (r - 128); } return n; }
    if (MODE == 2) { const int t = n >> 8, r = n & 255; return r < 128 ? 128 * t + r : DFF + 128 * t + (r - 128); }
    return n;
}
template <int MODE>
__device__ __forceinline__ int conv_T(LAS float* tile, const float* src, int ldsrc, const float* scale, bf16_t* dst, int ldd, int N, int K, int nb, int bi, int base) {
    const int tid = otid(), ntn = N >> 8, ntiles = ntn * (K >> 6);
    int t = bi - (base % nb); if (t < 0) t += nb;
    const int q = tid & 63, kr = tid >> 6; f32x4 v[8]; float sc8[8];
#define CT_LOAD(tt) do { const int n0_ = ((tt) % ntn) << 8, k0_ = ((tt) / ntn) << 6, sc_ = srccol<MODE>(n0_ + 4 * q); \
        _Pragma("unroll") for (int i = 0; i < 8; ++i) { v[i] = *(const f32x4*)(src + (size_t)(k0_ + i * 8 + kr) * ldsrc + sc_); sc8[i] = scale ? scale[k0_ + i * 8 + kr] : 1.0f; } } while (0)
    if (t < ntiles) CT_LOAD(t);
    for (; t < ntiles; t += nb) {
        const int n0 = (t % ntn) << 8, k0 = (t / ntn) << 6;
#pragma unroll
        for (int i = 0; i < 8; ++i) *(LAS f32x4*)(tile + (i * 8 + kr) * 260 + 4 * q) = v[i] * sc8[i];
        __syncthreads();
        if (t + nb < ntiles) CT_LOAD(t + nb);
        { const int n = tid >> 1, kh = tid & 1;
#pragma unroll
          for (int j4 = 0; j4 < 4; ++j4) { float w[8];
#pragma unroll
              for (int j = 0; j < 8; ++j) w[j] = tile[(kh * 32 + j4 * 8 + j) * 260 + n];
              store8(dst + (size_t)(n0 + n) * ldd + k0 + kh * 32 + j4 * 8, w); } }
        __syncthreads();
    }
#undef CT_LOAD
    return base + ntiles;
}

__device__ __forceinline__ void s5_build(KArgsP a, int l, int g, LAS unsigned char* lds, const int part, const int nparts) {
    const int tid = otid();
    LAS float* apr = (LAS float*)lds; LAS float* api = apr + 17 * 64; LAS float* bbr = api + 17 * 64; LAS float* bbi = bbr + 1024;
    LAS float* ccr = bbi + 1024; LAS float* cci = ccr + 1024; LAS float* kk = cci + 1024;
    const float* lam_re = a->in[20] + (size_t)(l * 32 + g) * 64; const float* lam_im = a->in[21] + (size_t)(l * 32 + g) * 64;
    const float dt = expf(a->in[22][l * 32 + g]);
    bf16_t* TF = (bf16_t*)(a->ws + OFF_TF); bf16_t* ET = (bf16_t*)(a->ws + OFF_ET); float* TAB = (float*)(a->ws + OFF_TAB);
    for (int idx = tid; idx < 17 * 64; idx += 512) { const int d = idx >> 6, p = idx & 63; const float lr = lam_re[p], li = lam_im[p];
        const float mag = expf((float)d * lr * dt);
        double x = (double)d * (double)li * (double)dt; x -= 6.283185307179586 * rint(x * 0.15915494309189535); const float xr = (float)x;
        apr[idx] = mag * cosf(xr); api[idx] = mag * sinf(xr); }
    __syncthreads();
    for (int idx = tid; idx < 1024; idx += 512) { const int p = idx >> 4; const float lr = lam_re[p], li = lam_im[p], ar = apr[64 + p], ai = api[64 + p], den = lr * lr + li * li;
        const float qr = ((ar - 1.0f) * lr + ai * li) / den, qi = (ai * lr - (ar - 1.0f) * li) / den;
        const float br = a->in[23][(size_t)(l * 32 + g) * 1024 + idx], bi = a->in[24][(size_t)(l * 32 + g) * 1024 + idx];
        bbr[idx] = qr * br - qi * bi; bbi[idx] = qr * bi + qi * br;
        ccr[idx] = a->in[25][(size_t)(l * 32 + g) * 1024 + idx]; cci[idx] = a->in[26][(size_t)(l * 32 + g) * 1024 + idx]; }
    __syncthreads();
    if (part == 0 && tid < 64) { TAB[(g * 64 + tid) * 2] = apr[64 + tid]; TAB[(g * 64 + tid) * 2 + 1] = api[64 + tid]; TAB[4096 + (g * 64 + tid) * 2] = apr[16 * 64 + tid]; TAB[4096 + (g * 64 + tid) * 2 + 1] = api[16 * 64 + tid]; }
    if (part == 0) for (int idx = tid; idx < 1024; idx += 512) { TAB[8192 + ((size_t)g * 1024 + idx) * 2] = bbr[idx]; TAB[8192 + ((size_t)g * 1024 + idx) * 2 + 1] = bbi[idx]; }
    for (int idx = tid; idx < 4096; idx += 512) { const int d = idx >> 8, c = (idx >> 4) & 15, c2 = idx & 15; float s = 0.f;
        for (int p = 0; p < 64; ++p) { const float Pr = apr[d * 64 + p], Pi = api[d * 64 + p], Br = bbr[p * 16 + c2], Bi = bbi[p * 16 + c2];
            const float Wr = Pr * Br - Pi * Bi, Wi = Pr * Bi + Pi * Br; s += ccr[c * 64 + p] * Wr - cci[c * 64 + p] * Wi; }
        kk[idx] = s; }
    __syncthreads();
    const int tfn = 256 / nparts, etn = 128 / nparts;
    for (int idx = part * tfn * KS5 + tid; idx < (part + 1) * tfn * KS5; idx += 512) { const int n = idx / KS5, k = idx % KS5, i = n >> 4, c = n & 15; float v;
        if (k < 256) { const int j = k >> 4, c2 = k & 15; v = (i >= j) ? kk[(i - j) * 256 + c * 16 + c2] : 0.f; }
        else if (k < 320) { const int p = k - 256; v = ccr[c * 64 + p] * apr[(i + 1) * 64 + p] - cci[c * 64 + p] * api[(i + 1) * 64 + p]; }
        else { const int p = k - 320; v = -(ccr[c * 64 + p] * api[(i + 1) * 64 + p] + cci[c * 64 + p] * apr[(i + 1) * 64 + p]); }
        TF[((size_t)g * 256 + n) * KS5 + k] = f2bf(v); }
    for (int idx = part * etn * 256 + tid; idx < (part + 1) * etn * 256; idx += 512) { const int n = idx >> 8, k = idx & 255, p = n & 63, j = k >> 4, c2 = k & 15, d = 15 - j;
        const float Pr = apr[d * 64 + p], Pi = api[d * 64 + p], Br = bbr[p * 16 + c2], Bi = bbi[p * 16 + c2];
        ET[((size_t)g * 128 + n) * 256 + k] = f2bf(n < 64 ? (Pr * Br - Pi * Bi) : (Pr * Bi + Pi * Br)); }
    if (g == 31 && part == 0) for (int idx = tid; idx < 128 * 256; idx += 512) ET[(size_t)32 * 128 * 256 + idx] = 0;
    __syncthreads();
}

__device__ __forceinline__ void phase0(KArgsP a, int l, LAS unsigned char* lds) {
    const int tid = otid(), blk = blockIdx.x, nblk = gridDim.x;
    LAS float* tile = (LAS float*)lds; unsigned char* ws = a->ws;
    const int nsb = (nblk >= 256) ? 128 : 0, nb = nblk - nsb;
    if (blk < nb) { int base = 0;
        base = conv_T<1>(tile, a->in[8] + (size_t)l * 1024 * INW, INW, a->in[7] + l * 1024, (bf16_t*)(ws + OFF_WIN), 1024, INW, 1024, nb, blk, base);
        base = conv_T<2>(tile, a->in[36] + (size_t)l * 1024 * INW, INW, a->in[35] + l * 1024, (bf16_t*)(ws + OFF_WF1), 1024, INW, 1024, nb, blk, base);
        base = conv_T<0>(tile, a->in[37] + (size_t)l * DFF * 1024, 1024, nullptr, (bf16_t*)(ws + OFF_WF2), DFF, 1024, DFF, nb, blk, base);
        base = conv_T<0>(tile, a->in[31] + (size_t)l * 1024 * 1024, 1024, nullptr, (bf16_t*)(ws + OFF_WPA), 1024, 1024, 1024, nb, blk, base);
        base = conv_T<0>(tile, a->in[34] + (size_t)l * 1024 * 1024, 1024, nullptr, (bf16_t*)(ws + OFF_WOUT), 1024, 1024, 1024, nb, blk, base);
        base = conv_T<0>(tile, a->in[32] + (size_t)l * 512 * 1024, 1024, nullptr, (bf16_t*)(ws + OFF_WPB), 512, 1024, 512, nb, blk, base);
        base = conv_T<0>(tile, a->in[33] + (size_t)l * 512 * 1024, 1024, nullptr, (bf16_t*)(ws + OFF_WPC), 512, 1024, 512, nb, blk, base);
        base = conv_T<0>(tile, a->in[28] + (size_t)l * 512 * 512, 512, nullptr, (bf16_t*)(ws + OFF_WGLU), 512, 512, 512, nb, blk, base);
    }
    { bf16_t* wgt = (bf16_t*)(ws + OFF_WGT); const float* wrg = a->in[11] + (size_t)l * 8 * 128 * 128; const float* wig = a->in[13] + (size_t)l * 8 * 128 * 128;
      for (int idx = blk * 512 + tid; idx < 2048 * 256; idx += nblk * 512) { const int n = idx >> 8, k = idx & 255, h = n >> 8, s = (n >> 7) & 1, j = n & 127; float v = 0.f;
          if ((k >> 7) == (h & 1)) v = (s ? wig : wrg)[((size_t)h * 128 + (k & 127)) * 128 + j];
          wgt[idx] = f2bf(v); } }
    { float* TAB = (float*)(ws + OFF_TAB); for (int idx = blk * 512 + tid; idx < 1024; idx += nblk * 512) TAB[TAB_LAM + idx] = -8.0f * log1pf(expf(-a->in[15][l * 1024 + idx])); }
    if (nsb) { if (blk >= nb) s5_build(a, l, (blk - nb) >> 2, lds, (blk - nb) & 3, 4); } else { for (int g = blk; g < 32; g += nblk) s5_build(a, l, g, lds, 0, 1); }
    if (l == 0) {
        bf16_t* xb = (bf16_t*)(ws + OFF_XB); float* rsq = (float*)(ws + OFF_RSQ); const int wv = tid >> 6, lane = tid & 63;
        f32x4 vn[4]; const int rstep = nblk * 8; int row = blk * 8 + wv;
        if (row < MT) { const float* src = (row < MP) ? a->in[0] + (size_t)row * 1024 : a->in[1] + (size_t)(row - MP) * 1024;
#pragma unroll
            for (int i = 0; i < 4; ++i) vn[i] = *(const f32x4*)(src + i * 256 + lane * 4); }
        for (; row < MT; row += rstep) { f32x4 vc[4]; float ss = 0.f;
#pragma unroll
            for (int i = 0; i < 4; ++i) vc[i] = vn[i];
            if (row + rstep < MT) { const int rn = row + rstep; const float* src = (rn < MP) ? a->in[0] + (size_t)rn * 1024 : a->in[1] + (size_t)(rn - MP) * 1024;
#pragma unroll
                for (int i = 0; i < 4; ++i) vn[i] = *(const f32x4*)(src + i * 256 + lane * 4); }
#pragma unroll
            for (int i = 0; i < 4; ++i) { const f32x4 v = vc[i]; ss += v[0] * v[0] + v[1] * v[1] + v[2] * v[2] + v[3] * v[3];
                u32x2 w; w.x = cvt_pk_bf16(v[0], v[1]); w.y = cvt_pk_bf16(v[2], v[3]); *(u32x2*)(xb + (size_t)row * 1024 + i * 256 + lane * 4) = w; }
            ss = wave_sum(ss); if (lane < 16) rsq[(size_t)row * 16 + lane] = (lane == 0) ? ss : 0.f; }
    }
}

__device__ __forceinline__ void conv_a_phase(KArgsP a, int l) {
    const bf16_t* ua = (const bf16_t*)(a->ws + OFF_SA); bf16_t* ca = (bf16_t*)(a->ws + OFF_SB);
    const float* w = a->in[9] + (size_t)l * 4 * 1024; const float* bias = a->in[10] + (size_t)l * 1024;
    const int tid = otid();
    const int c8 = (tid & 127) * 8;
    float wv[4][8], bv[8];
#pragma unroll
    for (int k = 0; k < 4; ++k) { const f32x4 p = *(const f32x4*)(w + k * 1024 + c8), q = *(const f32x4*)(w + k * 1024 + c8 + 4);
#pragma unroll
        for (int j = 0; j < 4; ++j) { wv[k][j] = p[j]; wv[k][4 + j] = q[j]; } }
    { const f32x4 p = *(const f32x4*)(bias + c8), q = *(const f32x4*)(bias + c8 + 4);
#pragma unroll
      for (int j = 0; j < 4; ++j) { bv[j] = p[j]; bv[4 + j] = q[j]; } }
    const int step = gridDim.x * 512; int idx = blockIdx.x * 512 + tid;
    u32x4 xv[4];
    if (idx < MT * 128) { const int row = idx >> 7;
#pragma unroll
        for (int k = 0; k < 4; ++k) { const int rr = row - 3 + k; xv[k] = *(const u32x4*)(ua + (size_t)(rr < 0 ? 0 : rr) * 1024 + c8); } }
    for (; idx < MT * 128; idx += step) {
        const int row = idx >> 7; float acc[8], x[8]; u32x4 xc[4];
#pragma unroll
        for (int k = 0; k < 4; ++k) xc[k] = xv[k];
        if (idx + step < MT * 128) { const int rown = (idx + step) >> 7;
#pragma unroll
            for (int k = 0; k < 4; ++k) { const int rr = rown - 3 + k; xv[k] = *(const u32x4*)(ua + (size_t)(rr < 0 ? 0 : rr) * 1024 + c8); } }
#pragma unroll
        for (int j = 0; j < 8; ++j) acc[j] = bv[j];
        unpack8(xc[3], x);
        if (row < MP) { const int t = row & (SEQ - 1), b = row >> 11;
#pragma unroll
            for (int k = 0; k < 4; ++k) { if (t - 3 + k >= 0) { float xk[8]; unpack8(xc[k], xk);
#pragma unroll
                for (int j = 0; j < 8; ++j) acc[j] += wv[k][j] * xk[j]; } }
            if (t >= SEQ - 3) { float* o = a->out + O_PLC + (((size_t)l * NBATCH + b) * 3 + (t - (SEQ - 3))) * 1024 + c8;
#pragma unroll
                for (int j = 0; j < 8; ++j) o[j] = x[j]; }
        } else { const int s = row - MP; const float* st = a->in[2] + ((size_t)l * MS + s) * 3 * 1024 + c8; float* o = a->out + O_SLC + ((size_t)l * MS + s) * 3 * 1024 + c8;
#pragma unroll
            for (int j = 0; j < 8; ++j) { const float s0 = st[j], s1 = st[1024 + j], s2 = st[2048 + j];
                acc[j] += wv[0][j] * s0 + wv[1][j] * s1 + wv[2][j] * s2 + wv[3][j] * x[j]; o[j] = s1; o[1024 + j] = s2; o[2048 + j] = x[j]; }
        }
        store8(ca + (size_t)row * 1024 + c8, acc);
    }
}

__device__ __forceinline__ void cfm_phase(KArgsP a, int l, LAS unsigned char* lds) {
    const int tid = otid(), half = tid >> 8, cp = tid & 255, wv = tid >> 6, lane = tid & 63;
    const bf16_t* glu = (const bf16_t*)(a->ws + OFF_SE); bf16_t* yb = (bf16_t*)(a->ws + OFF_YB);
    LAS unsigned* in = (LAS unsigned*)lds;
    LAS float* part = (LAS float*)(lds + 62 * 1024);
    const float* wdw = a->in[16] + (size_t)l * 31 * 512 + 2 * cp;
    typedef float f32x2 __attribute__((ext_vector_type(2)));
    LAS f32x2* wl = (LAS f32x2*)(lds + 65536);
    for (int idx = tid; idx < 31 * 256; idx += 512) { const f32x2 wk = *(const f32x2*)(a->in[16] + (size_t)l * 31 * 512 + 2 * idx);
        u32x2 pk; pk.x = cvt_pk_bf16(wk.x, 0.f); pk.y = cvt_pk_bf16(0.f, wk.y); ((LAS u32x2*)wl)[idx] = pk; }
    const float bs0 = a->in[17][l * 512 + 2 * cp], bs1 = a->in[17][l * 512 + 2 * cp + 1];
    const float lg0 = a->in[18][l * 512 + 2 * cp], lg1 = a->in[18][l * 512 + 2 * cp + 1], lb0 = a->in[19][l * 512 + 2 * cp], lb1 = a->in[19][l * 512 + 2 * cp + 1];
    u32x4 pv[8];
#define CFM_LOAD(tl) do { const int b_ = (tl) >> 6, t0_ = ((tl) & 63) * 32; \
        _Pragma("unroll") for (int i = 0; i < 8; ++i) { const int idx = tid + 512 * i, r = idx >> 6, c16 = idx & 63, t = t0_ - 30 + r; pv[i] = (u32x4){0u, 0u, 0u, 0u}; \
            if (idx < 62 * 64 && t >= 0) pv[i] = *(const u32x4*)(glu + ((size_t)b_ * SEQ + t) * 512 + c16 * 8); } } while (0)
    if ((int)blockIdx.x < 512) CFM_LOAD((int)blockIdx.x);
    const int ntl = (gridDim.x == 256) ? 768 : 512 + 64;
    for (int tile0 = blockIdx.x; tile0 < ntl; tile0 += gridDim.x) {
        int tile = tile0;
        if (gridDim.x == 256 && tile0 >= 512) { tile = 512 + (((int)blockIdx.x + 64) & 255); if (tile >= 512 + 64) continue; }
        if (tile < 512) {
            const int b = tile >> 6, t0 = (tile & 63) * 32;
#pragma unroll
            for (int i = 0; i < 8; ++i) { const int idx = tid + 512 * i; if (idx < 62 * 64) *(LAS u32x4*)(in + (idx >> 6) * 256 + (idx & 63) * 4) = pv[i]; }
            if (tile + (int)gridDim.x < 512) CFM_LOAD(tile + (int)gridDim.x);
            __syncthreads();
            float val0[16], val1[16];
#pragma unroll
            for (int j = 0; j < 16; ++j) { val0[j] = bs0; val1[j] = bs1; }
#pragma unroll 1
            for (int k = 0; k < 31; ++k) { const u32x2 wk = ((const LAS u32x2*)wl)[k * 256 + cp]; const LAS unsigned* ip = in + (half * 16 + k) * 256 + cp;
#pragma unroll
                for (int j = 0; j < 16; ++j) { const unsigned xw = ip[j * 256];
                    asm("v_dot2c_f32_bf16 %0, %1, %2" : "+v"(val0[j]) : "v"(xw), "v"(wk.x));
                    asm("v_dot2c_f32_bf16 %0, %1, %2" : "+v"(val1[j]) : "v"(xw), "v"(wk.y)); } }
#pragma unroll
            for (int ti = 0; ti < 16; ++ti) { float s = val0[ti] + val1[ti], q = val0[ti] * val0[ti] + val1[ti] * val1[ti]; s = wave_sum(s); q = wave_sum(q);
                if (lane == 0) { part[((half * 16 + ti) * 4 + (wv & 3)) * 2] = s; part[((half * 16 + ti) * 4 + (wv & 3)) * 2 + 1] = q; } }
            if (t0 + 32 == SEQ) {
                float* o = a->out + O_PCC + ((size_t)l * NBATCH + b) * 30 * 512;
                for (int idx = tid; idx < 30 * 256; idx += 512) { const int r = idx >> 8, c = idx & 255; const unsigned xw = in[(32 + r) * 256 + c]; o[r * 512 + 2 * c] = __uint_as_float(xw << 16); o[r * 512 + 2 * c + 1] = __uint_as_float(xw & 0xffff0000u); } }
            __syncthreads();
#pragma unroll
            for (int ti = 0; ti < 16; ++ti) { const LAS float* pp = part + (half * 16 + ti) * 8; const float S = (pp[0] + pp[2]) + (pp[4] + pp[6]), Q = (pp[1] + pp[3]) + (pp[5] + pp[7]);
                const float mean = S * (1.0f / 512.0f), var = fmaxf(Q * (1.0f / 512.0f) - mean * mean, 0.f), rstd = rsqrtf(var + EPS);
                float y0 = (val0[ti] - mean) * rstd * lg0 + lb0, y1 = (val1[ti] - mean) * rstd * lg1 + lb1; y0 *= sigm(y0); y1 *= sigm(y1);
                *(unsigned*)(yb + ((size_t)b * SEQ + t0 + half * 16 + ti) * 512 + 2 * cp) = cvt_pk_bf16(y0, y1); }
            __syncthreads();
        } else {
            const int s = (tile - 512) * 2 + half; const float* st = a->in[4] + ((size_t)l * MS + s) * 30 * 512 + 2 * cp; float* o = a->out + O_SCC + ((size_t)l * MS + s) * 30 * 512 + 2 * cp;
            float a0 = bs0, a1 = bs1;
#pragma unroll 2
            for (int k = 0; k < 30; ++k) { const float x0 = st[k * 512], x1 = st[k * 512 + 1]; a0 += wdw[k * 512] * x0; a1 += wdw[k * 512 + 1] * x1; if (k >= 1) { o[(k - 1) * 512] = x0; o[(k - 1) * 512 + 1] = x1; } }
            { const unsigned xw = *(const unsigned*)(glu + (size_t)(MP + s) * 512 + 2 * cp); const float x0 = __uint_as_float(xw << 16), x1 = __uint_as_float(xw & 0xffff0000u);
              a0 += wdw[30 * 512] * x0; a1 += wdw[30 * 512 + 1] * x1; o[29 * 512] = x0; o[29 * 512 + 1] = x1; }
            float sm = wave_sum(a0 + a1), q = wave_sum(a0 * a0 + a1 * a1);
            if (lane == 0) { part[(half * 4 + (wv & 3)) * 2] = sm; part[(half * 4 + (wv & 3)) * 2 + 1] = q; }
            __syncthreads();
            { const LAS float* pp = part + half * 8; const float S = (pp[0] + pp[2]) + (pp[4] + pp[6]), Q = (pp[1] + pp[3]) + (pp[5] + pp[7]);
              const float mean = S * (1.0f / 512.0f), var = fmaxf(Q * (1.0f / 512.0f) - mean * mean, 0.f), rstd = rsqrtf(var + EPS);
              float y0 = (a0 - mean) * rstd * lg0 + lb0, y1 = (a1 - mean) * rstd * lg1 + lb1; y0 *= sigm(y0); y1 *= sigm(y1);
              *(unsigned*)(yb + (size_t)(MP + s) * 512 + 2 * cp) = cvt_pk_bf16(y0, y1); }
            __syncthreads();
        }
    }
}

#undef CFM_LOAD
__device__ __forceinline__ void s5_sample(KArgsP a, int l) {
    const int tid = otid(); const int wv = tid >> 6, p = tid & 63; const float* TAB = (const float*)(a->ws + OFF_TAB);
    const bf16_t* ucs = (const bf16_t*)(a->ws + OFF_UCS); bf16_t* yc0 = (bf16_t*)(a->ws + OFF_SE);
    for (int w = blockIdx.x * 8 + wv; w < MS * 32; w += gridDim.x * 8) { const int s = w >> 5, g = w & 31;
        float u[16]; load8(ucs + (size_t)s * 512 + g * 16, u); load8(ucs + (size_t)s * 512 + g * 16 + 8, u + 8);
        const float ar = TAB[(g * 64 + p) * 2], ai = TAB[(g * 64 + p) * 2 + 1]; const float* bb = TAB + 8192 + ((size_t)g * 1024 + p * 16) * 2;
        const size_t si = (((size_t)l * MS + s) * 32 + g) * 64 + p; const float s0r = a->in[5][si], s0i = a->in[6][si];
        float xr = ar * s0r - ai * s0i, xi = ar * s0i + ai * s0r;
#pragma unroll
        for (int c = 0; c < 16; ++c) { xr += bb[2 * c] * u[c]; xi += bb[2 * c + 1] * u[c]; }
        a->out[O_SSR + si] = xr; a->out[O_SSI + si] = xi;
        const float* cr = a->in[25] + (size_t)(l * 32 + g) * 1024; const float* ci = a->in[26] + (size_t)(l * 32 + g) * 1024; float mine = 0.f;
#pragma unroll
        for (int c = 0; c < 16; ++c) { const float t = wave_sum(cr[c * 64 + p] * xr - ci[c * 64 + p] * xi); if (p == c) mine = t; }
        float up = 0.f;
#pragma unroll
        for (int c = 0; c < 16; ++c) up = (p == c) ? u[c] : up;
        if (p < 16) yc0[(size_t)(MP + s) * 512 + g * 16 + p] = f2bf(gelu_tanh(mine + a->in[27][l * 512 + g * 16 + p] * up));
    }
}

__device__ __forceinline__ void s5_carry_bg(KArgsP a, int l, LAS unsigned char* lds, const int b, const int g) {
    const int tid = otid(), seg = tid >> 6, p = tid & 63; const float* TAB = (const float*)(a->ws + OFF_TAB);
    const float* ends = (const float*)(a->ws + OFF_SF); bf16_t* ucg = (bf16_t*)(a->ws + OFF_UCG); LAS float* sT = (LAS float*)lds;
    {
        const float ar = TAB[4096 + (g * 64 + p) * 2], ai = TAB[4096 + (g * 64 + p) * 2 + 1];
        const size_t c0 = (size_t)g * NCHK + b * 128 + seg * 16; float er[16], ei[16];
#pragma unroll
        for (int k = 0; k < 16; ++k) { er[k] = ends[(c0 + k) * 128 + p]; ei[k] = ends[(c0 + k) * 128 + 64 + p]; }
        float Lr[17], Li[17]; Lr[0] = 0.f; Li[0] = 0.f;
#pragma unroll
        for (int k = 0; k < 16; ++k) { Lr[k + 1] = ar * Lr[k] - ai * Li[k] + er[k]; Li[k + 1] = ar * Li[k] + ai * Lr[k] + ei[k]; }
        sT[(seg * 64 + p) * 2] = Lr[16]; sT[(seg * 64 + p) * 2 + 1] = Li[16];
        __syncthreads();
        float br = ar, bi = ai;
#pragma unroll
        for (int i = 0; i < 4; ++i) { const float t = br * br - bi * bi; bi = 2.f * br * bi; br = t; }
        float Sr = 0.f, Si = 0.f;
        for (int s2 = 0; s2 < seg; ++s2) { const float tr = sT[(s2 * 64 + p) * 2], ti = sT[(s2 * 64 + p) * 2 + 1]; const float nr = br * Sr - bi * Si + tr; Si = br * Si + bi * Sr + ti; Sr = nr; }
        float pr = 1.f, pi = 0.f;
#pragma unroll
        for (int k = 0; k < 16; ++k) { const float vr = Lr[k] + pr * Sr - pi * Si, vi = Li[k] + pr * Si + pi * Sr;
            ucg[(c0 + k) * KS5 + 256 + p] = f2bf(vr); ucg[(c0 + k) * KS5 + 320 + p] = f2bf(vi);
            const float t = pr * ar - pi * ai; pi = pr * ai + pi * ar; pr = t; }
        if (seg == 7) { const size_t o = (((size_t)l * NBATCH + b) * 32 + g) * 64 + p; a->out[O_PSR + o] = Lr[16] + br * Sr - bi * Si; a->out[O_PSI + o] = Li[16] + br * Si + bi * Sr; }
        __syncthreads();
    }
}
__device__ __forceinline__ void s5_carry(KArgsP a, int l, LAS unsigned char* lds) { for (int w = blockIdx.x; w < NBATCH * 32; w += gridDim.x) s5_carry_bg(a, l, lds, w >> 5, w & 31); }

__device__ __forceinline__ void lru_scan(KArgsP a, int l, LAS unsigned char* lds, bf16_t* dst_alt) {
    const int tid = otid(), cq = tid & 7, chunk = tid >> 3;
    bf16_t* la = (bf16_t*)(a->ws + OFF_SA); const bf16_t* bx = (const bf16_t*)(a->ws + OFF_SC);
    LAS f32x4* sP = (LAS f32x4*)lds; LAS f32x4* sH = sP + 64 * 8;
    for (int w = blockIdx.x; w < NBATCH * 32; w += gridDim.x) { const int b = w >> 5, cg_ = w & 31;
        const size_t base = ((size_t)b * SEQ + chunk * 32) * 1024 + cg_ * 32 + cq * 4;
        f32x4 P = (f32x4){1.f, 1.f, 1.f, 1.f}, h = (f32x4){0.f, 0.f, 0.f, 0.f};
        u32x2 lw[32], bw[32];
#pragma unroll
        for (int j = 0; j < 32; ++j) { lw[j] = *(const u32x2*)(la + base + (size_t)j * 1024); bw[j] = *(const u32x2*)(bx + base + (size_t)j * 1024); }
#pragma unroll
        for (int j = 0; j < 32; ++j) { const f32x4 av = (f32x4){__expf(bf2f(lw[j].x & 0xffffu)), __expf(bf2f(lw[j].x >> 16)), __expf(bf2f(lw[j].y & 0xffffu)), __expf(bf2f(lw[j].y >> 16))};
            const f32x4 bv = (f32x4){bf2f(bw[j].x & 0xffffu), bf2f(bw[j].x >> 16), bf2f(bw[j].y & 0xffffu), bf2f(bw[j].y >> 16)};
            h = av * h + bv; P = P * av; }
        sP[chunk * 8 + cq] = P; sH[chunk * 8 + cq] = h;
        __syncthreads();
        f32x4 cin = (f32x4){0.f, 0.f, 0.f, 0.f};
        for (int c2 = 0; c2 < chunk; ++c2) cin = sP[c2 * 8 + cq] * cin + sH[c2 * 8 + cq];
        h = cin;
#pragma unroll
        for (int j = 0; j < 32; ++j) { asm volatile("" : "+v"(lw[j].x), "+v"(lw[j].y), "+v"(bw[j].x), "+v"(bw[j].y));
            const f32x4 av = (f32x4){__expf(bf2f(lw[j].x & 0xffffu)), __expf(bf2f(lw[j].x >> 16)), __expf(bf2f(lw[j].y & 0xffffu)), __expf(bf2f(lw[j].y >> 16))};
            const f32x4 bv = (f32x4){bf2f(bw[j].x & 0xffffu), bf2f(bw[j].x >> 16), bf2f(bw[j].y & 0xffffu), bf2f(bw[j].y >> 16)};
            h = av * h + bv; u32x2 o; o.x = cvt_pk_bf16(h[0], h[1]); o.y = cvt_pk_bf16(h[2], h[3]); *(u32x2*)(dst_alt + base + (size_t)j * 1024) = o; }
        if (chunk == 63) *(f32x4*)(a->out + O_PLH + ((size_t)l * NBATCH + b) * 1024 + cg_ * 32 + cq * 4) = h;
        __syncthreads();
    }
}


#define XB_TMO      128
#define XB_XCNT(j)  (256  + 64 * (j))
#define XB_XSUB(j)  (1280 + 64 * (j))
#define XB_XGEN(j)  (2304 + 64 * (j))
#define XB_TOP      3328
#define XB_TOPGEN   3392
#define XCD_BAR_WORDS 3456
#define XB_SPIN_CAP (1u << 18)
__device__ __forceinline__ unsigned xb_ld(unsigned* p)              { return __hip_atomic_load(p, __ATOMIC_RELAXED, __HIP_MEMORY_SCOPE_AGENT); }
__device__ __forceinline__ unsigned xb_add(unsigned* p, unsigned v) { return __hip_atomic_fetch_add(p, v, __ATOMIC_RELAXED, __HIP_MEMORY_SCOPE_AGENT); }
__device__ __forceinline__ unsigned xb_xcc_id() { return (unsigned)__builtin_amdgcn_s_getreg((3 << 11) | 20) & 0xFu; }
#define XB_SPIN(cond, bar) do { unsigned _sp = 0; while (cond) { __builtin_amdgcn_s_sleep(1); \
    if ((++_sp & 255u) == 0u) { if (xb_ld(&(bar)[XB_TMO])) break; if (_sp > XB_SPIN_CAP) { atomicAdd(&(bar)[XB_TMO], 1u); break; } } } } while (0)
__device__ __forceinline__ void xcd_barrier_complete(unsigned* bar, unsigned x, unsigned& nloc, unsigned& nx) {
    const unsigned G = gridDim.x * gridDim.y * gridDim.z;
    unsigned sum, cnt, mine, sp = 0u;
    for (;;) {
        sum = 0u; cnt = 0u; mine = 0u;
#pragma unroll
        for (unsigned j = 0; j < 16; ++j) { const unsigned c = xb_ld(&bar[XB_XCNT(j)]); sum += c; cnt += (c > 0u) ? 1u : 0u; mine = (j == x) ? c : mine; }
        if (sum == G) break;
        __builtin_amdgcn_s_sleep(1);
        if ((++sp & 255u) == 0u) { if (xb_ld(&bar[XB_TMO])) break; if (sp > XB_SPIN_CAP) { atomicAdd(&bar[XB_TMO], 1u); break; } }
    }
    nloc = mine > 0u ? mine : 1u; nx = cnt > 0u ? cnt : 1u;
}
__device__ __forceinline__ void xcd_barrier(unsigned* bar, volatile LAS unsigned* st) {
    asm volatile("s_waitcnt vmcnt(0)" ::: "memory");
    __syncthreads();
    if (threadIdx.x == 0) {
        const unsigned x = xb_xcc_id();
        __builtin_amdgcn_s_waitcnt(0);
        unsigned nloc = st[0], nx = st[1];
        if (nloc == 0u) { xcd_barrier_complete(bar, x, nloc, nx); st[0] = nloc; st[1] = nx; }
        const unsigned old = xb_add(&bar[XB_XSUB(x)], 1u);
        const unsigned gen = old / nloc;
        if (old + 1u == (gen + 1u) * nloc) {
            __builtin_amdgcn_fence(__ATOMIC_RELEASE, "agent");
            asm volatile("s_waitcnt vmcnt(0)" ::: "memory");
            const unsigned og = xb_add(&bar[XB_TOP], 1u);
            const unsigned tg = og / nx;
            if (og + 1u == (tg + 1u) * nx) xb_add(&bar[XB_TOPGEN], 1u);
            else XB_SPIN(xb_ld(&bar[XB_TOPGEN]) == tg, bar);
            __builtin_amdgcn_fence(__ATOMIC_ACQUIRE, "agent");
            xb_add(&bar[XB_XGEN(x)], 1u);
            asm volatile("s_waitcnt vmcnt(0)" ::: "memory");
        } else {
            XB_SPIN(xb_ld(&bar[XB_XGEN(x)]) == gen, bar);
            __builtin_amdgcn_fence(__ATOMIC_ACQUIRE, "agent");
            asm volatile("s_waitcnt vmcnt(0)" ::: "memory");
        }
    }
    __syncthreads();
}

#ifndef PROBE_DUP
#define PROBE_DUP -1
#endif
#define REP(k) for (int rep_ = 0; rep_ < ((PROBE_DUP) == (k) ? 2 : 1); ++rep_)
#define XBAR() xcd_barrier((unsigned*)(kargs()->ws + OFF_BAR), (volatile LAS unsigned*)(lds + 131072 + 512))
#define GSYNC() do { XBAR(); if ((PROBE_DUP) == 100) XBAR(); } while (0)
#ifndef PH_ONLY
#define PH_ON(n) true
#else
#define PH_ON(n) ((n) == PH_ONLY)
#endif
__global__ void __launch_bounds__(512) fwd_megakernel(KArgs a_by_value) {
    extern __shared__ __attribute__((aligned(16))) unsigned char lds_raw[];
    LAS unsigned char* lds = (LAS unsigned char*)lds_raw;
    cg::grid_group grid = cg::this_grid();
    { volatile LAS unsigned* st = (volatile LAS unsigned*)(lds + 131072 + 512); if (threadIdx.x == 0) { st[0] = 0u; st[1] = 0u; }
      __syncthreads();
      if (threadIdx.x == 0) (void)xb_add((unsigned*)(kargs()->ws + OFF_BAR) + XB_XCNT(xb_xcc_id()), 1u); }
    grid.sync();
#define WSB(off) ((bf16_t*)(ws + (off)))
#define PH_HEAD KArgsP a = kargs(); unsigned char* ws = a->ws; const int G = gridDim.x, c = oblk(); (void)G; (void)c; (void)ws;

    for (int l = 0; l < NLAYER; ++l) {
        REP(0) if (PH_ON(0)) { PH_HEAD phase0(a, l, lds); }
        GSYNC();
        REP(1) if (PH_ON(1)) { PH_HEAD
          Sched S{65, 10, 1, G, c, 0, (const char*)WSB(OFF_XB), (const char*)WSB(OFF_WIN), 0, 0, (size_t)256 * 1024 * 2, (size_t)256 * 1024 * 2};
          F1 f{(const float*)(ws + OFF_RSQ), WSB(OFF_SA), WSB(OFF_SE), WSB(OFF_UCG), WSB(OFF_UCS)};
          gemm_phase(lds, 1024, 1024, 16, S, f); }
        GSYNC();
        REP(20) if (PH_ON(20)) { PH_HEAD conv_a_phase(a, l); }
        REP(21) if (PH_ON(21)) { PH_HEAD cfm_phase(a, l, lds); }
        REP(22) if (PH_ON(22)) { PH_HEAD
          Sched S{4, 1, 32, G, c, 0, (const char*)WSB(OFF_UCG), (const char*)(ws + OFF_ET), (size_t)NCHK * KS5 * 2, (size_t)128 * 256 * 2, (size_t)256 * KS5 * 2, 0};
          FEnd f{(float*)(ws + OFF_SF)};
          gemm_phase(lds, KS5, 256, 4, S, f);
          if (G == 256) { Unit u; if (S.next(0, u)) { s5_carry_bg(a, l, lds, 2 * u.pm, u.g); s5_carry_bg(a, l, lds, 2 * u.pm + 1, u.g); } } }
        GSYNC();
        if (gridDim.x == 256) {
            REP(3) if (PH_ON(3)) { PH_HEAD
              const bool lo = c < 128;
              Sched S{64, 8, 1, 128, lo ? c : c - 128, 1, (const char*)WSB(OFF_SB), (const char*)(ws + OFF_WGT), 0, 0, (size_t)256 * 1024 * 2, (size_t)256 * 256 * 2, lo ? 0L : 384L, lo ? 384L : 512L};
              F2 f{WSB(OFF_SB), a->in[12] + l * 1024, a->in[14] + l * 1024, (const float*)(ws + OFF_TAB) + TAB_LAM, a->in[3] + (size_t)l * MS * 1024, WSB(OFF_SA), WSB(OFF_SC), a->out + O_SLH + (size_t)l * MS * 1024};
              gemm_phase(lds, 1024, 256, 4, S, f);
              thin_gemm(lds, WSB(OFF_SB), 1024, WSB(OFF_WGT), 256, 256, 8, 1, f, c, G); }
            REP(41) if (PH_ON(41)) { PH_HEAD
              if (c >= 128) { Sched S{4, 1, 32, G, c - 128, 0, (const char*)WSB(OFF_UCG), (const char*)(ws + OFF_TF), (size_t)NCHK * KS5 * 2, (size_t)256 * KS5 * 2, (size_t)256 * KS5 * 2, 0};
                FS5 f{WSB(OFF_UCG), a->in[27] + l * 512, WSB(OFF_SE)};
                gemm_phase(lds, KS5, KS5, 6, S, f); } }
            REP(23) if (PH_ON(23)) { PH_HEAD s5_sample(a, l); }
            GSYNC();
            REP(4) if (PH_ON(4)) { PH_HEAD lru_scan(a, l, lds, WSB(OFF_SA)); }
        } else {
        REP(3) if (PH_ON(3)) { PH_HEAD
          Sched S{64, 8, 1, G, c, 1, (const char*)WSB(OFF_SB), (const char*)(ws + OFF_WGT), 0, 0, (size_t)256 * 1024 * 2, (size_t)256 * 256 * 2};
          F2 f{WSB(OFF_SB), a->in[12] + l * 1024, a->in[14] + l * 1024, (const float*)(ws + OFF_TAB) + TAB_LAM, a->in[3] + (size_t)l * MS * 1024, WSB(OFF_SA), WSB(OFF_SC), a->out + O_SLH + (size_t)l * MS * 1024};
          gemm_phase(lds, 1024, 256, 4, S, f);
          thin_gemm(lds, WSB(OFF_SB), 1024, WSB(OFF_WGT), 256, 256, 8, 1, f, c, G); }
        REP(31) if (PH_ON(31)) { PH_HEAD s5_carry(a, l, lds); }
        GSYNC();
        REP(4) if (PH_ON(4)) { PH_HEAD lru_scan(a, l, lds, ((PROBE_DUP) == 4 && rep_ == 0) ? WSB(OFF_SB) : WSB(OFF_SA)); }
        REP(23) if (PH_ON(23)) { PH_HEAD s5_sample(a, l); }
        REP(41) if (PH_ON(41)) { PH_HEAD
          Sched S{4, 1, 32, G, c, 0, (const char*)WSB(OFF_UCG), (const char*)(ws + OFF_TF), (size_t)NCHK * KS5 * 2, (size_t)256 * KS5 * 2, (size_t)256 * KS5 * 2, 0};
          FS5 f{WSB(OFF_UCG), a->in[27] + l * 512, WSB(OFF_SE)};
          gemm_phase(lds, KS5, KS5, 6, S, f); }
        GSYNC();
        }
        REP(5) if (PH_ON(5)) {
            { PH_HEAD
              Sched S{64, 2, 1, G, c, 0, (const char*)WSB(OFF_SE), (const char*)(ws + OFF_WGLU), 0, 0, (size_t)256 * 512 * 2, (size_t)256 * 512 * 2};
              F4 f{WSB(OFF_SE), a->in[29] + l * 512, WSB(OFF_SF)};
              gemm_phase(lds, 512, 512, 8, S, f);
              const int hb = G >> 1;
              thin_gemm(lds, WSB(OFF_SE), 512, WSB(OFF_WGLU), 512, 512, 2, 0, f, c >= hb ? c - hb : -1, G - hb); }
            { PH_HEAD
              const int hb = G >> 1, cr = c >= hb ? c - hb : c + (G - hb);
              const bf16_t* Wg = WSB(OFF_WIN) + (size_t)2560 * 1024;
              Sched S{64, 12, 1, G, cr, 0, (const char*)WSB(OFF_XB), (const char*)Wg, 0, 0, (size_t)256 * 1024 * 2, (size_t)256 * 1024 * 2};
              FG8 f{(const float*)(ws + OFF_RSQ), a->in[30] + l * 3072, ws + OFF_GT8};
              gemm_phase(lds, 1024, 1024, 16, S, f);
              thin_gemm(lds, WSB(OFF_XB), 1024, Wg, 1024, 1024, 12, 0, f, c >= hb ? c - hb : -1, G - hb); }
        }
        GSYNC();
        REP(6) if (PH_ON(6)) {
            { PH_HEAD
              SchedM3 S{G, c, (const char*)WSB(OFF_SA), (const char*)WSB(OFF_YB), (const char*)WSB(OFF_SF), (const char*)WSB(OFF_WPA), (const char*)WSB(OFF_WPB), (const char*)WSB(OFF_WPC)};
              FMS f{ws + OFF_GT8, WSB(OFF_MRG)};
              gemm_phase_t<FMS, SchedM3, true>(lds, 1024, 1024, 16, S, f); }
            { PH_HEAD
              thin_merge(lds, WSB(OFF_SA), WSB(OFF_YB), WSB(OFF_SF), WSB(OFF_WPA), WSB(OFF_WPB), WSB(OFF_WPC), ws + OFF_GT8, WSB(OFF_MRG), c, G); }
        }
        GSYNC();
        if (PH_ON(7)) { PH_HEAD
          Sched S{64, 4, 1, G, c, 0, (const char*)WSB(OFF_MRG), (const char*)(ws + OFF_WOUT), 0, 0, (size_t)256 * 1024 * 2, (size_t)256 * 1024 * 2};
          F6T<false> f{l == 0 ? a->in[0] : a->out, l == 0 ? a->in[1] : a->out + (size_t)MP * 1024, a->out, WSB(OFF_XB), (float*)(ws + OFF_RSQ2)};
          gemm_phase(lds, 1024, 1024, 16, S, f);
          F6T<true> ft{f.xs_p, f.xs_s, f.xd, f.xb, f.rsq};
          thin_gemm(lds, WSB(OFF_MRG), 1024, WSB(OFF_WOUT), 1024, 1024, 4, 0, ft, c, G); }
        GSYNC();
        REP(8) if (PH_ON(8)) { PH_HEAD
          Sched S{65, 22, 1, G, c, 0, (const char*)WSB(OFF_XB), (const char*)(ws + OFF_WF1), 0, 0, (size_t)256 * 1024 * 2, (size_t)256 * 1024 * 2};
          F7 f{(const float*)(ws + OFF_RSQ2), WSB(OFF_SA)};
          gemm_phase(lds, 1024, 1024, 16, S, f); }
        GSYNC();
        if (PH_ON(9)) { PH_HEAD
          Sched S{64, 4, 1, G, c, 0, (const char*)WSB(OFF_SA), (const char*)(ws + OFF_WF2), 0, 0, (size_t)256 * DFF * 2, (size_t)256 * DFF * 2};
          F6T<false> f{a->out, a->out + (size_t)MP * 1024, a->out, WSB(OFF_XB), (float*)(ws + OFF_RSQ)};
          gemm_phase(lds, DFF, DFF, DFF / 64, S, f);
          F6T<true> ft{f.xs_p, f.xs_s, f.xd, f.xb, f.rsq};
          thin_gemm(lds, WSB(OFF_SA), DFF, WSB(OFF_WF2), DFF, DFF, 4, 0, ft, c, G); }
        GSYNC();
    }
    { PH_HEAD const int tid = otid(); const int wv = tid >> 6, lane = tid & 63; const float* gf = a->in[38]; const float* RSQ = (const float*)(ws + OFF_RSQ);
      f32x4 vn[4], pn4; const int rstep = gridDim.x * 8; int row = blockIdx.x * 8 + wv; f32x4 gv[4];
#pragma unroll
      for (int i = 0; i < 4; ++i) gv[i] = *(const f32x4*)(gf + i * 256 + lane * 4);
      if (row < MT) { pn4 = *(const f32x4*)(RSQ + (size_t)row * 16 + (lane & 3) * 4);
#pragma unroll
          for (int i = 0; i < 4; ++i) vn[i] = *(const f32x4*)(a->out + (size_t)row * 1024 + i * 256 + lane * 4); }
      for (; row < MT; row += rstep) { f32x4 vc[4]; const f32x4 pc = pn4;
#pragma unroll
          for (int i = 0; i < 4; ++i) vc[i] = vn[i];
          if (row + rstep < MT) { const int rn = row + rstep; pn4 = *(const f32x4*)(RSQ + (size_t)rn * 16 + (lane & 3) * 4);
#pragma unroll
              for (int i = 0; i < 4; ++i) vn[i] = *(const f32x4*)(a->out + (size_t)rn * 1024 + i * 256 + lane * 4); }
          float sq = (pc[0] + pc[1]) + (pc[2] + pc[3]); sq += __shfl_xor(sq, 1); sq += __shfl_xor(sq, 2);
          const float rs = rsqrtf(sq * (1.0f / 1024.0f) + EPS); float* x = a->out + (size_t)row * 1024;
#pragma unroll
          for (int i = 0; i < 4; ++i) *(f32x4*)(x + i * 256 + lane * 4) = vc[i] * rs * gv[i]; } }
}

extern "C" void kernel_launch(void* const* d_in, const int* in_sizes, int n_in, void* d_out, int out_size, void* d_ws, size_t ws_size, hipStream_t stream) {
    static int grid_blocks = 0;
    if (!grid_blocks) {
        int dev = 0, cus = 0, per_cu = 0;
        hipGetDevice(&dev);
        hipDeviceGetAttribute(&cus, hipDeviceAttributeMultiprocessorCount, dev);
        hipFuncSetAttribute((const void*)fwd_megakernel, hipFuncAttributeMaxDynamicSharedMemorySize, LDS_BYTES);
        hipOccupancyMaxActiveBlocksPerMultiprocessor(&per_cu, (const void*)fwd_megakernel, 512, LDS_BYTES);
        if (per_cu < 1) { fprintf(stderr, "occupancy query says %d blocks/CU\n", per_cu); per_cu = 1; }
        if (per_cu > 1) per_cu = 1;
        grid_blocks = cus * per_cu;
        if (n_in != 39 || ws_size < WS_END) fprintf(stderr, "kernel_launch: unexpected n_in %d / ws_size %zu (need %zu)\n", n_in, ws_size, (size_t)WS_END);
    }
    (void)hipMemsetAsync((unsigned char*)d_ws + OFF_BAR, 0, 16384, stream);
    KArgs a{};
    for (int i = 0; i < 39; ++i) a.in[i] = (const float*)d_in[i];
    a.out = (float*)d_out; a.ws = (unsigned char*)d_ws;
    void* args[] = {&a};
    hipError_t e = hipLaunchCooperativeKernel((const void*)fwd_megakernel, dim3(grid_blocks), dim3(512), args, LDS_BYTES, stream);
    if (e != hipSuccess) fprintf(stderr, "cooperative launch failed: %s (grid %d)\n", hipGetErrorString(e), grid_blocks);
}
```
